# Optimizing an MI355X kernel written in HIP

```python
import math
import jax, jax.numpy as jnp
from jax import lax
import numpy as np

D_MODEL = 2048
BATCH = 16
SEQ = 256
DEPTH = 4
DEC_BATCH = 2
DEC_SEQ = 4096
PAST_LEN = 512

GRID_W = 64
N_MIXERS = 3
N_MLA = (DEPTH + 2) // 3
N_HYENA = (DEPTH + 1) // 3
N_FNET = DEPTH // 3

MLA_HEADS = 16
QK_NOPE = 128
QK_ROPE = 64
V_DIM = 128
Q_RANK = 512
KV_RANK = 512
ROPE_THETA = 10000.0
AXIS_ROPE = QK_ROPE // 2
Q_BLOCK = 128

HY_ORDER = 2
HY_DIRS = 2
HY_CONV = 3
HY_BANDS = 16
HY_EMB = 1 + 2 * HY_BANDS
HY_FW = 64
HY_SHIFT = 0.05
HY_DECAY_MIN = math.log(100.0) / 1.5
HY_DECAY_MAX = math.log(100.0) / 0.3

FNET_GROUPS = 8
FNET_CG = D_MODEL // FNET_GROUPS

D_FF = -(-8 * D_MODEL // (3 * 256)) * 256

DN_ALPHA = (2 * DEPTH) ** 0.25
DN_BETA = (8 * DEPTH) ** -0.25
LN_EPS = 1e-5
RMS_EPS = 1e-6
N_MOD = 6

kernel_name = 'hybrid_mla_hyena_fnet_diffusion_step'


def layer_norm(x, g, b):
    xf = x.astype(jnp.float32)
    mu = jnp.mean(xf, axis=-1, keepdims=True)
    var = jnp.mean(jnp.square(xf - mu), axis=-1, keepdims=True)
    return ((xf - mu) * lax.rsqrt(var + LN_EPS) * g + b).astype(x.dtype)


def rms_norm(x, g):
    xf = x.astype(jnp.float32)
    ms = jnp.mean(jnp.square(xf), axis=-1, keepdims=True)
    return (xf * lax.rsqrt(ms + RMS_EPS) * g).astype(x.dtype)


def modulation(cond, w, b):
    m = (jax.nn.silu(cond) @ w + b).reshape(cond.shape[:-1] + (N_MOD, 1, D_MODEL))
    return jnp.moveaxis(m, -3, 0)


def post_norm(h, delta, g, b):
    return layer_norm(DN_ALPHA * h + delta, g, b)


def swiglu(u, w_gate, w_up, w_down):
    return (jax.nn.silu(u @ w_gate) * (u @ w_up)) @ w_down


def grid_rope_tables(rows):
    row = jnp.repeat(jnp.arange(rows), GRID_W).astype(jnp.float32)
    col = jnp.tile(jnp.arange(GRID_W), rows).astype(jnp.float32)
    inv = ROPE_THETA ** (-jnp.arange(0, AXIS_ROPE, 2, dtype=jnp.float32) / AXIS_ROPE)
    ang = jnp.concatenate([row[:, None] * inv, col[:, None] * inv], axis=-1)
    return jnp.cos(ang), jnp.sin(ang)


def apply_rope(x, cos, sin):
    xf = x.astype(jnp.float32)
    x1, x2 = xf[..., 0::2], xf[..., 1::2]
    out = jnp.stack([x1 * cos - x2 * sin, x1 * sin + x2 * cos], axis=-1)
    return out.reshape(x.shape).astype(x.dtype)


def mla_queries(u, w_dq, q_norm, w_uq):
    b, l, _ = u.shape
    q = (rms_norm(u @ w_dq, q_norm) @ w_uq).reshape(b, l, MLA_HEADS, QK_NOPE + QK_ROPE)
    return q[..., :QK_NOPE], q[..., QK_NOPE:]


def mla_compress(u, w_dkv, kv_norm, w_kr):
    return rms_norm(u @ w_dkv, kv_norm), u @ w_kr


def mla_expand(ckv, w_ukv):
    b, l, _ = ckv.shape
    kv = (ckv @ w_ukv).reshape(b, l, MLA_HEADS, QK_NOPE + V_DIM)
    return kv[..., :QK_NOPE], kv[..., QK_NOPE:]


def mla_attention(q_nope, q_rope, k_nope, k_rope, v):
    b, lq = q_nope.shape[0], q_nope.shape[1]
    nb = lq // Q_BLOCK
    scale = (QK_NOPE + QK_ROPE) ** -0.5

    def to_blocks(t):
        return jnp.moveaxis(t.reshape((b, nb, Q_BLOCK) + t.shape[2:]), 1, 0)

    def block(qs):
        qn, qr = qs
        s = jnp.einsum('bqhd,bkhd->bhqk', qn, k_nope) + jnp.einsum('bqhr,bkr->bhqk', qr, k_rope)
        p = jax.nn.softmax(s.astype(jnp.float32) * scale, axis=-1).astype(v.dtype)
        return jnp.einsum('bhqk,bkhd->bqhd', p, v)

    o = lax.map(block, (to_blocks(q_nope), to_blocks(q_rope)))
    return jnp.moveaxis(o, 0, 1).reshape(b, lq, MLA_HEADS * V_DIM)


def mla_context(u, w_dq, q_norm, w_uq, w_dkv, kv_norm, w_kr, w_ukv, w_o):
    qn, qr = mla_queries(u, w_dq, q_norm, w_uq)
    ckv, krope = mla_compress(u, w_dkv, kv_norm, w_kr)
    kn, v = mla_expand(ckv, w_ukv)
    return mla_attention(qn, qr, kn, krope, v) @ w_o, ckv, krope


def mla_latent(u, ckv_ctx, krope_ctx, cos, sin, w_dq, q_norm, w_uq, w_dkv, kv_norm, w_kr, w_ukv, w_o):
    qn, qr = mla_queries(u, w_dq, q_norm, w_uq)
    qr = apply_rope(qr, cos[:, None, :], sin[:, None, :])
    ckv, krope = mla_compress(u, w_dkv, kv_norm, w_kr)
    krope = apply_rope(krope, cos, sin)
    ckv_all = jnp.concatenate([ckv, ckv_ctx.astype(ckv.dtype)], axis=1)
    krope_all = jnp.concatenate([krope, krope_ctx.astype(krope.dtype)], axis=1)
    kn, v = mla_expand(ckv_all, w_ukv)
    return mla_attention(qn, qr, kn, krope_all, v) @ w_o


def short_conv(x, w, b):
    l = x.shape[1]
    xp = jnp.pad(x, ((0, 0), (HY_CONV // 2, HY_CONV // 2), (0, 0)))
    return sum(w[k] * xp[:, k:k + l] for k in range(HY_CONV)) + b


def hyena_filters(l, f_w1, f_b1, f_freq1, f_w2, f_b2, f_freq2, f_w3, log_decay):
    t = jnp.linspace(0.0, 1.0, l, dtype=jnp.float32)[:, None]
    t_idx = jnp.arange(l, dtype=jnp.float32)[:, None]
    bands = jnp.linspace(1e-4, HY_BANDS - 1, HY_BANDS, dtype=jnp.float32)
    w = 2.0 * math.pi * t_idx * bands / l
    feat = jnp.concatenate([t, jnp.cos(w), -jnp.sin(w)], axis=-1).astype(f_w1.dtype)
    h = jnp.sin(f_freq1 * (feat @ f_w1 + f_b1))
    h = jnp.sin(f_freq2 * (h @ f_w2 + f_b2))
    h = (h @ f_w3).astype(jnp.float32).reshape(l, HY_DIRS, HY_ORDER, D_MODEL)
    decay = jnp.exp(log_decay.astype(jnp.float32))
    h = h * (jnp.exp(-t[:, :, None, None] * decay) + HY_SHIFT)
    h = h * lax.rsqrt(jnp.sum(h * h, axis=(0, 1), keepdims=True) + 1e-12)
    fwd, bwd = h[:, 0], h[:, 1]
    k = jnp.concatenate([fwd, jnp.zeros((1, HY_ORDER, D_MODEL), jnp.float32), bwd[1:][::-1]], axis=0)
    return jnp.fft.rfft(k, axis=0)


def long_conv(z, kf, skip):
    l = z.shape[1]
    zf = z.astype(jnp.float32)
    y = jnp.fft.irfft(jnp.fft.rfft(zf, n=2 * l, axis=1) * kf, n=2 * l, axis=1)[:, :l]
    return (y + skip.astype(jnp.float32) * zf).astype(z.dtype)


def hyena(u, w_in, b_in, conv_w, conv_b, f_w1, f_b1, f_freq1, f_w2, f_b2, f_freq2, f_w3,
          log_decay, skip, w_out, b_out):
    proj = short_conv(u @ w_in + b_in, conv_w, conv_b)
    v, x1, x2 = jnp.split(proj, 3, axis=-1)
    kf = hyena_filters(u.shape[1], f_w1, f_b1, f_freq1, f_w2, f_b2, f_freq2, f_w3, log_decay)
    z = v
    for o, gate in enumerate((x1, x2)):
        z = gate * long_conv(z, kf[:, o], skip[o])
    return z @ w_out + b_out


def fnet(u, w_out, b_out):
    b, l, d = u.shape
    g = u.astype(jnp.float32).reshape(b, l, FNET_GROUPS, FNET_CG)
    f = jnp.fft.fft2(g, axes=(1, 3), norm='ortho').real
    return f.reshape(b, l, d).astype(u.dtype) @ w_out + b_out


def setup_inputs(seed: int = 0) -> dict:
    key = jax.random.key(seed)
    ks = iter(jax.random.split(key, 64))
    D = D_MODEL

    def nrm(shape, scale=1.0):
        return jax.random.normal(next(ks), shape, jnp.float32) * scale

    inp = {}
    inp['x_prompt'] = nrm((BATCH, SEQ, D))
    inp['x_sample'] = nrm((DEC_BATCH, DEC_SEQ, D))
    inp['c'] = nrm((DEC_BATCH, D))
    inp['cache_ckv'] = nrm((DEC_BATCH, N_MLA, PAST_LEN, KV_RANK))
    inp['cache_krope'] = nrm((DEC_BATCH, N_MLA, PAST_LEN, QK_ROPE))
    inp['c_ctx'] = nrm((D,))
    inp['ada_w'] = nrm((DEPTH, D, N_MOD * D), D ** -0.5)
    inp['ada_b'] = nrm((DEPTH, N_MOD * D), 0.02)
    inp['ln_g'] = 1.0 + nrm((DEPTH, 2, D), 0.05)
    inp['ln_b'] = nrm((DEPTH, 2, D), 0.02)
    inp['ffn_w_gate'] = nrm((DEPTH, D, D_FF), D ** -0.5)
    inp['ffn_w_up'] = nrm((DEPTH, D, D_FF), D ** -0.5)
    inp['ffn_w_down'] = nrm((DEPTH, D_FF, D), DN_BETA * D_FF ** -0.5)
    inp['mla_w_dq'] = nrm((N_MLA, D, Q_RANK), D ** -0.5)
    inp['mla_q_norm'] = 1.0 + nrm((N_MLA, Q_RANK), 0.05)
    inp['mla_w_uq'] = nrm((N_MLA, Q_RANK, MLA_HEADS * (QK_NOPE + QK_ROPE)), Q_RANK ** -0.5)
    inp['mla_w_dkv'] = nrm((N_MLA, D, KV_RANK), D ** -0.5)
    inp['mla_kv_norm'] = 1.0 + nrm((N_MLA, KV_RANK), 0.05)
    inp['mla_w_kr'] = nrm((N_MLA, D, QK_ROPE), D ** -0.5)
    inp['mla_w_ukv'] = nrm((N_MLA, KV_RANK, MLA_HEADS * (QK_NOPE + V_DIM)), KV_RANK ** -0.5)
    inp['mla_w_o'] = nrm((N_MLA, MLA_HEADS * V_DIM, D), DN_BETA * (MLA_HEADS * V_DIM) ** -0.5)
    inp['hy_w_in'] = nrm((N_HYENA, D, 3 * D), D ** -0.5)
    inp['hy_b_in'] = nrm((N_HYENA, 3 * D), 0.02)
    inp['hy_conv_w'] = nrm((N_HYENA, HY_CONV, 3 * D), HY_CONV ** -0.5)
    inp['hy_conv_b'] = nrm((N_HYENA, 3 * D), 0.02)
    inp['hy_f_w1'] = nrm((N_HYENA, HY_EMB, HY_FW), HY_EMB ** -0.5)
    inp['hy_f_b1'] = nrm((N_HYENA, HY_FW), 0.1)
    inp['hy_f_freq1'] = 1.0 + nrm((N_HYENA, HY_FW), 0.1)
    inp['hy_f_w2'] = nrm((N_HYENA, HY_FW, HY_FW), HY_FW ** -0.5)
    inp['hy_f_b2'] = nrm((N_HYENA, HY_FW), 0.1)
    inp['hy_f_freq2'] = 1.0 + nrm((N_HYENA, HY_FW), 0.1)
    inp['hy_f_w3'] = nrm((N_HYENA, HY_FW, HY_DIRS * HY_ORDER * D), HY_FW ** -0.5)
    inp['hy_log_decay'] = jax.random.uniform(next(ks), (N_HYENA, HY_DIRS, HY_ORDER, D), jnp.float32,
                                             minval=math.log(HY_DECAY_MIN), maxval=math.log(HY_DECAY_MAX))
    inp['hy_skip'] = nrm((N_HYENA, HY_ORDER, D), 1.0)
    inp['hy_w_out'] = nrm((N_HYENA, D, D), DN_BETA * D ** -0.5)
    inp['hy_b_out'] = nrm((N_HYENA, D), 0.02)
    inp['fn_w_out'] = nrm((N_FNET, D, D), DN_BETA * D ** -0.5)
    inp['fn_b_out'] = nrm((N_FNET, D), 0.02)
    return inp


def reference(x_prompt, x_sample, c, cache_ckv, cache_krope, c_ctx,
              ada_w, ada_b, ln_g, ln_b, ffn_w_gate, ffn_w_up, ffn_w_down,
              mla_w_dq, mla_q_norm, mla_w_uq, mla_w_dkv, mla_kv_norm, mla_w_kr, mla_w_ukv, mla_w_o,
              hy_w_in, hy_b_in, hy_conv_w, hy_conv_b, hy_f_w1, hy_f_b1, hy_f_freq1,
              hy_f_w2, hy_f_b2, hy_f_freq2, hy_f_w3, hy_log_decay, hy_skip, hy_w_out, hy_b_out,
              fn_w_out, fn_b_out):
    rows = x_sample.shape[1] // GRID_W
    cos, sin = grid_rope_tables(rows)
    h_ctx, h_lat = x_prompt, x_sample
    ckv_states, krope_states = [], []
    for i in range(DEPTH):
        kind, j = i % N_MIXERS, i // N_MIXERS
        m_ctx = modulation(c_ctx, ada_w[i], ada_b[i])
        m_lat = modulation(c, ada_w[i], ada_b[i])
        u_ctx = h_ctx * (1.0 + m_ctx[1]) + m_ctx[0]
        u_lat = h_lat * (1.0 + m_lat[1]) + m_lat[0]
        if kind == 0:
            mp = (mla_w_dq[j], mla_q_norm[j], mla_w_uq[j], mla_w_dkv[j], mla_kv_norm[j],
                  mla_w_kr[j], mla_w_ukv[j], mla_w_o[j])
            o_ctx, ckv, krope = mla_context(u_ctx, *mp)
            ckv_states.append(ckv)
            krope_states.append(krope)
            o_lat = mla_latent(u_lat, cache_ckv[:, j], cache_krope[:, j], cos, sin, *mp)
        elif kind == 1:
            hp = (hy_w_in[j], hy_b_in[j], hy_conv_w[j], hy_conv_b[j], hy_f_w1[j], hy_f_b1[j],
                  hy_f_freq1[j], hy_f_w2[j], hy_f_b2[j], hy_f_freq2[j], hy_f_w3[j],
                  hy_log_decay[j], hy_skip[j], hy_w_out[j], hy_b_out[j])
            o_ctx = hyena(u_ctx, *hp)
            o_lat = hyena(u_lat, *hp)
        else:
            o_ctx = fnet(u_ctx, fn_w_out[j], fn_b_out[j])
            o_lat = fnet(u_lat, fn_w_out[j], fn_b_out[j])
        h_ctx = post_norm(h_ctx, m_ctx[2] * o_ctx, ln_g[i, 0], ln_b[i, 0])
        h_lat = post_norm(h_lat, m_lat[2] * o_lat, ln_g[i, 0], ln_b[i, 0])
        f_ctx = swiglu(h_ctx * (1.0 + m_ctx[4]) + m_ctx[3], ffn_w_gate[i], ffn_w_up[i], ffn_w_down[i])
        f_lat = swiglu(h_lat * (1.0 + m_lat[4]) + m_lat[3], ffn_w_gate[i], ffn_w_up[i], ffn_w_down[i])
        h_ctx = post_norm(h_ctx, m_ctx[5] * f_ctx, ln_g[i, 1], ln_b[i, 1])
        h_lat = post_norm(h_lat, m_lat[5] * f_lat, ln_g[i, 1], ln_b[i, 1])
    state_ckv = jnp.stack(ckv_states, axis=1)
    state_krope = jnp.stack(krope_states, axis=1)
    return (h_ctx, h_lat, state_ckv, state_krope)
```

```cpp
#define MK_PER_PHASE 1
#include <hip/hip_runtime.h>
#include <cstdio>
#include <cstdint>
#define GAS __attribute__((address_space(1)))
#define LAS __attribute__((address_space(3)))
typedef unsigned short bf16_t;
typedef unsigned v4u __attribute__((ext_vector_type(4)));
typedef unsigned v2u __attribute__((ext_vector_type(2)));
typedef float f32x4 __attribute__((ext_vector_type(4)));
typedef float f32x2 __attribute__((ext_vector_type(2)));

constexpr int D = 2048, NCTX = 4096, NLAT = 8192, NTOK = 12288, DFF = 5632, NKV = 13312;
constexpr int NTHREADS = 512, NWAVES = 8;
constexpr float DN_ALPHA = 1.681792830507429f;
constexpr float LN_EPS = 1e-5f, RMS_EPS = 1e-6f;
constexpr float QSCALE = 0.07216878364870322f * 1.4426950408889634f;
constexpr int FILT_LD = 4352;

constexpr size_t al256(size_t x) { return (x + 255) & ~(size_t)255; }
constexpr size_t SZ_WGU = (size_t)11264 * 2048 * 2, SZ_WD = (size_t)2048 * 5632 * 2;
constexpr size_t SZ_W1 = (size_t)1280 * 2048 * 2, SZ_WUQ = (size_t)3072 * 512 * 2, SZ_WUKV = (size_t)4096 * 512 * 2, SZ_WO = (size_t)2048 * 2048 * 2;
constexpr size_t SZ_WIN = (size_t)6144 * 2048 * 2, SZ_W3 = (size_t)8192 * 256 * 2;
constexpr size_t SZ_DFTC = (size_t)512 * 256 * 2, SZ_DML = (size_t)4096 * 8192 * 2, SZ_DMC = (size_t)256 * 512 * 2;
constexpr size_t SZ_ROWS = (size_t)NTOK * D * 2;
constexpr size_t WS_CTL = 0, CTL_ZERO_BYTES = 1u << 20;
constexpr size_t WS_MOD = WS_CTL + CTL_ZERO_BYTES;
constexpr size_t WS_ROPE = WS_MOD + al256((size_t)4 * 3 * 12288 * 4);
constexpr size_t WS_HF2 = WS_ROPE + al256((size_t)4096 * 32 * 8);
constexpr size_t WS_WGU = WS_HF2 + al256((size_t)FILT_LD * 256 * 2);
constexpr size_t WS_WD = WS_WGU + 4 * SZ_WGU;
constexpr size_t WS_W1 = WS_WD + 4 * SZ_WD;
constexpr size_t WS_WUQ = WS_W1 + 2 * SZ_W1;
constexpr size_t WS_WUKV = WS_WUQ + 2 * SZ_WUQ;
constexpr size_t WS_WO = WS_WUKV + 2 * SZ_WUKV;
constexpr size_t WS_WIN = WS_WO + 4 * SZ_WO;
constexpr size_t WS_W3 = WS_WIN + SZ_WIN;
constexpr size_t WS_DFTC = WS_W3 + SZ_W3;
constexpr size_t WS_DML = WS_DFTC + SZ_DFTC;
constexpr size_t WS_DMC = WS_DML + SZ_DML;
constexpr size_t WS_H = WS_DMC + al256(SZ_DMC);
constexpr size_t WS_U = WS_H + SZ_ROWS;
constexpr size_t WS_PART = WS_U + SZ_ROWS;
constexpr size_t WS_ACT = WS_PART + (size_t)2 * NTOK * D * 4;
constexpr size_t WS_CKVN = WS_ACT + (size_t)NTOK * DFF * 2;
constexpr size_t WS_KR = WS_CKVN + 2 * (size_t)NKV * 512 * 2;
constexpr size_t WS_MIXO = WS_KR + 2 * al256((size_t)NKV * 64 * 2);
constexpr size_t WS_FILT = WS_MIXO + SZ_ROWS;
constexpr size_t WS_X = WS_FILT + (size_t)8192 * FILT_LD * 2;
constexpr size_t WS_T1 = WS_X;
constexpr size_t WS_QL = WS_T1 + (size_t)NTOK * 1280 * 4;
constexpr size_t WS_Q = WS_QL + (size_t)NTOK * 512 * 2;
constexpr size_t WS_KV = WS_Q + (size_t)NTOK * 3072 * 2;
constexpr size_t WS_XEND_MLA = WS_KV + (size_t)NKV * 4096 * 2;
constexpr size_t WS_PT = WS_X;
constexpr size_t WS_ZT = WS_PT + (size_t)6144 * NTOK * 2;
constexpr size_t WS_XEND_HY = WS_ZT + (size_t)2048 * NTOK * 2;
constexpr size_t WS_ATC = WS_X;
constexpr size_t WS_ATL = WS_ATC + (size_t)16 * 2048 * 512 * 2;
constexpr size_t WS_XEND_FN = WS_ATL + (size_t)2 * 2048 * 8192 * 2;
constexpr size_t cmax(size_t a, size_t b) { return a > b ? a : b; }
constexpr size_t WS_END = cmax(WS_XEND_MLA, cmax(WS_XEND_HY, WS_XEND_FN));
static_assert(WS_END <= (size_t)1610612736, "d_ws map exceeds 4 x largest tensor");

constexpr int RING_OFF = 0, RING_BYTES = 131072;
constexpr int LDSCTL_OFF = RING_BYTES, MISC_OFF = LDSCTL_OFF + 320;
constexpr int LDS_BYTES = 147456;
static_assert(MISC_OFF + 128 <= LDS_BYTES, "LDS map");

__device__ __forceinline__ unsigned f2bf(float f) { unsigned u = __builtin_bit_cast(unsigned, f); return (u + 0x7fffu + ((u >> 16) & 1u)) >> 16; }
__device__ __forceinline__ unsigned pk2(float lo, float hi) { return f2bf(lo) | (f2bf(hi) << 16); }
__device__ __forceinline__ float bf2f(unsigned short b) { return __builtin_bit_cast(float, ((unsigned)b) << 16); }
__device__ __forceinline__ float bflo(unsigned w) { return __builtin_bit_cast(float, w << 16); }
__device__ __forceinline__ float bfhi(unsigned w) { return __builtin_bit_cast(float, w & 0xffff0000u); }
#define LDS_WAIT() asm volatile("s_waitcnt lgkmcnt(0)" ::: "memory")
#define VM_WAIT() asm volatile("s_waitcnt vmcnt(0)" ::: "memory")
__device__ __forceinline__ float wave_sum(float v) {
#pragma unroll
    for (int o = 1; o < 64; o <<= 1) v += __shfl_xor(v, o);
    return v;
}

namespace pg8 {
typedef short bf16x8 __attribute__((ext_vector_type(8)));
typedef float f32x4 __attribute__((ext_vector_type(4)));
typedef float f32x2 __attribute__((ext_vector_type(2)));
typedef unsigned u32x4 __attribute__((ext_vector_type(4)));
constexpr int BM = 256, BK = 64, HALF = 128, HTB = HALF * BK * 2  , STAGE_BYTES = 8 * HTB, NXCD = 8, WGM = 8;

__host__ __device__ __forceinline__ int lds_byte(int r, int c) { const int st = (r >> 4) * 2 + (c >> 5), rr = r & 15, cc = c & 31, ob = rr * 64 + cc * 2; return st * 1024 + (ob ^ (((ob >> 9) & 1) << 5)); }
__host__ __device__ __forceinline__ void stage_rc(int b, int& R, int& C) { const int st = b / 1024, sb = b % 1024, swz = sb ^ (((sb >> 9) & 1) << 5); R = (st >> 1) * 16 + swz / 64; C = (st & 1) * 32 + (swz % 64) / 2; }
__host__ __device__ __forceinline__ int perm32(int rho) { const int n = rho >> 4, i = rho & 15; return 8 * (i >> 2) + 4 * n + (i & 3); }

struct Unit { const char* A; const char* B; char* O; int ldc; int pm, pn, aux; };

__device__ __forceinline__ void tile_of(int L, int nM, int nN, int& pm, int& pn) {
    const int nwg = nM * nN; int wgid = L; { const int q = nwg / NXCD, r = nwg % NXCD, xcd = wgid % NXCD, off = wgid / NXCD; wgid = (xcd < r ? xcd * (q + 1) : r * (q + 1) + (xcd - r) * q) + off; }
    const int nig = WGM * nN, gid = wgid / nig, fm = gid * WGM, gsz = (nM - fm) < WGM ? (nM - fm) : WGM;
    pm = fm + ((wgid % nig) % gsz); pn = (wgid % nig) / gsz;
}

__device__ __forceinline__ unsigned cvt_pk_bf16(float lo, float hi) { unsigned r; asm volatile("v_cvt_pk_bf16_f32 %0, %1, %2" : "=v"(r) : "v"(lo), "v"(hi)); return r; }

struct EpiF32 {
    static constexpr bool PERM = false;
    __device__ __forceinline__ void operator()(const f32x4 (&acc)[2][2][4][2], const Unit& u, int wr, int wc, int fr, int fq) const {
        const int row0 = wr * 64 + fr, col0 = wc * 32 + 4 * fq; float* O = (float*)u.O;
#pragma unroll
        for (int ai = 0; ai < 2; ++ai)
#pragma unroll
            for (int m = 0; m < 4; ++m) { float* rowp = O + (size_t)(row0 + ai * HALF + m * 16) * u.ldc + col0;
#pragma unroll
                for (int bj = 0; bj < 2; ++bj)
#pragma unroll
                    for (int n = 0; n < 2; ++n) *(f32x4*)(rowp + bj * HALF + n * 16) = acc[ai][bj][m][n]; }
    }
};
template <int BIAS  > struct EpiBf16 {
    static constexpr bool PERM = true;
    const float* bias;
    __device__ __forceinline__ void operator()(const f32x4 (&acc)[2][2][4][2], const Unit& u, int wr, int wc, int fr, int fq) const {
        const int row0 = wr * 64 + fr, col0 = wc * 32 + 8 * fq; bf16_t* O = (bf16_t*)u.O;
#pragma unroll
        for (int ai = 0; ai < 2; ++ai)
#pragma unroll
            for (int m = 0; m < 4; ++m) { const int r = row0 + ai * HALF + m * 16; bf16_t* rowp = O + (size_t)r * u.ldc + col0; const float b = BIAS == 1 ? bias[u.pm * BM + r] : 0.f;
#pragma unroll
                for (int bj = 0; bj < 2; ++bj) { const f32x4 v0 = acc[ai][bj][m][0] + b, v1 = acc[ai][bj][m][1] + b;
                    u32x4 w; w.x = cvt_pk_bf16(v0[0], v0[1]); w.y = cvt_pk_bf16(v0[2], v0[3]); w.z = cvt_pk_bf16(v1[0], v1[1]); w.w = cvt_pk_bf16(v1[2], v1[3]);
                    *(u32x4*)(rowp + bj * HALF) = w; } }
    }
};
struct EpiSwiglu {
    static constexpr bool PERM = true;
    __device__ __forceinline__ void operator()(const f32x4 (&acc)[2][2][4][2], const Unit& u, int wr, int wc, int fr, int fq) const {
        const int row0 = wr * 64 + fr, col0 = wc * 32 + 8 * fq; bf16_t* O = (bf16_t*)u.O;
#pragma unroll
        for (int ai = 0; ai < 2; ++ai)
#pragma unroll
            for (int m = 0; m < 4; ++m) { bf16_t* rowp = O + (size_t)(row0 + ai * HALF + m * 16) * u.ldc + col0; float v[8];
#pragma unroll
                for (int n = 0; n < 2; ++n)
#pragma unroll
                    for (int j = 0; j < 4; ++j) { const float g = acc[ai][0][m][n][j], up = acc[ai][1][m][n][j]; v[n * 4 + j] = g * __builtin_amdgcn_rcpf(1.0f + __expf(-g)) * up; }
                u32x4 w; w.x = cvt_pk_bf16(v[0], v[1]); w.y = cvt_pk_bf16(v[2], v[3]); w.z = cvt_pk_bf16(v[4], v[5]); w.w = cvt_pk_bf16(v[6], v[7]);
                *(u32x4*)rowp = w; }
    }
};
struct EpiQKV {
    static constexpr bool PERM = true;
    const f32x2* rope; float qscale;
    __device__ __forceinline__ void operator()(const f32x4 (&acc)[2][2][4][2], const Unit& u, int wr, int wc, int fr, int fq) const {
        const int row0 = wr * 64 + fr, col0 = wc * 32 + 8 * fq; bf16_t* O = (bf16_t*)u.O;
        const bool isq = (u.aux == 0); const float sc = isq ? qscale : 1.0f; const bool lat = isq && (u.pm >= 16);
        int pr[2]; bool rp[2];
#pragma unroll
        for (int bj = 0; bj < 2; ++bj) { const int c8 = u.pn * BM + bj * HALF + col0, d = c8 % 192; rp[bj] = lat && d >= 128; pr[bj] = (d - 128) >> 1; }
#pragma unroll
        for (int ai = 0; ai < 2; ++ai)
#pragma unroll
            for (int m = 0; m < 4; ++m) { const int r = row0 + ai * HALF + m * 16; bf16_t* rowp = O + (size_t)r * u.ldc + col0; const int t = (u.pm * BM + r) & 4095;
#pragma unroll
                for (int bj = 0; bj < 2; ++bj) { f32x4 v0 = acc[ai][bj][m][0] * sc, v1 = acc[ai][bj][m][1] * sc;
                    if (rp[bj]) { const f32x4* cs = (const f32x4*)(rope + (size_t)t * 32 + pr[bj]); const f32x4 c01 = cs[0], c23 = cs[1];
                        f32x4 a, b; a[0] = v0[0] * c01[0] - v0[1] * c01[1]; a[1] = v0[0] * c01[1] + v0[1] * c01[0]; a[2] = v0[2] * c01[2] - v0[3] * c01[3]; a[3] = v0[2] * c01[3] + v0[3] * c01[2];
                        b[0] = v1[0] * c23[0] - v1[1] * c23[1]; b[1] = v1[0] * c23[1] + v1[1] * c23[0]; b[2] = v1[2] * c23[2] - v1[3] * c23[3]; b[3] = v1[2] * c23[3] + v1[3] * c23[2]; v0 = a; v1 = b; }
                    u32x4 w; w.x = cvt_pk_bf16(v0[0], v0[1]); w.y = cvt_pk_bf16(v0[2], v0[3]); w.z = cvt_pk_bf16(v1[0], v1[1]); w.w = cvt_pk_bf16(v1[2], v1[3]);
                    *(u32x4*)(rowp + bj * HALF) = w; } }
    }
};

template <class Epi, class Sched, bool ALIGN_EPI = false, bool SP2 = false>
__device__ __forceinline__ void gemm_phase(LAS unsigned char* lds, const int K, const int lda, const int ldb, const Sched& S, const Epi& E) {
    const int tid = threadIdx.x, wid = __builtin_amdgcn_readfirstlane(tid >> 6), lane = tid & 63, wr = wid >> 2, wc = wid & 3, fr = lane & 15, fq = lane >> 4;
    const int nt = K / BK;
    unsigned voffA[2], voffB[2];
#pragma unroll
    for (int i = 0; i < 2; ++i) { int R, C; stage_rc(tid * 16 + i * 8192, R, C); const int Rb = Epi::PERM ? ((R & ~31) + perm32(R & 31)) : R;
        voffA[i] = (unsigned)(R * lda + C) * 2u; voffB[i] = (unsigned)(Rb * ldb + C) * 2u; }
    const size_t kstep = (size_t)(BK * 2);
    const size_t hstepA = (size_t)HALF * lda * 2, hstepB = (size_t)HALF * ldb * 2;
    const unsigned ldsw = (unsigned)wid * 1024u;
    const int aoff = lds_byte(wr * 64 + fr, fq * 8), boff = lds_byte(wc * 32 + fr, fq * 8);
#define PG8_SA(b, h) (((b) * 2 + (h)) * HTB)
#define PG8_SB(b, h) ((4 + (b) * 2 + (h)) * HTB)
#define PG8_STAGE(bufoff, gbase, voff) do { _Pragma("unroll") for (int _i = 0; _i < 2; ++_i) \
        __builtin_amdgcn_global_load_lds((const unsigned*)((const char*)(gbase) + (voff)[_i]), (LAS unsigned*)(lds + (bufoff) + ldsw + _i * 8192), 16, 0, 0); } while (0)
#define PG8_LDA(dst, b, h) do { _Pragma("unroll") for (int m = 0; m < 4; ++m) _Pragma("unroll") for (int k = 0; k < 2; ++k) dst[m][k] = *(const LAS bf16x8*)(lds + PG8_SA(b, h) + aoff + m * 2048 + k * 1024); } while (0)
#define PG8_LDB(dst, b, h) do { _Pragma("unroll") for (int n = 0; n < 2; ++n) _Pragma("unroll") for (int k = 0; k < 2; ++k) dst[n][k] = *(const LAS bf16x8*)(lds + PG8_SB(b, h) + boff + n * 2048 + k * 1024); } while (0)
#define PG8_MMA(ai, bj, At, Bt) do { __builtin_amdgcn_s_setprio(1); _Pragma("unroll") for (int m = 0; m < 4; ++m) _Pragma("unroll") for (int n = 0; n < 2; ++n) _Pragma("unroll") for (int k = 0; k < 2; ++k) \
        acc[ai][bj][m][n] = __builtin_amdgcn_mfma_f32_16x16x32_bf16(Bt[n][k], At[m][k], acc[ai][bj][m][n], 0, 0, 0); __builtin_amdgcn_s_setprio(0); } while (0)
#define PG8_WAIT_V(n) asm volatile("s_waitcnt vmcnt(" #n ")" ::: "memory")
#define PG8_WAIT_L(n) asm volatile("s_waitcnt lgkmcnt(" #n ")" ::: "memory")
#define PG8_BAR __builtin_amdgcn_s_barrier()
#define PG8_SCHED __builtin_amdgcn_sched_barrier(0)
    Unit cur, nxt; int ui = 0;
    if (!S.next(0, cur)) return;
    f32x4 acc[2][2][4][2];
#pragma unroll
    for (int a = 0; a < 2; ++a)
#pragma unroll
        for (int b = 0; b < 2; ++b)
#pragma unroll
            for (int m = 0; m < 4; ++m)
#pragma unroll
                for (int n = 0; n < 2; ++n) acc[a][b][m][n] = (f32x4){0.f, 0.f, 0.f, 0.f};
    bf16x8 At[4][2], B0[2][2], B1[2][2];
    const char* cA = cur.A; const char* cB = cur.B;
    if constexpr (SP2) {
        PG8_STAGE(PG8_SB(0, 0), cB, voffB); PG8_STAGE(PG8_SB(0, 1), cB + hstepB, voffB); PG8_STAGE(PG8_SA(0, 0), cA, voffA); PG8_STAGE(PG8_SA(0, 1), cA + hstepA, voffA);
        if (wr == 1) PG8_BAR;
        PG8_WAIT_V(2); PG8_BAR;
        PG8_STAGE(PG8_SB(1, 0), cB + kstep, voffB); PG8_STAGE(PG8_SA(1, 0), cA + kstep, voffA); PG8_STAGE(PG8_SB(1, 1), cB + hstepB + kstep, voffB);
        PG8_WAIT_V(6); PG8_BAR;
    } else {
        PG8_STAGE(PG8_SB(0, 0), cB, voffB); PG8_STAGE(PG8_SA(0, 0), cA, voffA); PG8_STAGE(PG8_SB(0, 1), cB + hstepB, voffB); PG8_STAGE(PG8_SA(0, 1), cA + hstepA, voffA);
        if (wr == 1) PG8_BAR;
        PG8_WAIT_V(4); PG8_BAR;
        PG8_STAGE(PG8_SB(1, 0), cB + kstep, voffB); PG8_STAGE(PG8_SA(1, 0), cA + kstep, voffA); PG8_STAGE(PG8_SB(1, 1), cB + hstepB + kstep, voffB);
        PG8_WAIT_V(6); PG8_BAR;
    }
    for (;;) {
        const bool has_next = S.next(ui + 1, nxt);
        const char* nA = has_next ? nxt.A : cA; const char* nB = has_next ? nxt.B : cB;
        for (int t = 0; t < nt; t += 2) {
            const bool last = (t == nt - 2);
            const char* a1 = cA + (size_t)(t + 1) * kstep;
            const char* a2 = last ? nA : cA + (size_t)(t + 2) * kstep; const char* b2 = last ? nB : cB + (size_t)(t + 2) * kstep;
            const char* a3 = a2 + kstep; const char* b3 = b2 + kstep;
            if constexpr (SP2) {
            PG8_LDB(B0, 0, 0); PG8_LDB(B1, 0, 1); PG8_SCHED; PG8_LDA(At, 0, 0); PG8_STAGE(PG8_SA(1, 1), a1 + hstepA, voffA);
            PG8_WAIT_V(8); PG8_WAIT_L(0); PG8_BAR; PG8_MMA(0, 0, At, B0); PG8_MMA(0, 1, At, B1); PG8_BAR; PG8_SCHED;
            PG8_LDA(At, 0, 1); PG8_STAGE(PG8_SB(0, 0), b2, voffB); PG8_STAGE(PG8_SB(0, 1), b2 + hstepB, voffB); PG8_STAGE(PG8_SA(0, 0), a2, voffA);
            PG8_WAIT_V(8); PG8_WAIT_L(0); PG8_BAR; PG8_MMA(1, 0, At, B0); PG8_MMA(1, 1, At, B1); PG8_BAR; PG8_SCHED;
            PG8_LDB(B0, 1, 0); PG8_LDB(B1, 1, 1); PG8_SCHED; PG8_LDA(At, 1, 0); PG8_STAGE(PG8_SA(0, 1), a2 + hstepA, voffA);
            PG8_WAIT_V(8); PG8_WAIT_L(0); PG8_BAR; PG8_MMA(0, 0, At, B0); PG8_MMA(0, 1, At, B1); PG8_BAR; PG8_SCHED;
            PG8_LDA(At, 1, 1); PG8_STAGE(PG8_SB(1, 0), b3, voffB); PG8_STAGE(PG8_SB(1, 1), b3 + hstepB, voffB); PG8_STAGE(PG8_SA(1, 0), a3, voffA);
            PG8_WAIT_V(8); PG8_WAIT_L(0); PG8_BAR; PG8_MMA(1, 0, At, B0); PG8_MMA(1, 1, At, B1); PG8_BAR; PG8_SCHED;
            } else {
            PG8_LDB(B0, 0, 0); PG8_SCHED; PG8_LDA(At, 0, 0); PG8_STAGE(PG8_SA(1, 1), a1 + hstepA, voffA);
            PG8_WAIT_L(8); PG8_BAR; PG8_WAIT_L(0); PG8_MMA(0, 0, At, B0); PG8_BAR; PG8_SCHED;
            PG8_LDB(B1, 0, 1); PG8_STAGE(PG8_SB(0, 0), b2, voffB);
            PG8_BAR; PG8_WAIT_L(0); PG8_MMA(0, 1, At, B1); PG8_BAR;
            PG8_LDA(At, 0, 1); PG8_STAGE(PG8_SA(0, 0), a2, voffA);
            PG8_BAR; PG8_WAIT_L(0); PG8_MMA(1, 0, At, B0); PG8_BAR; PG8_SCHED;
            PG8_STAGE(PG8_SB(0, 1), b2 + hstepB, voffB);
            PG8_WAIT_V(6); PG8_BAR; PG8_MMA(1, 1, At, B1); PG8_BAR;
            PG8_LDB(B0, 1, 0); PG8_SCHED; PG8_LDA(At, 1, 0); PG8_STAGE(PG8_SA(0, 1), a2 + hstepA, voffA);
            PG8_WAIT_L(8); PG8_BAR; PG8_WAIT_L(0); PG8_MMA(0, 0, At, B0); PG8_BAR; PG8_SCHED;
            PG8_LDB(B1, 1, 1); PG8_STAGE(PG8_SB(1, 0), b3, voffB);
            PG8_BAR; PG8_WAIT_L(0); PG8_MMA(0, 1, At, B1); PG8_BAR;
            PG8_LDA(At, 1, 1); PG8_STAGE(PG8_SA(1, 0), a3, voffA);
            PG8_BAR; PG8_WAIT_L(0); PG8_MMA(1, 0, At, B0); PG8_BAR; PG8_SCHED;
            PG8_STAGE(PG8_SB(1, 1), b3 + hstepB, voffB);
            PG8_WAIT_V(6); PG8_BAR; PG8_MMA(1, 1, At, B1); PG8_BAR;
            }
        }
        if constexpr (ALIGN_EPI) { if (wr == 0) PG8_BAR; }
        E(acc, cur, wr, wc, fr, fq);
        if (!has_next) break;
#pragma unroll
        for (int a = 0; a < 2; ++a)
#pragma unroll
            for (int b = 0; b < 2; ++b)
#pragma unroll
                for (int m = 0; m < 4; ++m)
#pragma unroll
                    for (int n = 0; n < 2; ++n) acc[a][b][m][n] = (f32x4){0.f, 0.f, 0.f, 0.f};
        cur = nxt; cA = nA; cB = nB; ++ui;
        if constexpr (ALIGN_EPI) { if (wr == 1) PG8_BAR; }
    }
    PG8_WAIT_V(0);
    if constexpr (!ALIGN_EPI) { if (wr == 0) PG8_BAR; }
    PG8_BAR;
#undef PG8_SA
#undef PG8_SB
#undef PG8_STAGE
#undef PG8_LDA
#undef PG8_LDB
#undef PG8_MMA
#undef PG8_WAIT_V
#undef PG8_WAIT_L
#undef PG8_BAR
#undef PG8_SCHED
}
}

#define XB_TMO      128
#define XB_XCNT(j)  (256  + 64 * (j))
#define XB_XSUB(j)  (1280 + 64 * (j))
#define XB_XGEN(j)  (2304 + 64 * (j))
#define XB_TOP      3328
#define XB_TOPGEN   3392
#define XCD_BAR_WORDS 3456
#define XB_SPIN_CAP (1u << 24)

__device__ __forceinline__ unsigned xb_ld(unsigned* p)              { return __hip_atomic_load(p, __ATOMIC_RELAXED, __HIP_MEMORY_SCOPE_AGENT); }
__device__ __forceinline__ unsigned xb_add(unsigned* p, unsigned v) { return __hip_atomic_fetch_add(p, v, __ATOMIC_RELAXED, __HIP_MEMORY_SCOPE_AGENT); }
__device__ __forceinline__ unsigned xb_xcc_id() { return (unsigned)__builtin_amdgcn_s_getreg((3 << 11) | 20) & 0xFu; }
#define XB_SPIN(cond, bar) do { unsigned _sp = 0; while (cond) { __builtin_amdgcn_s_sleep(1); \
    if ((++_sp & 255u) == 0u) { if (xb_ld(&(bar)[XB_TMO])) break; if (_sp > XB_SPIN_CAP) { atomicAdd(&(bar)[XB_TMO], 1u); break; } } } } while (0)

struct XcdBarrier {
    unsigned* bar; unsigned x;
    volatile LAS unsigned* st;
};
__device__ __forceinline__ XcdBarrier xcd_barrier_post(unsigned* bar, volatile LAS unsigned* st) {
    XcdBarrier b; b.bar = bar; b.x = xb_xcc_id(); b.st = st;
    if (threadIdx.x == 0) (void)xb_add(&bar[XB_XCNT(b.x)], 1u);
    return b;
}
__device__ __forceinline__ void xcd_barrier_complete(unsigned* bar, unsigned x, unsigned& nloc, unsigned& nx) {
    const unsigned G = gridDim.x * gridDim.y * gridDim.z;
    unsigned sum, cnt, mine, sp = 0u;
    for (;;) {
        sum = 0u; cnt = 0u; mine = 0u;
#pragma unroll
        for (unsigned j = 0; j < 16; ++j) { const unsigned c = xb_ld(&bar[XB_XCNT(j)]); sum += c; cnt += (c > 0u) ? 1u : 0u; mine = (j == x) ? c : mine; }
        if (sum == G) break;
        __builtin_amdgcn_s_sleep(1);
        if ((++sp & 255u) == 0u) { if (xb_ld(&bar[XB_TMO])) break; if (sp > XB_SPIN_CAP) { atomicAdd(&bar[XB_TMO], 1u); break; } }
    }
    nloc = mine > 0u ? mine : 1u; nx = cnt > 0u ? cnt : 1u;
}
__device__ __forceinline__ void xcd_barrier(const XcdBarrier& b) {
    asm volatile("s_waitcnt vmcnt(0)" ::: "memory");
    __syncthreads();
    if (threadIdx.x == 0) {
        unsigned* bar = b.bar;
        __builtin_amdgcn_s_waitcnt(0);
        unsigned nloc = b.st[0], nx = b.st[1];
        if (nloc == 0u) { xcd_barrier_complete(bar, b.x, nloc, nx); b.st[0] = nloc; b.st[1] = nx; }
        const unsigned old = xb_add(&bar[XB_XSUB(b.x)], 1u);
        const unsigned gen = old / nloc;
        if (old + 1u == (gen + 1u) * nloc) {
            __builtin_amdgcn_fence(__ATOMIC_RELEASE, "agent");
            asm volatile("s_waitcnt vmcnt(0)" ::: "memory");
            const unsigned og = xb_add(&bar[XB_TOP], 1u);
            const unsigned tg = og / nx;
            if (og + 1u == (tg + 1u) * nx) xb_add(&bar[XB_TOPGEN], 1u);
            else XB_SPIN(xb_ld(&bar[XB_TOPGEN]) == tg, bar);
            __builtin_amdgcn_fence(__ATOMIC_ACQUIRE, "agent");
            xb_add(&bar[XB_XGEN(b.x)], 1u);
            asm volatile("s_waitcnt vmcnt(0)" ::: "memory");
        } else {
            XB_SPIN(xb_ld(&bar[XB_XGEN(b.x)]) == gen, bar);
            __builtin_amdgcn_fence(__ATOMIC_ACQUIRE, "agent");
            asm volatile("s_waitcnt vmcnt(0)" ::: "memory");
        }
    }
    __syncthreads();
}

struct XDesc { int in_idx; long long src_off; int K, N; long long dst; int ldt; int mode; int row_off; };
constexpr int NXD = 28;
__constant__ XDesc c_xd[NXD] = {
    {10, 0LL * 2048 * 5632, 2048, 5632, (long long)(WS_WGU + 0 * SZ_WGU), 2048, 1, 0}, {11, 0LL * 2048 * 5632, 2048, 5632, (long long)(WS_WGU + 0 * SZ_WGU), 2048, 2, 0}, {12, 0LL * 5632 * 2048, 5632, 2048, (long long)(WS_WD + 0 * SZ_WD), 5632, 0, 0},
    {10, 1LL * 2048 * 5632, 2048, 5632, (long long)(WS_WGU + 1 * SZ_WGU), 2048, 1, 0}, {11, 1LL * 2048 * 5632, 2048, 5632, (long long)(WS_WGU + 1 * SZ_WGU), 2048, 2, 0}, {12, 1LL * 5632 * 2048, 5632, 2048, (long long)(WS_WD + 1 * SZ_WD), 5632, 0, 0},
    {10, 2LL * 2048 * 5632, 2048, 5632, (long long)(WS_WGU + 2 * SZ_WGU), 2048, 1, 0}, {11, 2LL * 2048 * 5632, 2048, 5632, (long long)(WS_WGU + 2 * SZ_WGU), 2048, 2, 0}, {12, 2LL * 5632 * 2048, 5632, 2048, (long long)(WS_WD + 2 * SZ_WD), 5632, 0, 0},
    {10, 3LL * 2048 * 5632, 2048, 5632, (long long)(WS_WGU + 3 * SZ_WGU), 2048, 1, 0}, {11, 3LL * 2048 * 5632, 2048, 5632, (long long)(WS_WGU + 3 * SZ_WGU), 2048, 2, 0}, {12, 3LL * 5632 * 2048, 5632, 2048, (long long)(WS_WD + 3 * SZ_WD), 5632, 0, 0},
    {13, 0LL * 2048 * 512, 2048, 512, (long long)(WS_W1 + 0 * SZ_W1), 2048, 0, 0}, {16, 0LL * 2048 * 512, 2048, 512, (long long)(WS_W1 + 0 * SZ_W1), 2048, 0, 512}, {18, 0LL * 2048 * 64, 2048, 64, (long long)(WS_W1 + 0 * SZ_W1), 2048, 0, 1024},
    {15, 0LL * 512 * 3072, 512, 3072, (long long)(WS_WUQ + 0 * SZ_WUQ), 512, 0, 0}, {19, 0LL * 512 * 4096, 512, 4096, (long long)(WS_WUKV + 0 * SZ_WUKV), 512, 0, 0}, {20, 0LL * 2048 * 2048, 2048, 2048, (long long)(WS_WO + 0 * SZ_WO), 2048, 0, 0},
    {13, 1LL * 2048 * 512, 2048, 512, (long long)(WS_W1 + 1 * SZ_W1), 2048, 0, 0}, {16, 1LL * 2048 * 512, 2048, 512, (long long)(WS_W1 + 1 * SZ_W1), 2048, 0, 512}, {18, 1LL * 2048 * 64, 2048, 64, (long long)(WS_W1 + 1 * SZ_W1), 2048, 0, 1024},
    {15, 1LL * 512 * 3072, 512, 3072, (long long)(WS_WUQ + 1 * SZ_WUQ), 512, 0, 0}, {19, 1LL * 512 * 4096, 512, 4096, (long long)(WS_WUKV + 1 * SZ_WUKV), 512, 0, 0}, {20, 1LL * 2048 * 2048, 2048, 2048, (long long)(WS_WO + 3 * SZ_WO), 2048, 0, 0},
    {21, 0, 2048, 6144, (long long)WS_WIN, 2048, 0, 0}, {34, 0, 2048, 2048, (long long)(WS_WO + 1 * SZ_WO), 2048, 0, 0}, {31, 0, 64, 8192, (long long)WS_W3, 256, 0, 0},
    {36, 0, 2048, 2048, (long long)(WS_WO + 2 * SZ_WO), 2048, 0, 0},
};
__device__ __forceinline__ void transpose_item(const float* W, int ldw, bf16_t* WT, int ldt, int k0, int n0, int drow0, LAS float* scr, int lane) {
#pragma unroll 8
    for (int i = 0; i < 32; ++i) { const int kk = 2 * i + (lane >> 5); scr[kk * 33 + (lane & 31)] = W[(size_t)(k0 + kk) * ldw + n0 + (lane & 31)]; }
    LDS_WAIT(); asm volatile("" ::: "memory");
    const int c = lane & 7;
#pragma unroll
    for (int j = 0; j < 4; ++j) { const int n = (lane >> 3) + 8 * j; const LAS float* s = scr + (8 * c) * 33 + n;
        v4u o; o.x = pk2(s[0 * 33], s[1 * 33]); o.y = pk2(s[2 * 33], s[3 * 33]); o.z = pk2(s[4 * 33], s[5 * 33]); o.w = pk2(s[6 * 33], s[7 * 33]);
        *(GAS v4u*)(WT + (size_t)(drow0 + n) * ldt + k0 + 8 * c) = o; }
    LDS_WAIT(); asm volatile("" ::: "memory");
}

struct Args { const float* in[38]; float* out; unsigned char* ws; int ph_lo, ph_hi, li, pad; };
enum { I_XP = 0, I_XS, I_C, I_CCKV, I_CKR, I_CCTX, I_ADAW, I_ADAB, I_LNG, I_LNB, I_FG, I_FU, I_FD, I_DQ, I_QN, I_UQ, I_DKV, I_KVN, I_WKR, I_UKV, I_WOM,
       I_HWIN, I_HBIN, I_HCW, I_HCB, I_HW1, I_HB1, I_HFR1, I_HW2, I_HB2, I_HFR2, I_HW3, I_HDEC, I_HSKIP, I_HWOUT, I_HBOUT, I_FNW, I_FNB };
constexpr size_t OUT_CKV = (size_t)NTOK * D, OUT_KR = OUT_CKV + (size_t)16 * 2 * 256 * 512;

__device__ __forceinline__ int group_of_row(int row) { return row < NCTX ? 0 : (row < NCTX + 4096 ? 1 : 2); }
__device__ __forceinline__ int kvrow_of_row(int row) { return row < NCTX ? row : (row < NCTX + 4096 ? row : row + 512); }

__device__ __forceinline__ void p0_prologue(const Args& a, LAS unsigned char* lds, int tid, int lane, int wave, int vcu, int G) {
    unsigned char* ws = a.ws;
    const int gw = vcu * NWAVES + wave, NGW = G * NWAVES; const size_t gt = (size_t)vcu * NTHREADS + tid, NGT = (size_t)G * NTHREADS;
    { LAS float* scr = (LAS float*)(lds + wave * 16384);
      for (int d = 0; d < NXD; ++d) {
        const XDesc x = c_xd[d]; const float* W = a.in[x.in_idx] + x.src_off; bf16_t* WT = (bf16_t*)(ws + x.dst); const int nnb = x.N / 32, items = (x.K / 64) * nnb;
        for (int it = gw; it < items; it += NGW) { const int kb = it / nnb, nb = it - kb * nnb, n0 = 32 * nb;
            const int drow0 = x.mode == 0 ? x.row_off + n0 : ((n0 >> 7) * 256 + (n0 & 127) + (x.mode == 2 ? 128 : 0));
            transpose_item(W, x.N, WT, x.ldt, 64 * kb, n0, drow0, scr, lane); }
      } }
    { const v4u z = {0u, 0u, 0u, 0u};
      for (size_t i = gt; i < (size_t)2 * 192 * 256; i += NGT) { const int j = (int)(i / (192 * 256)); const size_t r = i % (192 * 256); *(GAS v4u*)(ws + WS_W1 + j * SZ_W1 + (size_t)1088 * 2048 * 2 + r * 16) = z; }
      for (size_t i = gt; i < (size_t)8192 * 24; i += NGT) { const size_t row = i / 24, ch = i % 24; *(GAS v4u*)(ws + WS_W3 + row * 512 + 128 + ch * 16) = z; } }
    { for (size_t i = gt; i < (size_t)512 * 32; i += NGT) { const int row = (int)(i >> 5), c8 = (int)(i & 31) * 8, part = row >> 8, m = row & 255; float v[8];
#pragma unroll
          for (int j = 0; j < 8; ++j) { const int r = (m * (c8 + j)) & 255; float s, c; sincospif((float)r * (1.0f / 128.0f), &s, &c); v[j] = part ? s : c; }
          v4u o; o.x = pk2(v[0], v[1]); o.y = pk2(v[2], v[3]); o.z = pk2(v[4], v[5]); o.w = pk2(v[6], v[7]); *(GAS v4u*)(ws + WS_DFTC + i * 16) = o; }
      for (size_t i = gt; i < (size_t)256 * 64; i += NGT) { const int k = (int)(i >> 6), c8 = (int)(i & 63) * 8; float v[8];
#pragma unroll
          for (int j = 0; j < 8; ++j) { const int col = c8 + j, l = col & 255, r = (k * l) & 255; float s, c; sincospif((float)r * (1.0f / 128.0f), &s, &c); v[j] = (col < 256 ? c : -s) * (1.0f / 256.0f); }
          v4u o; o.x = pk2(v[0], v[1]); o.y = pk2(v[2], v[3]); o.z = pk2(v[4], v[5]); o.w = pk2(v[6], v[7]); *(GAS v4u*)(ws + WS_DMC + i * 16) = o; }
      for (size_t i = gt; i < (size_t)4096 * 1024; i += NGT) { const int k = (int)(i >> 10), c8 = (int)(i & 1023) * 8; float v[8];
#pragma unroll
          for (int j = 0; j < 8; ++j) { const int col = c8 + j, l = col & 4095, r = (k * l) & 4095; float s, c; sincospif((float)r * (1.0f / 2048.0f), &s, &c); v[j] = (col < 4096 ? c : -s) * (1.0f / 1024.0f); }
          v4u o; o.x = pk2(v[0], v[1]); o.y = pk2(v[2], v[3]); o.z = pk2(v[4], v[5]); o.w = pk2(v[6], v[7]); *(GAS v4u*)(ws + WS_DML + i * 16) = o; } }
    { f32x2* rope = (f32x2*)(ws + WS_ROPE);
      for (size_t i = gt; i < (size_t)4096 * 32; i += NGT) { const int t = (int)(i >> 5), p = (int)(i & 31); const float inv = exp2f(-(float)(p & 15) * (13.287712379549449f / 16.0f));
          const float ang = (float)(p < 16 ? (t >> 6) : (t & 63)) * inv; float s, c; sincosf(ang, &s, &c); rope[i] = (f32x2){c, s}; } }
    { for (size_t i = gt; i < (size_t)2 * 2 * 512 * 64; i += NGT) { const int r8 = (int)(i & 63) * 8, p = (int)(i >> 6) & 511, lb = (int)(i >> 15) & 1, j = (int)(i >> 16);
          const float* s = a.in[I_CCKV] + ((size_t)(lb * 2 + j) * 512 + p) * 512 + r8; const f32x4 x0 = *(const f32x4*)s, x1 = *(const f32x4*)(s + 4);
          v4u o; o.x = pk2(x0[0], x0[1]); o.y = pk2(x0[2], x0[3]); o.z = pk2(x1[0], x1[1]); o.w = pk2(x1[2], x1[3]);
          *(GAS v4u*)(ws + WS_CKVN + (size_t)j * NKV * 512 * 2 + ((size_t)(4096 + lb * 4608 + 4096 + p) * 512 + r8) * 2) = o; }
      for (size_t i = gt; i < (size_t)2 * 2 * 512 * 8; i += NGT) { const int r8 = (int)(i & 7) * 8, p = (int)(i >> 3) & 511, lb = (int)(i >> 12) & 1, j = (int)(i >> 13);
          const float* s = a.in[I_CKR] + ((size_t)(lb * 2 + j) * 512 + p) * 64 + r8; const f32x4 x0 = *(const f32x4*)s, x1 = *(const f32x4*)(s + 4);
          v4u o; o.x = pk2(x0[0], x0[1]); o.y = pk2(x0[2], x0[3]); o.z = pk2(x1[0], x1[1]); o.w = pk2(x1[2], x1[3]);
          *(GAS v4u*)(ws + WS_KR + (size_t)j * al256((size_t)NKV * 64 * 2) + ((size_t)(4096 + lb * 4608 + 4096 + p) * 64 + r8) * 2) = o; } }
    { const float* w1 = a.in[I_HW1]; const float* w2 = a.in[I_HW2]; bf16_t* hf2 = (bf16_t*)(ws + WS_HF2);
      const float b1 = a.in[I_HB1][lane], fr1 = a.in[I_HFR1][lane], b2 = a.in[I_HB2][lane], fr2 = a.in[I_HFR2][lane];
      for (int pos = gw; pos < FILT_LD; pos += NGW) { const int L = pos < 4096 ? 4096 : 256, t = pos < 4096 ? pos : pos - 4096;
          float feat = 0.f;
          if (lane == 0) feat = (float)t / (float)(L - 1);
          else if (lane <= 32) { const int b = (lane - 1) & 15; const float band = 1e-4f + (float)b * ((15.0f - 1e-4f) / 15.0f); const float turns = (float)t * band / (float)L; float s, c; sincospif(2.0f * turns, &s, &c); feat = lane <= 16 ? c : -s; }
          float z = b1;
#pragma unroll
          for (int k = 0; k < 33; ++k) z += __shfl(feat, k) * w1[k * 64 + lane];
          const float h1 = sinf(fr1 * z); float z2 = b2;
#pragma unroll 8
          for (int k = 0; k < 64; ++k) z2 += __shfl(h1, k) * w2[k * 64 + lane];
          const float h2 = sinf(fr2 * z2);
          bf16_t* row = hf2 + (size_t)pos * 256; row[lane] = (bf16_t)f2bf(h2); row[64 + lane] = 0; row[128 + lane] = 0; row[192 + lane] = 0; } }
    __syncthreads();
    { LAS float* S = (LAS float*)lds; LAS float* red = (LAS float*)(lds + 24576); float* mod = (float*)(ws + WS_MOD);
      for (int i = tid; i < 3 * 2048; i += NTHREADS) { const int g = i >> 11, k = i & 2047; const float x = g == 0 ? a.in[I_CCTX][k] : a.in[I_C][(g - 1) * 2048 + k]; S[i] = x / (1.0f + __expf(-x)); }
      __syncthreads();
      const int q = tid & 15, kc = tid >> 4;
      for (int it = vcu; it < 768; it += G) { const int l = it / 192, n0 = (it % 192) * 64;
          const float* Wp = a.in[I_ADAW] + (size_t)l * 2048 * 12288 + (size_t)(kc * 64) * 12288 + n0 + 4 * q;
          f32x4 a0 = {0.f, 0.f, 0.f, 0.f}, a1 = a0, a2 = a0;
#pragma unroll 8
          for (int kk = 0; kk < 64; ++kk) { const f32x4 w = *(const f32x4*)(Wp + (size_t)kk * 12288); const int k = kc * 64 + kk; a0 += w * S[k]; a1 += w * S[2048 + k]; a2 += w * S[4096 + k]; }
#pragma unroll
          for (int j = 0; j < 4; ++j) { red[(kc * 3 + 0) * 64 + 4 * q + j] = a0[j]; red[(kc * 3 + 1) * 64 + 4 * q + j] = a1[j]; red[(kc * 3 + 2) * 64 + 4 * q + j] = a2[j]; }
          __syncthreads();
          if (tid < 192) { const int g = tid >> 6, col = tid & 63; float s = a.in[I_ADAB][l * 12288 + n0 + col];
#pragma unroll 8
              for (int k2 = 0; k2 < 32; ++k2) s += red[(k2 * 3 + g) * 64 + col];
              mod[(size_t)(l * 3 + g) * 12288 + n0 + col] = s; }
          __syncthreads(); } }
}

__device__ __forceinline__ void p1_embed(const Args& a, int lane, int wave, int vcu, int G) {
    unsigned char* ws = a.ws; const float* mod = (const float*)(ws + WS_MOD); bf16_t* H = (bf16_t*)(ws + WS_H); bf16_t* U = (bf16_t*)(ws + WS_U);
    for (int row = vcu * NWAVES + wave; row < NTOK; row += G * NWAVES) {
        const float* x = row < NCTX ? a.in[I_XP] + (size_t)row * D : a.in[I_XS] + (size_t)(row - NCTX) * D; const int g = group_of_row(row);
        const float* sh = mod + (size_t)(0 * 3 + g) * 12288 + 0 * 2048; const float* sc = sh + 2048;
#pragma unroll
        for (int j = 0; j < 4; ++j) { const int c = 512 * j + 8 * lane; float v[8], u[8];
#pragma unroll
            for (int h = 0; h < 2; ++h) { const f32x4 xv = *(const f32x4*)(x + c + 4 * h), s1 = *(const f32x4*)(sc + c + 4 * h), s0 = *(const f32x4*)(sh + c + 4 * h);
#pragma unroll
                for (int e = 0; e < 4; ++e) { v[4 * h + e] = xv[e]; u[4 * h + e] = xv[e] * (1.0f + s1[e]) + s0[e]; } }
            v4u o; o.x = pk2(v[0], v[1]); o.y = pk2(v[2], v[3]); o.z = pk2(v[4], v[5]); o.w = pk2(v[6], v[7]); *(GAS v4u*)(H + (size_t)row * D + c) = o;
            o.x = pk2(u[0], u[1]); o.y = pk2(u[2], u[3]); o.z = pk2(u[4], u[5]); o.w = pk2(u[6], u[7]); *(GAS v4u*)(U + (size_t)row * D + c) = o; }
    }
}

__device__ __forceinline__ void ln_phase(const Args& a, LAS unsigned char* lds, int tid, int lane, int wave, int vcu, int G, int l, int gi, int lni, const float* bias, int ln, int si, bool final) {
    unsigned char* ws = a.ws; const float* mod = (const float*)(ws + WS_MOD); bf16_t* H = (bf16_t*)(ws + WS_H); bf16_t* U = (bf16_t*)(ws + WS_U);
    const float* P0 = (const float*)(ws + WS_PART); const float* P1 = P0 + (size_t)NTOK * D;
    LAS float* V = (LAS float*)lds;
    for (int blk = vcu; blk < NTOK / 16; blk += G) {
        const int g = group_of_row(blk * 16);
        __syncthreads();
        for (int i = tid; i < 6 * 2048; i += NTHREADS) { const int v = i >> 11, c = i & 2047; float x;
            if (v == 0) x = mod[(size_t)(l * 3 + g) * 12288 + gi * 2048 + c]; else if (v == 1) x = bias ? bias[c] : 0.f; else if (v == 2) x = a.in[I_LNG][(l * 2 + lni) * 2048 + c];
            else if (v == 3) x = a.in[I_LNB][(l * 2 + lni) * 2048 + c]; else if (v == 4) x = final ? 0.f : mod[(size_t)(ln * 3 + g) * 12288 + si * 2048 + c]; else x = final ? 0.f : mod[(size_t)(ln * 3 + g) * 12288 + (si + 1) * 2048 + c];
            V[i] = x; }
        __syncthreads();
#pragma unroll 1
        for (int rr = 0; rr < 2; ++rr) { const int row = blk * 16 + wave * 2 + rr; float x[32]; float s = 0.f;
            v4u hv[4]; f32x4 pa[4][2], pb[4][2];
#pragma unroll
            for (int j = 0; j < 4; ++j) { const int c = 512 * j + 8 * lane; hv[j] = *(const GAS v4u*)(H + (size_t)row * D + c);
#pragma unroll
                for (int h = 0; h < 2; ++h) { pa[j][h] = *(const f32x4*)(P0 + (size_t)row * D + c + 4 * h); pb[j][h] = *(const f32x4*)(P1 + (size_t)row * D + c + 4 * h); } }
            asm volatile("" ::: "memory");
#pragma unroll
            for (int j = 0; j < 4; ++j) { const int c = 512 * j + 8 * lane; const unsigned hw[4] = {hv[j].x, hv[j].y, hv[j].z, hv[j].w};
#pragma unroll
                for (int h = 0; h < 2; ++h) { const f32x4 gt = *(const LAS f32x4*)(V + c + 4 * h), bs = *(const LAS f32x4*)(V + 2048 + c + 4 * h);
#pragma unroll
                    for (int e = 0; e < 4; ++e) { const float hh = (e & 1) ? bfhi(hw[2 * h + (e >> 1)]) : bflo(hw[2 * h + (e >> 1)]);
                        const float v = DN_ALPHA * hh + gt[e] * (pa[j][h][e] + pb[j][h][e] + bs[e]); x[8 * j + 4 * h + e] = v; s += v; } }
                asm volatile("" ::: "memory"); }
            const float mean = wave_sum(s) * (1.0f / D); float q = 0.f;
#pragma unroll
            for (int i = 0; i < 32; ++i) { x[i] -= mean; q += x[i] * x[i]; }
            const float rstd = 1.0f / sqrtf(wave_sum(q) * (1.0f / D) + LN_EPS);
#pragma unroll
            for (int j = 0; j < 4; ++j) { const int c = 512 * j + 8 * lane; float hn[8], u[8];
#pragma unroll
                for (int h = 0; h < 2; ++h) { const f32x4 lg = *(const LAS f32x4*)(V + 2 * 2048 + c + 4 * h), lb = *(const LAS f32x4*)(V + 3 * 2048 + c + 4 * h), sh = *(const LAS f32x4*)(V + 4 * 2048 + c + 4 * h), sc = *(const LAS f32x4*)(V + 5 * 2048 + c + 4 * h);
#pragma unroll
                    for (int e = 0; e < 4; ++e) { hn[4 * h + e] = x[8 * j + 4 * h + e] * rstd * lg[e] + lb[e]; u[4 * h + e] = hn[4 * h + e] * (1.0f + sc[e]) + sh[e]; } }
                if (final) { float* o = a.out + (size_t)row * D + c; *(f32x4*)o = (f32x4){hn[0], hn[1], hn[2], hn[3]}; *(f32x4*)(o + 4) = (f32x4){hn[4], hn[5], hn[6], hn[7]}; }
                else { v4u o; o.x = pk2(hn[0], hn[1]); o.y = pk2(hn[2], hn[3]); o.z = pk2(hn[4], hn[5]); o.w = pk2(hn[6], hn[7]); *(GAS v4u*)(H + (size_t)row * D + c) = o;
                    o.x = pk2(u[0], u[1]); o.y = pk2(u[2], u[3]); o.z = pk2(u[4], u[5]); o.w = pk2(u[6], u[7]); *(GAS v4u*)(U + (size_t)row * D + c) = o; }
                asm volatile("" ::: "memory"); }
        }
    }
    __syncthreads();
}

__device__ __forceinline__ void mla_norm_phase(const Args& a, int lane, int wave, int vcu, int G, int j) {
    unsigned char* ws = a.ws; const float* T1 = (const float*)(ws + WS_T1); bf16_t* QL = (bf16_t*)(ws + WS_QL);
    bf16_t* CK = (bf16_t*)(ws + WS_CKVN + (size_t)j * NKV * 512 * 2); bf16_t* KR = (bf16_t*)(ws + WS_KR + (size_t)j * al256((size_t)NKV * 64 * 2)); const f32x2* rope = (const f32x2*)(ws + WS_ROPE);
    const float* qn = a.in[I_QN] + j * 512 + 8 * lane; const float* kn = a.in[I_KVN] + j * 512 + 8 * lane;
    for (int row = vcu * NWAVES + wave; row < NTOK; row += G * NWAVES) {
        const float* t = T1 + (size_t)row * 1280; const int kvr = kvrow_of_row(row);
        float q[8], k[8]; float sq = 0.f, sk = 0.f;
        { const f32x4 a0 = *(const f32x4*)(t + 8 * lane), a1 = *(const f32x4*)(t + 8 * lane + 4), b0 = *(const f32x4*)(t + 512 + 8 * lane), b1 = *(const f32x4*)(t + 512 + 8 * lane + 4);
#pragma unroll
          for (int e = 0; e < 4; ++e) { q[e] = a0[e]; q[4 + e] = a1[e]; k[e] = b0[e]; k[4 + e] = b1[e]; } }
#pragma unroll
        for (int e = 0; e < 8; ++e) { sq += q[e] * q[e]; sk += k[e] * k[e]; }
        const float rq = 1.0f / sqrtf(wave_sum(sq) * (1.0f / 512.0f) + RMS_EPS), rk = 1.0f / sqrtf(wave_sum(sk) * (1.0f / 512.0f) + RMS_EPS);
#pragma unroll
        for (int e = 0; e < 8; ++e) { q[e] = q[e] * rq * qn[e]; k[e] = k[e] * rk * kn[e]; }
        v4u o; o.x = pk2(q[0], q[1]); o.y = pk2(q[2], q[3]); o.z = pk2(q[4], q[5]); o.w = pk2(q[6], q[7]); *(GAS v4u*)(QL + (size_t)row * 512 + 8 * lane) = o;
        o.x = pk2(k[0], k[1]); o.y = pk2(k[2], k[3]); o.z = pk2(k[4], k[5]); o.w = pk2(k[6], k[7]); *(GAS v4u*)(CK + (size_t)kvr * 512 + 8 * lane) = o;
        float kr = t[1024 + lane];
        if (row < NCTX) { const int b = row >> 8, tt = row & 255; float* oc = a.out + OUT_CKV + ((size_t)(b * 2 + j) * 256 + tt) * 512 + 8 * lane;
            *(f32x4*)oc = (f32x4){k[0], k[1], k[2], k[3]}; *(f32x4*)(oc + 4) = (f32x4){k[4], k[5], k[6], k[7]};
            a.out[OUT_KR + ((size_t)(b * 2 + j) * 256 + tt) * 64 + lane] = kr; }
        else { const int tp = (row - NCTX) & 4095; const f32x2 cs = rope[(size_t)tp * 32 + (lane >> 1)]; const float other = __shfl_xor(kr, 1);
            kr = (lane & 1) ? (other * cs[1] + kr * cs[0]) : (kr * cs[0] - other * cs[1]); }
        KR[(size_t)kvr * 64 + lane] = (bf16_t)f2bf(kr);
    }
}

__device__ __forceinline__ void attn_naive_phase(const Args& a, int lane, int wave, int vcu, int G, int j) {
    unsigned char* ws = a.ws; const bf16_t* Q = (const bf16_t*)(ws + WS_Q); const bf16_t* KV = (const bf16_t*)(ws + WS_KV);
    const bf16_t* KR = (const bf16_t*)(ws + WS_KR + (size_t)j * al256((size_t)NKV * 64 * 2)); bf16_t* O = (bf16_t*)(ws + WS_MIXO);
    for (int pair = vcu * NWAVES + wave; pair < NTOK * 16; pair += G * NWAVES) {
        const int row = pair >> 4, h = pair & 15; int kv0, nk;
        if (row < NCTX) { kv0 = (row >> 8) * 256; nk = 256; } else { const int lb = (row - NCTX) >> 12; kv0 = 4096 + lb * 4608; nk = 4608; }
        const bf16_t* qp = Q + (size_t)row * 3072 + h * 192; const float q0 = bf2f(qp[lane]), q1 = bf2f(qp[64 + lane]), q2 = bf2f(qp[128 + lane]);
        float m = -1e30f, l = 0.f, o0 = 0.f, o1 = 0.f;
        for (int key = 0; key < nk; key += 4) { float s[4], v0[4], v1[4];
#pragma unroll
            for (int u = 0; u < 4; ++u) { const bf16_t* kp = KV + (size_t)(kv0 + key + u) * 4096 + h * 256;
                s[u] = q0 * bf2f(kp[lane]) + q1 * bf2f(kp[64 + lane]) + q2 * bf2f(KR[(size_t)(kv0 + key + u) * 64 + lane]); v0[u] = bf2f(kp[128 + lane]); v1[u] = bf2f(kp[192 + lane]); }
#pragma unroll
            for (int u = 0; u < 4; ++u) s[u] = wave_sum(s[u]);
#pragma unroll
            for (int u = 0; u < 4; ++u) { const float mn = fmaxf(m, s[u]), al = exp2f(m - mn), p = exp2f(s[u] - mn); l = l * al + p; o0 = o0 * al + p * v0[u]; o1 = o1 * al + p * v1[u]; m = mn; }
        }
        const float il = 1.0f / l; O[(size_t)row * D + h * 128 + lane] = (bf16_t)f2bf(o0 * il); O[(size_t)row * D + h * 128 + 64 + lane] = (bf16_t)f2bf(o1 * il);
    }
}

__device__ __forceinline__ void transpose_zt_phase(const Args& a, LAS unsigned char* lds, int lane, int wave, int vcu, int G) {
    const bf16_t* ZT = (const bf16_t*)(a.ws + WS_ZT); bf16_t* Z = (bf16_t*)(a.ws + WS_MIXO); LAS bf16_t* scr = (LAS bf16_t*)(lds + wave * 16384);
    for (int tile = vcu * NWAVES + wave; tile < 32 * 192; tile += G * NWAVES) { const int c0 = (tile / 192) * 64, t0 = (tile % 192) * 64;
#pragma unroll 8
        for (int i = 0; i < 64; ++i) scr[i * 66 + lane] = ZT[(size_t)(c0 + i) * NTOK + t0 + lane];
        LDS_WAIT(); asm volatile("" ::: "memory");
#pragma unroll 8
        for (int t = 0; t < 64; ++t) Z[(size_t)(t0 + t) * D + c0 + lane] = scr[lane * 66 + t];
        LDS_WAIT(); asm volatile("" ::: "memory"); }
}

struct SchedGrid {
    const char* A; const char* B; char* O;
    size_t a_pm, b_pn, a_s, b_s, o_pm, o_pn, o_s;
    int ldc, nM, nN, nS, G, c;
    __device__ __forceinline__ bool next(int i, pg8::Unit& u) const {
        const int L = i * G + c, per = nM * nN; if (L >= per * nS) return false;
        const int s = L / per; int pm, pn; pg8::tile_of(L - s * per, nM, nN, pm, pn);
        u.A = A + pm * a_pm + s * a_s; u.B = B + pn * b_pn + s * b_s; u.O = O + pm * o_pm + pn * o_pn + s * o_s; u.ldc = ldc; u.pm = pm; u.pn = pn; u.aux = s; return true;
    }
};
struct SchedPair {
    SchedGrid g0, g1; int G, c;
    __device__ __forceinline__ bool next(int i, pg8::Unit& u) const {
        const int L = i * G + c, n0 = g0.nM * g0.nN;
        if (L < n0) { int pm, pn; pg8::tile_of(L, g0.nM, g0.nN, pm, pn); u.A = g0.A + pm * g0.a_pm; u.B = g0.B + pn * g0.b_pn; u.O = g0.O + pm * g0.o_pm + pn * g0.o_pn; u.ldc = g0.ldc; u.pm = pm; u.pn = pn; u.aux = 0; return true; }
        const int L1 = L - n0; if (L1 >= g1.nM * g1.nN) return false;
        int pm, pn; pg8::tile_of(L1, g1.nM, g1.nN, pm, pn); u.A = g1.A + pm * g1.a_pm; u.B = g1.B + pn * g1.b_pn; u.O = g1.O + pm * g1.o_pm + pn * g1.o_pn; u.ldc = g1.ldc; u.pm = pm; u.pn = pn; u.aux = 1; return true;
    }
};
struct SchedF1 {
    const char* dftc; const char* U; char* atc; char* atl; int G, c;
    __device__ __forceinline__ bool next(int i, pg8::Unit& u) const {
        const int L = i * G + c; if (L >= 768) return false;
        const int part = L & 1, g = (L >> 1) & 7, tt = L >> 4;
        u.A = dftc + (size_t)part * 256 * 256 * 2; u.B = U + ((size_t)tt * 256 * D + g * 256) * 2;
        if (tt < 16) { u.O = atc + ((size_t)tt * 2048 * 512 + (size_t)(g * 256) * 512 + part * 256) * 2; u.ldc = 512; }
        else { const int lb = (tt - 16) >> 4, l0 = ((tt - 16) & 15) * 256; u.O = atl + ((size_t)lb * 2048 * 8192 + (size_t)(g * 256) * 8192 + part * 4096 + l0) * 2; u.ldc = 8192; }
        u.pm = part; u.pn = tt; u.aux = g; return true;
    }
};

#define DEVFN __device__ __forceinline__
#define C2_TYPEDEF typedef float c2 __attribute__((ext_vector_type(2)));
#define LDSP LAS
#define OPAQUE(x) asm volatile("" : "+v"(x))
#define U32X4 v4u
#define U32X2 v2u
#define LOAD16(p) (*(const v4u*)(p))
#define LOAD8(p) (*(const v2u*)(p))
#define STORE16(p, v) (*(v4u*)(p) = (v))
#define STORE8(p, v) (*(v2u*)(p) = (v))
#define BFLO(w) bflo(w)
#define BFHI(w) bfhi(w)
#define PK2(a, b) pk2(a, b)
#define BF2F(x) bf2f(x)
#define F2BF(x) ((bf16_t)f2bf(x))
#define COS_TURNS(x) __builtin_amdgcn_cosf(x)
#define SIN_TURNS(x) __builtin_amdgcn_sinf(x)
#define EXPF(x) __expf(x)
#define RSQRTF(x) (1.0f / sqrtf(x))
#define WAVE_SUM(v) wave_sum(v)
#define BLOCK_SYNC() __syncthreads()
C2_TYPEDEF
DEVFN c2 cmul(c2 a, c2 b) { c2 r; r.x = a.x * b.x - a.y * b.y; r.y = a.x * b.y + a.y * b.x; return r; }
DEVFN c2 cmulc(c2 a, c2 b) { c2 r; r.x = a.x * b.x + a.y * b.y; r.y = a.y * b.x - a.x * b.y; return r; }
template <int LOGN, int S, int G, bool INV>
DEVFN void fft_pass(LDSP c2* x, int total, int tid) {
    OPAQUE(tid);
    constexpr int N = 1 << LOGN, R = 1 << G, H3 = N >> (S + G);
    const int ngroups = total / R;
#pragma unroll 1
    for (int j = tid; j < ngroups; j += NTHREADS) {
        const int tr = j / (N / R), jj = j % (N / R), blk = jj / H3, pos = jj % H3;
        const int i0 = tr * N + blk * (R * H3) + pos;
        c2 v[R];
#pragma unroll
        for (int q = 0; q < R; ++q) v[q] = x[i0 + q * H3];
#pragma unroll
        for (int gg = 0; gg < G; ++gg) {
            const int g = INV ? (G - 1 - gg) : gg;
            const int hq = R >> (g + 1);
            const float inv_bs = 1.0f / (float)(H3 * 2 * hq);
#pragma unroll
            for (int q = 0; q < R; ++q) {
                if ((q & hq) == 0) {
                    const int p = pos + (q & (hq - 1)) * H3;
                    const float fr = (float)p * inv_bs;
                    c2 w; w.x = COS_TURNS(fr); w.y = -SIN_TURNS(fr);
                    const c2 a = v[q], b = v[q + hq];
                    if (!INV) { c2 d; d.x = a.x - b.x; d.y = a.y - b.y; v[q].x = a.x + b.x; v[q].y = a.y + b.y; v[q + hq] = cmul(d, w); }
                    else { const c2 bw = cmulc(b, w); v[q].x = a.x + bw.x; v[q].y = a.y + bw.y; v[q + hq].x = a.x - bw.x; v[q + hq].y = a.y - bw.y; }
                }
            }
        }
#pragma unroll
        for (int q = 0; q < R; ++q) x[i0 + q * H3] = v[q];
    }
}
template <int LOGN, bool INV> DEVFN void fft_all(LDSP c2* x, int total, int tid) {
    if constexpr (LOGN == 13) {
        if (!INV) { fft_pass<13, 0, 3, false>(x, total, tid); BLOCK_SYNC(); fft_pass<13, 3, 3, false>(x, total, tid); BLOCK_SYNC(); fft_pass<13, 6, 3, false>(x, total, tid); BLOCK_SYNC(); fft_pass<13, 9, 2, false>(x, total, tid); BLOCK_SYNC(); fft_pass<13, 11, 2, false>(x, total, tid); BLOCK_SYNC(); }
        else { fft_pass<13, 11, 2, true>(x, total, tid); BLOCK_SYNC(); fft_pass<13, 9, 2, true>(x, total, tid); BLOCK_SYNC(); fft_pass<13, 6, 3, true>(x, total, tid); BLOCK_SYNC(); fft_pass<13, 3, 3, true>(x, total, tid); BLOCK_SYNC(); fft_pass<13, 0, 3, true>(x, total, tid); BLOCK_SYNC(); }
    } else {
        static_assert(LOGN == 9 || LOGN == 13, "fft sizes");
        if (!INV) { fft_pass<9, 0, 3, false>(x, total, tid); BLOCK_SYNC(); fft_pass<9, 3, 3, false>(x, total, tid); BLOCK_SYNC(); fft_pass<9, 6, 3, false>(x, total, tid); BLOCK_SYNC(); }
        else { fft_pass<9, 6, 3, true>(x, total, tid); BLOCK_SYNC(); fft_pass<9, 3, 3, true>(x, total, tid); BLOCK_SYNC(); fft_pass<9, 0, 3, true>(x, total, tid); BLOCK_SYNC(); }
    }
}
struct HyParams {
    float dec[2][2];
    float skip[2];
    float cw[3][3];
    float cb[3];
};
template <int NV>
DEVFN void hy_short_vec(const bf16_t* Pcol, unsigned o, int t0, int L, float w0, float w1, float w2, float cb, float (&out)[NV]) {
    float x[NV + 2];
    if constexpr (NV == 8) { const U32X4 r = LOAD16(Pcol + o); const unsigned w[4] = {r.x, r.y, r.z, r.w};
#pragma unroll
        for (int e = 0; e < 4; ++e) { x[1 + 2 * e] = BFLO(w[e]); x[2 + 2 * e] = BFHI(w[e]); } }
    else { const U32X2 r = LOAD8(Pcol + o); x[1] = BFLO(r.x); x[2] = BFHI(r.x); x[3] = BFLO(r.y); x[4] = BFHI(r.y); }
    const bool hl = t0 > 0, hr = t0 + NV < L;
    const float xl = BF2F(Pcol[hl ? o - 1u : o]), xr = BF2F(Pcol[hr ? o + (unsigned)NV : o]);
    x[0] = hl ? xl : 0.f; x[NV + 1] = hr ? xr : 0.f;
#pragma unroll
    for (int e = 0; e < NV; ++e) out[e] = w0 * x[e] + w1 * x[e + 1] + w2 * x[e + 2] + cb;
}
template <int LOGN, int NB, int O>
DEVFN void hy_conv_order(LDSP c2* XB, LDSP c2* KB, LDSP float* red, int c, int region_base, int fpos, const bf16_t* PT, const bf16_t* FILT, const HyParams& hp, bf16_t* ZT, int tid,
                         float (&za)[(NB << (LOGN - 1)) / NTHREADS], float (&zb)[(NB << (LOGN - 1)) / NTHREADS]) {
    constexpr int N = 1 << LOGN, L = N / 2, P = NB * N, PPT = P / NTHREADS, NV = NB * L / NTHREADS;
    static_assert(NV == 8 || NV == 4, "points per thread");
    const bf16_t* Pv = PT + (size_t)c * NTOK; const bf16_t* Pg = PT + (size_t)((1 + O) * 2048 + c) * NTOK;
    const int v0 = NV * tid, pair = v0 / L, t0 = v0 % L, sb = region_base + (2 * pair) * L;
    const bf16_t* Ff = FILT + (size_t)(0 * 4096 + O * 2048 + c) * FILT_LD + fpos; const bf16_t* Fb = FILT + (size_t)(1 * 4096 + O * 2048 + c) * FILT_LD + fpos;
    float ss = 0.f; const float tsc = 1.0f / (float)(L - 1); const float d0 = hp.dec[0][O], d1 = hp.dec[1][O];
#pragma unroll 2
    for (int idx = tid; idx < N; idx += NTHREADS) {
        float kv = 0.f;
        if (idx < L) { const float f = BF2F(Ff[idx]) * (EXPF(-(float)idx * tsc * d0) + 0.05f); ss += f * f; kv = f; }
        else { const int t = (idx == L) ? 0 : (N - idx); const float b = BF2F(Fb[t]) * (EXPF(-(float)t * tsc * d1) + 0.05f); ss += b * b; kv = (idx == L) ? 0.f : b; }
        c2 k; k.x = kv; k.y = 0.f; KB[idx] = k;
    }
    ss = WAVE_SUM(ss);
    BLOCK_SYNC();
    if ((tid & 63) == 0) red[tid >> 6] = ss;
    if (O == 0) { hy_short_vec<NV>(Pv, (unsigned)(sb + t0), t0, L, hp.cw[0][0], hp.cw[0][1], hp.cw[0][2], hp.cb[0], za); hy_short_vec<NV>(Pv, (unsigned)(sb + L + t0), t0, L, hp.cw[0][0], hp.cw[0][1], hp.cw[0][2], hp.cb[0], zb); }
#pragma unroll
    for (int e = 0; e < NV; ++e) { c2 z; z.x = za[e]; z.y = zb[e]; XB[pair * N + t0 + e] = z; c2 zz; zz.x = 0.f; zz.y = 0.f; XB[pair * N + L + t0 + e] = zz; }
    BLOCK_SYNC();
    float tot = 0.f;
#pragma unroll
    for (int w = 0; w < NTHREADS / 64; ++w) tot += red[w];
    const float sc = RSQRTF(tot + 1e-12f) * (1.0f / (float)N);
    fft_all<LOGN, false>(KB, N, tid);
    fft_all<LOGN, false>(XB, P, tid);
#pragma unroll 4
    for (int i = 0; i < PPT; ++i) { const int p = tid + NTHREADS * i, j = p & (N - 1); c2 k = KB[j]; k.x *= sc; k.y *= sc; const c2 xv = XB[p]; XB[p] = cmul(xv, k); }
    BLOCK_SYNC();
    fft_all<LOGN, true>(XB, P, tid);
    { const float sk = hp.skip[O]; float ga[NV], gb[NV];
      hy_short_vec<NV>(Pg, (unsigned)(sb + t0), t0, L, hp.cw[1 + O][0], hp.cw[1 + O][1], hp.cw[1 + O][2], hp.cb[1 + O], ga); hy_short_vec<NV>(Pg, (unsigned)(sb + L + t0), t0, L, hp.cw[1 + O][0], hp.cw[1 + O][1], hp.cw[1 + O][2], hp.cb[1 + O], gb);
#pragma unroll
      for (int e = 0; e < NV; ++e) { const c2 y = XB[pair * N + t0 + e]; za[e] = ga[e] * (y.x + sk * za[e]); zb[e] = gb[e] * (y.y + sk * zb[e]); }
      if (O == 1) { bf16_t* Zc = ZT + (size_t)c * NTOK;
          if constexpr (NV == 8) { U32X4 wa, wb; wa.x = PK2(za[0], za[1]); wa.y = PK2(za[2], za[3]); wa.z = PK2(za[4], za[5]); wa.w = PK2(za[6], za[7]); wb.x = PK2(zb[0], zb[1]); wb.y = PK2(zb[2], zb[3]); wb.z = PK2(zb[4], zb[5]); wb.w = PK2(zb[6], zb[7]);
              STORE16(Zc + (unsigned)(sb + t0), wa); STORE16(Zc + (unsigned)(sb + L + t0), wb); }
          else { U32X2 wa, wb; wa.x = PK2(za[0], za[1]); wa.y = PK2(za[2], za[3]); wb.x = PK2(zb[0], zb[1]); wb.y = PK2(zb[2], zb[3]); STORE8(Zc + (unsigned)(sb + t0), wa); STORE8(Zc + (unsigned)(sb + L + t0), wb); } } }
    BLOCK_SYNC();
}
template <int LOGN, int NB>
DEVFN void hy_conv_unit(LDSP c2* XB, LDSP c2* KB, LDSP float* red, int c, int region_base, int fpos, const bf16_t* PT, const bf16_t* FILT, const HyParams& hp, bf16_t* ZT, int tid) {
    constexpr int NV = (NB << (LOGN - 1)) / NTHREADS;
    float za[NV], zb[NV];
#pragma unroll
    for (int i = 0; i < NV; ++i) { za[i] = 0.f; zb[i] = 0.f; }
    hy_conv_order<LOGN, NB, 0>(XB, KB, red, c, region_base, fpos, PT, FILT, hp, ZT, tid, za, zb);
    hy_conv_order<LOGN, NB, 1>(XB, KB, red, c, region_base, fpos, PT, FILT, hp, ZT, tid, za, zb);
}
__device__ __forceinline__ void hy_conv_phase(const Args& a, LAS unsigned char* lds, int tid, int vcu, int G) {
    unsigned char* ws = a.ws; const bf16_t* PT = (const bf16_t*)(ws + WS_PT); const bf16_t* FILT = (const bf16_t*)(ws + WS_FILT); bf16_t* ZT = (bf16_t*)(ws + WS_ZT);
    LAS c2* XB = (LAS c2*)lds; LAS c2* KB = (LAS c2*)(lds + 65536); LAS float* red = (LAS float*)(lds + LDSCTL_OFF);
    for (int c = vcu; c < 2048; c += G) {
        HyParams hp;
#pragma unroll
        for (int d = 0; d < 2; ++d)
#pragma unroll
            for (int o = 0; o < 2; ++o) hp.dec[d][o] = __expf(a.in[I_HDEC][(d * 2 + o) * 2048 + c]);
        hp.skip[0] = a.in[I_HSKIP][c]; hp.skip[1] = a.in[I_HSKIP][2048 + c];
#pragma unroll
        for (int w = 0; w < 3; ++w) { hp.cb[w] = a.in[I_HCB][w * 2048 + c];
#pragma unroll
            for (int k = 0; k < 3; ++k) hp.cw[w][k] = a.in[I_HCW][k * 6144 + w * 2048 + c]; }
        hy_conv_unit<13, 1>(XB, KB, red, c, 4096, 0, PT, FILT, hp, ZT, tid);
        hy_conv_unit<9, 8>(XB, KB, red, c, 0, 4096, PT, FILT, hp, ZT, tid);
    }
}

constexpr int N_PHASES = 35;
#ifndef MK_PER_PHASE
#define MK_PER_PHASE 0
#endif
#ifndef ATTN_NAIVE
#define ATTN_NAIVE 1
#endif

__global__ void __launch_bounds__(NTHREADS, 2) trunk_fwd(Args args) {
    extern __shared__ __attribute__((aligned(16))) unsigned char lds_raw[];
    LAS unsigned char* lds = (LAS unsigned char*)lds_raw;
    volatile LAS unsigned* MISC = (volatile LAS unsigned*)(lds + MISC_OFF);
    const int tid = threadIdx.x, lane = tid & 63, wave = __builtin_amdgcn_readfirstlane(tid >> 6);
    const int G = gridDim.x, bx = blockIdx.x, vcu = (G % 8 == 0) ? (bx % 8) * (G / 8) + bx / 8 : bx;
    unsigned char* ws = args.ws;
    for (int u = tid; u < (LDS_BYTES - LDSCTL_OFF) / 4; u += NTHREADS) ((LAS unsigned*)(lds + LDSCTL_OFF))[u] = 0u;
    __syncthreads();
    XcdBarrier bar; bar.bar = (unsigned*)(ws + WS_CTL) + 4096; bar.x = 0; bar.st = nullptr;
    if (!MK_PER_PHASE) bar = xcd_barrier_post((unsigned*)(ws + WS_CTL) + 4096, MISC + 8);
    const int lo = args.ph_lo, hi = args.ph_hi;
#ifndef PH_ONLY_LO
#define PH_ONLY_LO 0
#define PH_ONLY_HI 1000
#endif
#define IN(k) ((k) >= PH_ONLY_LO && (k) < PH_ONLY_HI && lo <= (k) && (k) < hi)
#define SEAM(k) do { if (IN(k) && IN((k) + 1)) xcd_barrier(bar); } while (0)
    const char* U = (const char*)(ws + WS_U); const char* MIXO = (const char*)(ws + WS_MIXO); char* PART = (char*)(ws + WS_PART);

#define OUTPROJ(Aptr, Wptr, KTOT) do { SchedGrid S{(const char*)(Aptr), (const char*)(Wptr), PART, (size_t)256 * (KTOT) * 2, (size_t)256 * (KTOT) * 2, (size_t)((KTOT) / 2) * 2, (size_t)((KTOT) / 2) * 2, \
        (size_t)256 * D * 4, (size_t)256 * 4, (size_t)NTOK * D * 4, D, 48, 8, 2, G, bx}; pg8::EpiF32 E; pg8::gemm_phase<pg8::EpiF32, SchedGrid, false, true>(lds, (KTOT) / 2, (KTOT), (KTOT), S, E); } while (0)
#define FFN_BLOCK(l, p, lnext, final) do { \
    if (IN(p)) { SchedGrid S{U, (const char*)(ws + WS_WGU + (size_t)(l) * SZ_WGU), (char*)(ws + WS_ACT), (size_t)256 * D * 2, (size_t)256 * D * 2, 0, 0, (size_t)256 * DFF * 2, (size_t)128 * 2, 0, DFF, 48, 44, 1, G, bx}; \
        pg8::EpiSwiglu E; pg8::gemm_phase<pg8::EpiSwiglu, SchedGrid, false, true>(lds, D, D, D, S, E); } SEAM(p); \
    if (IN((p) + 1)) { OUTPROJ(ws + WS_ACT, ws + WS_WD + (size_t)(l) * SZ_WD, DFF); } SEAM((p) + 1); \
    if (IN((p) + 2)) { ln_phase(args, lds, tid, lane, wave, vcu, G, (l), 5, 1, nullptr, (lnext), 0, (final)); } if (!(final)) SEAM((p) + 2); } while (0)
#define MLA_BLOCK(j, l, p) do { \
    if (IN(p)) { SchedGrid S{U, (const char*)(ws + WS_W1 + (size_t)(j) * SZ_W1), (char*)(ws + WS_T1), (size_t)256 * D * 2, (size_t)256 * D * 2, 0, 0, (size_t)256 * 1280 * 4, (size_t)256 * 4, 0, 1280, 48, 5, 1, G, bx}; \
        pg8::EpiF32 E; pg8::gemm_phase<pg8::EpiF32, SchedGrid, false, true>(lds, D, D, D, S, E); } SEAM(p); \
    if (IN((p) + 1)) { mla_norm_phase(args, lane, wave, vcu, G, (j)); } SEAM((p) + 1); \
    if (IN((p) + 2)) { SchedPair S; \
        S.g0 = SchedGrid{(const char*)(ws + WS_QL), (const char*)(ws + WS_WUQ + (size_t)(j) * SZ_WUQ), (char*)(ws + WS_Q), (size_t)256 * 512 * 2, (size_t)256 * 512 * 2, 0, 0, (size_t)256 * 3072 * 2, (size_t)256 * 2, 0, 3072, 48, 12, 1, G, bx}; \
        S.g1 = SchedGrid{(const char*)(ws + WS_CKVN + (size_t)(j) * NKV * 512 * 2), (const char*)(ws + WS_WUKV + (size_t)(j) * SZ_WUKV), (char*)(ws + WS_KV), (size_t)256 * 512 * 2, (size_t)256 * 512 * 2, 0, 0, (size_t)256 * 4096 * 2, (size_t)256 * 2, 0, 4096, 52, 16, 1, G, bx}; \
        S.G = G; S.c = bx; pg8::EpiQKV E{(const pg8::f32x2*)(ws + WS_ROPE), QSCALE}; pg8::gemm_phase<pg8::EpiQKV, SchedPair, false, true>(lds, 512, 512, 512, S, E); } SEAM((p) + 2); \
    if (IN((p) + 3)) { attn_naive_phase(args, lane, wave, vcu, G, (j)); } SEAM((p) + 3); \
    if (IN((p) + 4)) { OUTPROJ(MIXO, ws + WS_WO + (size_t)(l) * SZ_WO, D); } SEAM((p) + 4); \
    if (IN((p) + 5)) { ln_phase(args, lds, tid, lane, wave, vcu, G, (l), 2, 0, nullptr, (l), 3, false); } SEAM((p) + 5); } while (0)

    if (IN(0)) { p0_prologue(args, lds, tid, lane, wave, vcu, G); } SEAM(0);
    if (IN(1)) { p1_embed(args, lane, wave, vcu, G);
        { SchedGrid S{(const char*)(ws + WS_W3), (const char*)(ws + WS_HF2), (char*)(ws + WS_FILT), (size_t)256 * 256 * 2, (size_t)256 * 256 * 2, 0, 0, (size_t)256 * FILT_LD * 2, (size_t)256 * 2, 0, FILT_LD, 32, 17, 1, G, bx};
          pg8::EpiBf16<0> E{nullptr}; pg8::gemm_phase<pg8::EpiBf16<0>, SchedGrid, false, true>(lds, 256, 256, 256, S, E); }
    } SEAM(1);
    MLA_BLOCK(0, 0, 2);
    FFN_BLOCK(0, 8, 1, false);
    if (IN(11)) {
        { SchedGrid S{(const char*)(ws + WS_WIN), U, (char*)(ws + WS_PT), (size_t)256 * D * 2, (size_t)256 * D * 2, 0, 0, (size_t)256 * NTOK * 2, (size_t)256 * 2, 0, NTOK, 24, 48, 1, G, bx};
          pg8::EpiBf16<1> E{args.in[I_HBIN]}; pg8::gemm_phase<pg8::EpiBf16<1>, SchedGrid, false, true>(lds, D, D, D, S, E); }
    } SEAM(11);
    if (IN(12)) { hy_conv_phase(args, lds, tid, vcu, G); } SEAM(12);
    if (IN(13)) { transpose_zt_phase(args, lds, lane, wave, vcu, G); } SEAM(13);
    if (IN(14)) { OUTPROJ(MIXO, ws + WS_WO + (size_t)1 * SZ_WO, D); } SEAM(14);
    if (IN(15)) { ln_phase(args, lds, tid, lane, wave, vcu, G, 1, 2, 0, args.in[I_HBOUT], 1, 3, false); } SEAM(15);
    FFN_BLOCK(1, 16, 2, false);
    if (IN(19)) { SchedF1 S{(const char*)(ws + WS_DFTC), U, (char*)(ws + WS_ATC), (char*)(ws + WS_ATL), G, bx}; pg8::EpiBf16<0> E{nullptr}; pg8::gemm_phase<pg8::EpiBf16<0>, SchedF1, false, true>(lds, 256, 256, D, S, E); } SEAM(19);
    if (IN(20)) {
        { SchedGrid S{(const char*)(ws + WS_DML), (const char*)(ws + WS_ATL), (char*)(ws + WS_MIXO) + (size_t)NCTX * D * 2, (size_t)256 * 8192 * 2, (size_t)256 * 8192 * 2, 0, (size_t)2048 * 8192 * 2, (size_t)256 * D * 2, (size_t)256 * 2, (size_t)4096 * D * 2, D, 16, 8, 2, G, bx};
          pg8::EpiBf16<0> E{nullptr}; pg8::gemm_phase<pg8::EpiBf16<0>, SchedGrid, false, true>(lds, 8192, 8192, 8192, S, E); }
        { SchedGrid S{(const char*)(ws + WS_DMC), (const char*)(ws + WS_ATC), (char*)(ws + WS_MIXO), 0, (size_t)256 * 512 * 2, 0, (size_t)2048 * 512 * 2, 0, (size_t)256 * 2, (size_t)256 * D * 2, D, 1, 8, 16, G, bx};
          pg8::EpiBf16<0> E{nullptr}; pg8::gemm_phase<pg8::EpiBf16<0>, SchedGrid, false, true>(lds, 512, 512, 512, S, E); }
    } SEAM(20);
    if (IN(21)) { OUTPROJ(MIXO, ws + WS_WO + (size_t)2 * SZ_WO, D); } SEAM(21);
    if (IN(22)) { ln_phase(args, lds, tid, lane, wave, vcu, G, 2, 2, 0, args.in[I_FNB], 2, 3, false); } SEAM(22);
    FFN_BLOCK(2, 23, 3, false);
    MLA_BLOCK(1, 3, 26);
    FFN_BLOCK(3, 32, 3, true);
#undef IN
#undef SEAM
}

extern "C" void kernel_launch(void* const* d_in, const int* in_sizes, int n_in, void* d_out, int out_size, void* d_ws, size_t ws_size, hipStream_t stream) {
    static int grid = 0;
    if (grid == 0) {
        if (n_in != 38 || ws_size < WS_END) { fprintf(stderr, "kernel_launch: expected 38 inputs and >= %zu bytes of workspace; got %d, %zu\n", (size_t)WS_END, n_in, ws_size); grid = -1; return; }
        int dev = 0, cus = 0, per_cu = 0;
        if (hipGetDevice(&dev) != hipSuccess || hipDeviceGetAttribute(&cus, hipDeviceAttributeMultiprocessorCount, dev) != hipSuccess) { grid = -1; return; }
        if (hipFuncSetAttribute((const void*)trunk_fwd, hipFuncAttributeMaxDynamicSharedMemorySize, LDS_BYTES) != hipSuccess) { fprintf(stderr, "kernel_launch: hipFuncSetAttribute failed\n"); grid = -1; return; }
        if (hipOccupancyMaxActiveBlocksPerMultiprocessor(&per_cu, (const void*)trunk_fwd, NTHREADS, LDS_BYTES) != hipSuccess || per_cu < 1) { fprintf(stderr, "kernel_launch: occupancy query reports %d workgroups per CU\n", per_cu); }
        (void)hipGetLastError();
        grid = cus;
    }
    if (grid < 0) return;
    if (hipMemsetAsync((char*)d_ws + WS_CTL, 0, CTL_ZERO_BYTES, stream) != hipSuccess) return;
    Args a{};
    for (int i = 0; i < 38; ++i) a.in[i] = (const float*)d_in[i];
    a.out = (float*)d_out; a.ws = (unsigned char*)d_ws; a.li = 0; a.pad = 0;
#if MK_PER_PHASE
    for (int p = 0; p < N_PHASES; ++p) { a.ph_lo = p; a.ph_hi = p + 1; hipLaunchKernelGGL(trunk_fwd, dim3(grid), dim3(NTHREADS), LDS_BYTES, stream, a); }
#else
    a.ph_lo = 0; a.ph_hi = N_PHASES; hipLaunchKernelGGL(trunk_fwd, dim3(grid), dim3(NTHREADS), LDS_BYTES, stream, a);
#endif
    const hipError_t le = hipPeekAtLastError();
    if (le != hipSuccess) fprintf(stderr, "kernel_launch: launch failed: %s\n", hipGetErrorName(le));
}
```

```cpp
#include <hip/hip_runtime.h>
#include <cstdio>
#include <cstdint>
#define GAS __attribute__((address_space(1)))
#define LAS __attribute__((address_space(3)))
typedef unsigned short bf16_t;
typedef unsigned v4u __attribute__((ext_vector_type(4)));
typedef unsigned v2u __attribute__((ext_vector_type(2)));
typedef float f32x4 __attribute__((ext_vector_type(4)));
typedef float f32x2 __attribute__((ext_vector_type(2)));

constexpr int D = 2048, NCTX = 4096, NLAT = 8192, NTOK = 12288, DFF = 5632, NKV = 13312;
constexpr int NTHREADS = 512, NWAVES = 8;
constexpr float DN_ALPHA = 1.681792830507429f;
constexpr float LN_EPS = 1e-5f, RMS_EPS = 1e-6f;
constexpr float QSCALE = 0.07216878364870322f * 1.4426950408889634f;
constexpr int FILT_LD = 4352;

constexpr size_t al256(size_t x) { return (x + 255) & ~(size_t)255; }
constexpr size_t SZ_WGU = (size_t)11264 * 2048 * 2, SZ_WD = (size_t)2048 * 5632 * 2;
constexpr size_t SZ_W1 = (size_t)1280 * 2048 * 2, SZ_WUQ = (size_t)3072 * 512 * 2, SZ_WUKV = (size_t)4096 * 512 * 2, SZ_WO = (size_t)2048 * 2048 * 2;
constexpr size_t SZ_WIN = (size_t)6144 * 2048 * 2, SZ_W3 = (size_t)8192 * 256 * 2;
constexpr size_t SZ_DFTC = (size_t)512 * 256 * 2, SZ_DML = (size_t)4096 * 8192 * 2, SZ_DMC = (size_t)256 * 512 * 2;
constexpr size_t SZ_ROWS = (size_t)NTOK * D * 2;
constexpr size_t WS_CTL = 0, CTL_ZERO_BYTES = 1u << 20;
constexpr size_t WS_MOD = WS_CTL + CTL_ZERO_BYTES;
constexpr size_t WS_ROPE = WS_MOD + al256((size_t)4 * 3 * 12288 * 4);
constexpr size_t WS_HF2 = WS_ROPE + al256((size_t)4096 * 32 * 8);
constexpr size_t WS_WGU = WS_HF2 + al256((size_t)FILT_LD * 256 * 2);
constexpr size_t WS_WD = WS_WGU + 4 * SZ_WGU;
constexpr size_t WS_W1 = WS_WD + 4 * SZ_WD;
constexpr size_t WS_WUQ = WS_W1 + 2 * SZ_W1;
constexpr size_t WS_WUKV = WS_WUQ + 2 * SZ_WUQ;
constexpr size_t WS_WO = WS_WUKV + 2 * SZ_WUKV;
constexpr size_t WS_WIN = WS_WO + 4 * SZ_WO;
constexpr size_t WS_W3 = WS_WIN + SZ_WIN;
constexpr size_t WS_DFTC = WS_W3 + SZ_W3;
constexpr size_t WS_DML = WS_DFTC + SZ_DFTC;
constexpr size_t WS_DMC = WS_DML + SZ_DML;
constexpr size_t WS_H = WS_DMC + al256(SZ_DMC);
constexpr size_t WS_U = WS_H + SZ_ROWS;
constexpr size_t WS_PART = WS_U + SZ_ROWS;
constexpr size_t WS_ACT = WS_PART + (size_t)2 * NTOK * D * 4;
constexpr size_t WS_CKVN = WS_ACT + (size_t)NTOK * DFF * 2;
constexpr size_t WS_KR = WS_CKVN + 2 * (size_t)NKV * 512 * 2;
constexpr size_t WS_MIXO = WS_KR + 2 * al256((size_t)NKV * 64 * 2);
constexpr size_t WS_FILT = WS_MIXO + SZ_ROWS;
constexpr size_t WS_X = WS_FILT + (size_t)8192 * FILT_LD * 2;
constexpr size_t WS_T1 = WS_X;
constexpr size_t WS_QL = WS_T1 + (size_t)NTOK * 1280 * 4;
constexpr size_t WS_Q = WS_QL + (size_t)NTOK * 512 * 2;
constexpr size_t WS_KV = WS_Q + (size_t)NTOK * 3072 * 2;
constexpr size_t WS_XEND_MLA = WS_KV + (size_t)NKV * 4096 * 2;
constexpr size_t WS_PT = WS_X;
constexpr size_t WS_ZT = WS_PT + (size_t)6144 * NTOK * 2;
constexpr size_t WS_XEND_HY = WS_ZT + (size_t)2048 * NTOK * 2;
constexpr size_t WS_ATC = WS_X;
constexpr size_t WS_ATL = WS_ATC + (size_t)16 * 2048 * 512 * 2;
constexpr size_t WS_XEND_FN = WS_ATL + (size_t)2 * 2048 * 8192 * 2;
constexpr size_t cmax(size_t a, size_t b) { return a > b ? a : b; }
constexpr size_t WS_END = cmax(WS_XEND_MLA, cmax(WS_XEND_HY, WS_XEND_FN));
static_assert(WS_END <= (size_t)1610612736, "d_ws map exceeds 4 x largest tensor");

constexpr int RING_OFF = 0, RING_BYTES = 131072;
constexpr int LDSCTL_OFF = RING_BYTES, MISC_OFF = LDSCTL_OFF + 320;
constexpr int LDS_BYTES = 147456;
static_assert(MISC_OFF + 128 <= LDS_BYTES, "LDS map");

__device__ __forceinline__ unsigned f2bf(float f) { unsigned u = __builtin_bit_cast(unsigned, f); return (u + 0x7fffu + ((u >> 16) & 1u)) >> 16; }
__device__ __forceinline__ unsigned pk2(float lo, float hi) { return f2bf(lo) | (f2bf(hi) << 16); }
__device__ __forceinline__ float bf2f(unsigned short b) { return __builtin_bit_cast(float, ((unsigned)b) << 16); }
__device__ __forceinline__ float bflo(unsigned w) { return __builtin_bit_cast(float, w << 16); }
__device__ __forceinline__ float bfhi(unsigned w) { return __builtin_bit_cast(float, w & 0xffff0000u); }
#define LDS_WAIT() asm volatile("s_waitcnt lgkmcnt(0)" ::: "memory")
#define VM_WAIT() asm volatile("s_waitcnt vmcnt(0)" ::: "memory")
__device__ __forceinline__ float wave_sum(float v) {
#pragma unroll
    for (int o = 1; o < 64; o <<= 1) v += __shfl_xor(v, o);
    return v;
}

namespace pg8 {
typedef short bf16x8 __attribute__((ext_vector_type(8)));
typedef float f32x4 __attribute__((ext_vector_type(4)));
typedef float f32x2 __attribute__((ext_vector_type(2)));
typedef unsigned u32x4 __attribute__((ext_vector_type(4)));
constexpr int BM = 256, BK = 64, HALF = 128, HTB = HALF * BK * 2  , STAGE_BYTES = 8 * HTB, NXCD = 8, WGM = 8;

__host__ __device__ __forceinline__ int lds_byte(int r, int c) { const int st = (r >> 4) * 2 + (c >> 5), rr = r & 15, cc = c & 31, ob = rr * 64 + cc * 2; return st * 1024 + (ob ^ (((ob >> 9) & 1) << 5)); }
__host__ __device__ __forceinline__ void stage_rc(int b, int& R, int& C) { const int st = b / 1024, sb = b % 1024, swz = sb ^ (((sb >> 9) & 1) << 5); R = (st >> 1) * 16 + swz / 64; C = (st & 1) * 32 + (swz % 64) / 2; }
__host__ __device__ __forceinline__ int perm32(int rho) { const int n = rho >> 4, i = rho & 15; return 8 * (i >> 2) + 4 * n + (i & 3); }

struct Unit { const char* A; const char* B; char* O; int ldc; int pm, pn, aux; };

__device__ __forceinline__ void tile_of(int L, int nM, int nN, int& pm, int& pn) {
    const int nwg = nM * nN; int wgid = L; { const int q = nwg / NXCD, r = nwg % NXCD, xcd = wgid % NXCD, off = wgid / NXCD; wgid = (xcd < r ? xcd * (q + 1) : r * (q + 1) + (xcd - r) * q) + off; }
    const int nig = WGM * nN, gid = wgid / nig, fm = gid * WGM, gsz = (nM - fm) < WGM ? (nM - fm) : WGM;
    pm = fm + ((wgid % nig) % gsz); pn = (wgid % nig) / gsz;
}

__device__ __forceinline__ unsigned cvt_pk_bf16(float lo, float hi) { unsigned r; asm volatile("v_cvt_pk_bf16_f32 %0, %1, %2" : "=v"(r) : "v"(lo), "v"(hi)); return r; }

struct EpiF32 {
    static constexpr bool PERM = false;
    __device__ __forceinline__ void operator()(const f32x4 (&acc)[2][2][4][2], const Unit& u, int wr, int wc, int fr, int fq) const {
        const int row0 = wr * 64 + fr, col0 = wc * 32 + 4 * fq; float* O = (float*)u.O;
#pragma unroll
        for (int ai = 0; ai < 2; ++ai)
#pragma unroll
            for (int m = 0; m < 4; ++m) { float* rowp = O + (size_t)(row0 + ai * HALF + m * 16) * u.ldc + col0;
#pragma unroll
                for (int bj = 0; bj < 2; ++bj)
#pragma unroll
                    for (int n = 0; n < 2; ++n) *(f32x4*)(rowp + bj * HALF + n * 16) = acc[ai][bj][m][n]; }
    }
};
template <int BIAS  > struct EpiBf16 {
    static constexpr bool PERM = true;
    const float* bias;
    __device__ __forceinline__ void operator()(const f32x4 (&acc)[2][2][4][2], const Unit& u, int wr, int wc, int fr, int fq) const {
        const int row0 = wr * 64 + fr, col0 = wc * 32 + 8 * fq; bf16_t* O = (bf16_t*)u.O;
#pragma unroll
        for (int ai = 0; ai < 2; ++ai)
#pragma unroll
            for (int m = 0; m < 4; ++m) { const int r = row0 + ai * HALF + m * 16; bf16_t* rowp = O + (size_t)r * u.ldc + col0; const float b = BIAS == 1 ? bias[u.pm * BM + r] : 0.f;
#pragma unroll
                for (int bj = 0; bj < 2; ++bj) { const f32x4 v0 = acc[ai][bj][m][0] + b, v1 = acc[ai][bj][m][1] + b;
                    u32x4 w; w.x = cvt_pk_bf16(v0[0], v0[1]); w.y = cvt_pk_bf16(v0[2], v0[3]); w.z = cvt_pk_bf16(v1[0], v1[1]); w.w = cvt_pk_bf16(v1[2], v1[3]);
                    *(u32x4*)(rowp + bj * HALF) = w; } }
    }
};
struct EpiSwiglu {
    static constexpr bool PERM = true;
    __device__ __forceinline__ void operator()(const f32x4 (&acc)[2][2][4][2], const Unit& u, int wr, int wc, int fr, int fq) const {
        const int row0 = wr * 64 + fr, col0 = wc * 32 + 8 * fq; bf16_t* O = (bf16_t*)u.O;
#pragma unroll
        for (int ai = 0; ai < 2; ++ai)
#pragma unroll
            for (int m = 0; m < 4; ++m) { bf16_t* rowp = O + (size_t)(row0 + ai * HALF + m * 16) * u.ldc + col0; float v[8];
#pragma unroll
                for (int n = 0; n < 2; ++n)
#pragma unroll
                    for (int j = 0; j < 4; ++j) { const float g = acc[ai][0][m][n][j], up = acc[ai][1][m][n][j]; v[n * 4 + j] = g * __builtin_amdgcn_rcpf(1.0f + __expf(-g)) * up; }
                u32x4 w; w.x = cvt_pk_bf16(v[0], v[1]); w.y = cvt_pk_bf16(v[2], v[3]); w.z = cvt_pk_bf16(v[4], v[5]); w.w = cvt_pk_bf16(v[6], v[7]);
                *(u32x4*)rowp = w; }
    }
};
struct EpiQKV {
    static constexpr bool PERM = true;
    const f32x2* rope; float qscale;
    __device__ __forceinline__ void operator()(const f32x4 (&acc)[2][2][4][2], const Unit& u, int wr, int wc, int fr, int fq) const {
        const int row0 = wr * 64 + fr, col0 = wc * 32 + 8 * fq; bf16_t* O = (bf16_t*)u.O;
        const bool isq = (u.aux == 0); const float sc = isq ? qscale : 1.0f; const bool lat = isq && (u.pm >= 16);
        int pr[2]; bool rp[2];
#pragma unroll
        for (int bj = 0; bj < 2; ++bj) { const int c8 = u.pn * BM + bj * HALF + col0, d = c8 % 192; rp[bj] = lat && d >= 128; pr[bj] = (d - 128) >> 1; }
#pragma unroll
        for (int ai = 0; ai < 2; ++ai)
#pragma unroll
            for (int m = 0; m < 4; ++m) { const int r = row0 + ai * HALF + m * 16; bf16_t* rowp = O + (size_t)r * u.ldc + col0; const int t = (u.pm * BM + r) & 4095;
#pragma unroll
                for (int bj = 0; bj < 2; ++bj) { f32x4 v0 = acc[ai][bj][m][0] * sc, v1 = acc[ai][bj][m][1] * sc;
                    if (rp[bj]) { const f32x4* cs = (const f32x4*)(rope + (size_t)t * 32 + pr[bj]); const f32x4 c01 = cs[0], c23 = cs[1];
                        f32x4 a, b; a[0] = v0[0] * c01[0] - v0[1] * c01[1]; a[1] = v0[0] * c01[1] + v0[1] * c01[0]; a[2] = v0[2] * c01[2] - v0[3] * c01[3]; a[3] = v0[2] * c01[3] + v0[3] * c01[2];
                        b[0] = v1[0] * c23[0] - v1[1] * c23[1]; b[1] = v1[0] * c23[1] + v1[1] * c23[0]; b[2] = v1[2] * c23[2] - v1[3] * c23[3]; b[3] = v1[2] * c23[3] + v1[3] * c23[2]; v0 = a; v1 = b; }
                    u32x4 w; w.x = cvt_pk_bf16(v0[0], v0[1]); w.y = cvt_pk_bf16(v0[2], v0[3]); w.z = cvt_pk_bf16(v1[0], v1[1]); w.w = cvt_pk_bf16(v1[2], v1[3]);
                    *(u32x4*)(rowp + bj * HALF) = w; } }
    }
};

template <class Epi, class Sched, bool ALIGN_EPI = false, bool SP2 = false>
__device__ __forceinline__ void gemm_phase(LAS unsigned char* lds, const int K, const int lda, const int ldb, const Sched& S, const Epi& E) {
    const int tid = threadIdx.x, wid = __builtin_amdgcn_readfirstlane(tid >> 6), lane = tid & 63, wr = wid >> 2, wc = wid & 3, fr = lane & 15, fq = lane >> 4;
    const int nt = K / BK;
    unsigned voffA[2], voffB[2];
#pragma unroll
    for (int i = 0; i < 2; ++i) { int R, C; stage_rc(tid * 16 + i * 8192, R, C); const int Rb = Epi::PERM ? ((R & ~31) + perm32(R & 31)) : R;
        voffA[i] = (unsigned)(R * lda + C) * 2u; voffB[i] = (unsigned)(Rb * ldb + C) * 2u; }
    const size_t kstep = (size_t)(BK * 2);
    const size_t hstepA = (size_t)HALF * lda * 2, hstepB = (size_t)HALF * ldb * 2;
    const unsigned ldsw = (unsigned)wid * 1024u;
    const int aoff = lds_byte(wr * 64 + fr, fq * 8), boff = lds_byte(wc * 32 + fr, fq * 8);
#define PG8_SA(b, h) (((b) * 2 + (h)) * HTB)
#define PG8_SB(b, h) ((4 + (b) * 2 + (h)) * HTB)
#define PG8_STAGE(bufoff, gbase, voff) do { _Pragma("unroll") for (int _i = 0; _i < 2; ++_i) \
        __builtin_amdgcn_global_load_lds((const unsigned*)((const char*)(gbase) + (voff)[_i]), (LAS unsigned*)(lds + (bufoff) + ldsw + _i * 8192), 16, 0, 0); } while (0)
#define PG8_LDA(dst, b, h) do { _Pragma("unroll") for (int m = 0; m < 4; ++m) _Pragma("unroll") for (int k = 0; k < 2; ++k) dst[m][k] = *(const LAS bf16x8*)(lds + PG8_SA(b, h) + aoff + m * 2048 + k * 1024); } while (0)
#define PG8_LDB(dst, b, h) do { _Pragma("unroll") for (int n = 0; n < 2; ++n) _Pragma("unroll") for (int k = 0; k < 2; ++k) dst[n][k] = *(const LAS bf16x8*)(lds + PG8_SB(b, h) + boff + n * 2048 + k * 1024); } while (0)
#define PG8_MMA(ai, bj, At, Bt) do { __builtin_amdgcn_s_setprio(1); _Pragma("unroll") for (int m = 0; m < 4; ++m) _Pragma("unroll") for (int n = 0; n < 2; ++n) _Pragma("unroll") for (int k = 0; k < 2; ++k) \
        acc[ai][bj][m][n] = __builtin_amdgcn_mfma_f32_16x16x32_bf16(Bt[n][k], At[m][k], acc[ai][bj][m][n], 0, 0, 0); __builtin_amdgcn_s_setprio(0); } while (0)
#define PG8_WAIT_V(n) asm volatile("s_waitcnt vmcnt(" #n ")" ::: "memory")
#define PG8_WAIT_L(n) asm volatile("s_waitcnt lgkmcnt(" #n ")" ::: "memory")
#define PG8_BAR __builtin_amdgcn_s_barrier()
#define PG8_SCHED __builtin_amdgcn_sched_barrier(0)
    Unit cur, nxt; int ui = 0;
    if (!S.next(0, cur)) return;
    f32x4 acc[2][2][4][2];
#pragma unroll
    for (int a = 0; a < 2; ++a)
#pragma unroll
        for (int b = 0; b < 2; ++b)
#pragma unroll
            for (int m = 0; m < 4; ++m)
#pragma unroll
                for (int n = 0; n < 2; ++n) acc[a][b][m][n] = (f32x4){0.f, 0.f, 0.f, 0.f};
    bf16x8 At[4][2], B0[2][2], B1[2][2];
    const char* cA = cur.A; const char* cB = cur.B;
    if constexpr (SP2) {
        PG8_STAGE(PG8_SB(0, 0), cB, voffB); PG8_STAGE(PG8_SB(0, 1), cB + hstepB, voffB); PG8_STAGE(PG8_SA(0, 0), cA, voffA); PG8_STAGE(PG8_SA(0, 1), cA + hstepA, voffA);
        if (wr == 1) PG8_BAR;
        PG8_WAIT_V(2); PG8_BAR;
        PG8_STAGE(PG8_SB(1, 0), cB + kstep, voffB); PG8_STAGE(PG8_SA(1, 0), cA + kstep, voffA); PG8_STAGE(PG8_SB(1, 1), cB + hstepB + kstep, voffB);
        PG8_WAIT_V(6); PG8_BAR;
    } else {
        PG8_STAGE(PG8_SB(0, 0), cB, voffB); PG8_STAGE(PG8_SA(0, 0), cA, voffA); PG8_STAGE(PG8_SB(0, 1), cB + hstepB, voffB); PG8_STAGE(PG8_SA(0, 1), cA + hstepA, voffA);
        if (wr == 1) PG8_BAR;
        PG8_WAIT_V(4); PG8_BAR;
        PG8_STAGE(PG8_SB(1, 0), cB + kstep, voffB); PG8_STAGE(PG8_SA(1, 0), cA + kstep, voffA); PG8_STAGE(PG8_SB(1, 1), cB + hstepB + kstep, voffB);
        PG8_WAIT_V(6); PG8_BAR;
    }
    for (;;) {
        const bool has_next = S.next(ui + 1, nxt);
        const char* nA = has_next ? nxt.A : cA; const char* nB = has_next ? nxt.B : cB;
        for (int t = 0; t < nt; t += 2) {
            const bool last = (t == nt - 2);
            const char* a1 = cA + (size_t)(t + 1) * kstep;
            const char* a2 = last ? nA : cA + (size_t)(t + 2) * kstep; const char* b2 = last ? nB : cB + (size_t)(t + 2) * kstep;
            const char* a3 = a2 + kstep; const char* b3 = b2 + kstep;
            if constexpr (SP2) {
            PG8_LDB(B0, 0, 0); PG8_LDB(B1, 0, 1); PG8_SCHED; PG8_LDA(At, 0, 0); PG8_STAGE(PG8_SA(1, 1), a1 + hstepA, voffA);
            PG8_WAIT_V(8); PG8_WAIT_L(0); PG8_BAR; PG8_MMA(0, 0, At, B0); PG8_MMA(0, 1, At, B1); PG8_BAR; PG8_SCHED;
            PG8_LDA(At, 0, 1); PG8_STAGE(PG8_SB(0, 0), b2, voffB); PG8_STAGE(PG8_SB(0, 1), b2 + hstepB, voffB); PG8_STAGE(PG8_SA(0, 0), a2, voffA);
            PG8_WAIT_V(8); PG8_WAIT_L(0); PG8_BAR; PG8_MMA(1, 0, At, B0); PG8_MMA(1, 1, At, B1); PG8_BAR; PG8_SCHED;
            PG8_LDB(B0, 1, 0); PG8_LDB(B1, 1, 1); PG8_SCHED; PG8_LDA(At, 1, 0); PG8_STAGE(PG8_SA(0, 1), a2 + hstepA, voffA);
            PG8_WAIT_V(8); PG8_WAIT_L(0); PG8_BAR; PG8_MMA(0, 0, At, B0); PG8_MMA(0, 1, At, B1); PG8_BAR; PG8_SCHED;
            PG8_LDA(At, 1, 1); PG8_STAGE(PG8_SB(1, 0), b3, voffB); PG8_STAGE(PG8_SB(1, 1), b3 + hstepB, voffB); PG8_STAGE(PG8_SA(1, 0), a3, voffA);
            PG8_WAIT_V(8); PG8_WAIT_L(0); PG8_BAR; PG8_MMA(1, 0, At, B0); PG8_MMA(1, 1, At, B1); PG8_BAR; PG8_SCHED;
            } else {
            PG8_LDB(B0, 0, 0); PG8_SCHED; PG8_LDA(At, 0, 0); PG8_STAGE(PG8_SA(1, 1), a1 + hstepA, voffA);
            PG8_WAIT_L(8); PG8_BAR; PG8_WAIT_L(0); PG8_MMA(0, 0, At, B0); PG8_BAR; PG8_SCHED;
            PG8_LDB(B1, 0, 1); PG8_STAGE(PG8_SB(0, 0), b2, voffB);
            PG8_BAR; PG8_WAIT_L(0); PG8_MMA(0, 1, At, B1); PG8_BAR;
            PG8_LDA(At, 0, 1); PG8_STAGE(PG8_SA(0, 0), a2, voffA);
            PG8_BAR; PG8_WAIT_L(0); PG8_MMA(1, 0, At, B0); PG8_BAR; PG8_SCHED;
            PG8_STAGE(PG8_SB(0, 1), b2 + hstepB, voffB);
            PG8_WAIT_V(6); PG8_BAR; PG8_MMA(1, 1, At, B1); PG8_BAR;
            PG8_LDB(B0, 1, 0); PG8_SCHED; PG8_LDA(At, 1, 0); PG8_STAGE(PG8_SA(0, 1), a2 + hstepA, voffA);
            PG8_WAIT_L(8); PG8_BAR; PG8_WAIT_L(0); PG8_MMA(0, 0, At, B0); PG8_BAR; PG8_SCHED;
            PG8_LDB(B1, 1, 1); PG8_STAGE(PG8_SB(1, 0), b3, voffB);
            PG8_BAR; PG8_WAIT_L(0); PG8_MMA(0, 1, At, B1); PG8_BAR;
            PG8_LDA(At, 1, 1); PG8_STAGE(PG8_SA(1, 0), a3, voffA);
            PG8_BAR; PG8_WAIT_L(0); PG8_MMA(1, 0, At, B0); PG8_BAR; PG8_SCHED;
            PG8_STAGE(PG8_SB(1, 1), b3 + hstepB, voffB);
            PG8_WAIT_V(6); PG8_BAR; PG8_MMA(1, 1, At, B1); PG8_BAR;
            }
        }
        if constexpr (ALIGN_EPI) { if (wr == 0) PG8_BAR; }
        E(acc, cur, wr, wc, fr, fq);
        if (!has_next) break;
#pragma unroll
        for (int a = 0; a < 2; ++a)
#pragma unroll
            for (int b = 0; b < 2; ++b)
#pragma unroll
                for (int m = 0; m < 4; ++m)
#pragma unroll
                    for (int n = 0; n < 2; ++n) acc[a][b][m][n] = (f32x4){0.f, 0.f, 0.f, 0.f};
        cur = nxt; cA = nA; cB = nB; ++ui;
        if constexpr (ALIGN_EPI) { if (wr == 1) PG8_BAR; }
    }
    PG8_WAIT_V(0);
    if constexpr (!ALIGN_EPI) { if (wr == 0) PG8_BAR; }
    PG8_BAR;
#undef PG8_SA
#undef PG8_SB
#undef PG8_STAGE
#undef PG8_LDA
#undef PG8_LDB
#undef PG8_MMA
#undef PG8_WAIT_V
#undef PG8_WAIT_L
#undef PG8_BAR
#undef PG8_SCHED
}
}

#define XB_TMO      128
#define XB_XCNT(j)  (256  + 64 * (j))
#define XB_XSUB(j)  (1280 + 64 * (j))
#define XB_XGEN(j)  (2304 + 64 * (j))
#define XB_TOP      3328
#define XB_TOPGEN   3392
#define XCD_BAR_WORDS 3456
#define XB_SPIN_CAP (1u << 24)

__device__ __forceinline__ unsigned xb_ld(unsigned* p)              { return __hip_atomic_load(p, __ATOMIC_RELAXED, __HIP_MEMORY_SCOPE_AGENT); }
__device__ __forceinline__ unsigned xb_add(unsigned* p, unsigned v) { return __hip_atomic_fetch_add(p, v, __ATOMIC_RELAXED, __HIP_MEMORY_SCOPE_AGENT); }
__device__ __forceinline__ unsigned xb_xcc_id() { return (unsigned)__builtin_amdgcn_s_getreg((3 << 11) | 20) & 0xFu; }
#define XB_SPIN(cond, bar) do { unsigned _sp = 0; while (cond) { __builtin_amdgcn_s_sleep(1); \
    if ((++_sp & 255u) == 0u) { if (xb_ld(&(bar)[XB_TMO])) break; if (_sp > XB_SPIN_CAP) { atomicAdd(&(bar)[XB_TMO], 1u); break; } } } } while (0)

struct XcdBarrier {
    unsigned* bar; unsigned x;
    volatile LAS unsigned* st;
};
__device__ __forceinline__ XcdBarrier xcd_barrier_post(unsigned* bar, volatile LAS unsigned* st) {
    XcdBarrier b; b.bar = bar; b.x = xb_xcc_id(); b.st = st;
    if (threadIdx.x == 0) (void)xb_add(&bar[XB_XCNT(b.x)], 1u);
    return b;
}
__device__ __forceinline__ void xcd_barrier_complete(unsigned* bar, unsigned x, unsigned& nloc, unsigned& nx) {
    const unsigned G = gridDim.x * gridDim.y * gridDim.z;
    unsigned sum, cnt, mine, sp = 0u;
    for (;;) {
        sum = 0u; cnt = 0u; mine = 0u;
#pragma unroll
        for (unsigned j = 0; j < 16; ++j) { const unsigned c = xb_ld(&bar[XB_XCNT(j)]); sum += c; cnt += (c > 0u) ? 1u : 0u; mine = (j == x) ? c : mine; }
        if (sum == G) break;
        __builtin_amdgcn_s_sleep(1);
        if ((++sp & 255u) == 0u) { if (xb_ld(&bar[XB_TMO])) break; if (sp > XB_SPIN_CAP) { atomicAdd(&bar[XB_TMO], 1u); break; } }
    }
    nloc = mine > 0u ? mine : 1u; nx = cnt > 0u ? cnt : 1u;
}
__device__ __forceinline__ void xcd_barrier(const XcdBarrier& b) {
    asm volatile("s_waitcnt vmcnt(0)" ::: "memory");
    __syncthreads();
    if (threadIdx.x == 0) {
        unsigned* bar = b.bar;
        __builtin_amdgcn_s_waitcnt(0);
        unsigned nloc = b.st[0], nx = b.st[1];
        if (nloc == 0u) { xcd_barrier_complete(bar, b.x, nloc, nx); b.st[0] = nloc; b.st[1] = nx; }
        const unsigned old = xb_add(&bar[XB_XSUB(b.x)], 1u);
        const unsigned gen = old / nloc;
        if (old + 1u == (gen + 1u) * nloc) {
            __builtin_amdgcn_fence(__ATOMIC_RELEASE, "agent");
            asm volatile("s_waitcnt vmcnt(0)" ::: "memory");
            const unsigned og = xb_add(&bar[XB_TOP], 1u);
            const unsigned tg = og / nx;
            if (og + 1u == (tg + 1u) * nx) xb_add(&bar[XB_TOPGEN], 1u);
            else XB_SPIN(xb_ld(&bar[XB_TOPGEN]) == tg, bar);
            __builtin_amdgcn_fence(__ATOMIC_ACQUIRE, "agent");
            xb_add(&bar[XB_XGEN(b.x)], 1u);
            asm volatile("s_waitcnt vmcnt(0)" ::: "memory");
        } else {
            XB_SPIN(xb_ld(&bar[XB_XGEN(b.x)]) == gen, bar);
            __builtin_amdgcn_fence(__ATOMIC_ACQUIRE, "agent");
            asm volatile("s_waitcnt vmcnt(0)" ::: "memory");
        }
    }
    __syncthreads();
}

struct XDesc { int in_idx; long long src_off; int K, N; long long dst; int ldt; int mode; int row_off; };
constexpr int NXD = 28;
__constant__ XDesc c_xd[NXD] = {
    {10, 0LL * 2048 * 5632, 2048, 5632, (long long)(WS_WGU + 0 * SZ_WGU), 2048, 1, 0}, {11, 0LL * 2048 * 5632, 2048, 5632, (long long)(WS_WGU + 0 * SZ_WGU), 2048, 2, 0}, {12, 0LL * 5632 * 2048, 5632, 2048, (long long)(WS_WD + 0 * SZ_WD), 5632, 0, 0},
    {10, 1LL * 2048 * 5632, 2048, 5632, (long long)(WS_WGU + 1 * SZ_WGU), 2048, 1, 0}, {11, 1LL * 2048 * 5632, 2048, 5632, (long long)(WS_WGU + 1 * SZ_WGU), 2048, 2, 0}, {12, 1LL * 5632 * 2048, 5632, 2048, (long long)(WS_WD + 1 * SZ_WD), 5632, 0, 0},
    {10, 2LL * 2048 * 5632, 2048, 5632, (long long)(WS_WGU + 2 * SZ_WGU), 2048, 1, 0}, {11, 2LL * 2048 * 5632, 2048, 5632, (long long)(WS_WGU + 2 * SZ_WGU), 2048, 2, 0}, {12, 2LL * 5632 * 2048, 5632, 2048, (long long)(WS_WD + 2 * SZ_WD), 5632, 0, 0},
    {10, 3LL * 2048 * 5632, 2048, 5632, (long long)(WS_WGU + 3 * SZ_WGU), 2048, 1, 0}, {11, 3LL * 2048 * 5632, 2048, 5632, (long long)(WS_WGU + 3 * SZ_WGU), 2048, 2, 0}, {12, 3LL * 5632 * 2048, 5632, 2048, (long long)(WS_WD + 3 * SZ_WD), 5632, 0, 0},
    {13, 0LL * 2048 * 512, 2048, 512, (long long)(WS_W1 + 0 * SZ_W1), 2048, 0, 0}, {16, 0LL * 2048 * 512, 2048, 512, (long long)(WS_W1 + 0 * SZ_W1), 2048, 0, 512}, {18, 0LL * 2048 * 64, 2048, 64, (long long)(WS_W1 + 0 * SZ_W1), 2048, 0, 1024},
    {15, 0LL * 512 * 3072, 512, 3072, (long long)(WS_WUQ + 0 * SZ_WUQ), 512, 0, 0}, {19, 0LL * 512 * 4096, 512, 4096, (long long)(WS_WUKV + 0 * SZ_WUKV), 512, 0, 0}, {20, 0LL * 2048 * 2048, 2048, 2048, (long long)(WS_WO + 0 * SZ_WO), 2048, 0, 0},
    {13, 1LL * 2048 * 512, 2048, 512, (long long)(WS_W1 + 1 * SZ_W1), 2048, 0, 0}, {16, 1LL * 2048 * 512, 2048, 512, (long long)(WS_W1 + 1 * SZ_W1), 2048, 0, 512}, {18, 1LL * 2048 * 64, 2048, 64, (long long)(WS_W1 + 1 * SZ_W1), 2048, 0, 1024},
    {15, 1LL * 512 * 3072, 512, 3072, (long long)(WS_WUQ + 1 * SZ_WUQ), 512, 0, 0}, {19, 1LL * 512 * 4096, 512, 4096, (long long)(WS_WUKV + 1 * SZ_WUKV), 512, 0, 0}, {20, 1LL * 2048 * 2048, 2048, 2048, (long long)(WS_WO + 3 * SZ_WO), 2048, 0, 0},
    {21, 0, 2048, 6144, (long long)WS_WIN, 2048, 0, 0}, {34, 0, 2048, 2048, (long long)(WS_WO + 1 * SZ_WO), 2048, 0, 0}, {31, 0, 64, 8192, (long long)WS_W3, 256, 0, 0},
    {36, 0, 2048, 2048, (long long)(WS_WO + 2 * SZ_WO), 2048, 0, 0},
};
__device__ __forceinline__ void transpose_item(const float* W, int ldw, bf16_t* WT, int ldt, int k0, int n0, int drow0, LAS float* scr, int lane) {
#pragma unroll 8
    for (int i = 0; i < 32; ++i) { const int kk = 2 * i + (lane >> 5); scr[kk * 33 + (lane & 31)] = W[(size_t)(k0 + kk) * ldw + n0 + (lane & 31)]; }
    LDS_WAIT(); asm volatile("" ::: "memory");
    const int c = lane & 7;
#pragma unroll
    for (int j = 0; j < 4; ++j) { const int n = (lane >> 3) + 8 * j; const LAS float* s = scr + (8 * c) * 33 + n;
        v4u o; o.x = pk2(s[0 * 33], s[1 * 33]); o.y = pk2(s[2 * 33], s[3 * 33]); o.z = pk2(s[4 * 33], s[5 * 33]); o.w = pk2(s[6 * 33], s[7 * 33]);
        *(GAS v4u*)(WT + (size_t)(drow0 + n) * ldt + k0 + 8 * c) = o; }
    LDS_WAIT(); asm volatile("" ::: "memory");
}

struct Args { const float* in[38]; float* out; unsigned char* ws; int ph_lo, ph_hi, li, pad; };
enum { I_XP = 0, I_XS, I_C, I_CCKV, I_CKR, I_CCTX, I_ADAW, I_ADAB, I_LNG, I_LNB, I_FG, I_FU, I_FD, I_DQ, I_QN, I_UQ, I_DKV, I_KVN, I_WKR, I_UKV, I_WOM,
       I_HWIN, I_HBIN, I_HCW, I_HCB, I_HW1, I_HB1, I_HFR1, I_HW2, I_HB2, I_HFR2, I_HW3, I_HDEC, I_HSKIP, I_HWOUT, I_HBOUT, I_FNW, I_FNB };
constexpr size_t OUT_CKV = (size_t)NTOK * D, OUT_KR = OUT_CKV + (size_t)16 * 2 * 256 * 512;

__device__ __forceinline__ int group_of_row(int row) { return row < NCTX ? 0 : (row < NCTX + 4096 ? 1 : 2); }
__device__ __forceinline__ int kvrow_of_row(int row) { return row < NCTX ? row : (row < NCTX + 4096 ? row : row + 512); }

__device__ __forceinline__ void p0_prologue(const Args& a, LAS unsigned char* lds, int tid, int lane, int wave, int vcu, int G) {
    unsigned char* ws = a.ws;
    const int gw = vcu * NWAVES + wave, NGW = G * NWAVES; const size_t gt = (size_t)vcu * NTHREADS + tid, NGT = (size_t)G * NTHREADS;
    { LAS float* scr = (LAS float*)(lds + wave * 16384);
      for (int d = 0; d < NXD; ++d) {
        const XDesc x = c_xd[d]; const float* W = a.in[x.in_idx] + x.src_off; bf16_t* WT = (bf16_t*)(ws + x.dst); const int nnb = x.N / 32, items = (x.K / 64) * nnb;
        for (int it = gw; it < items; it += NGW) { const int kb = it / nnb, nb = it - kb * nnb, n0 = 32 * nb;
            const int drow0 = x.mode == 0 ? x.row_off + n0 : ((n0 >> 7) * 256 + (n0 & 127) + (x.mode == 2 ? 128 : 0));
            transpose_item(W, x.N, WT, x.ldt, 64 * kb, n0, drow0, scr, lane); }
      } }
    { const v4u z = {0u, 0u, 0u, 0u};
      for (size_t i = gt; i < (size_t)2 * 192 * 256; i += NGT) { const int j = (int)(i / (192 * 256)); const size_t r = i % (192 * 256); *(GAS v4u*)(ws + WS_W1 + j * SZ_W1 + (size_t)1088 * 2048 * 2 + r * 16) = z; }
      for (size_t i = gt; i < (size_t)8192 * 24; i += NGT) { const size_t row = i / 24, ch = i % 24; *(GAS v4u*)(ws + WS_W3 + row * 512 + 128 + ch * 16) = z; } }
    { for (size_t i = gt; i < (size_t)512 * 32; i += NGT) { const int row = (int)(i >> 5), c8 = (int)(i & 31) * 8, part = row >> 8, m = row & 255; float v[8];
#pragma unroll
          for (int j = 0; j < 8; ++j) { const int r = (m * (c8 + j)) & 255; float s, c; sincospif((float)r * (1.0f / 128.0f), &s, &c); v[j] = part ? s : c; }
          v4u o; o.x = pk2(v[0], v[1]); o.y = pk2(v[2], v[3]); o.z = pk2(v[4], v[5]); o.w = pk2(v[6], v[7]); *(GAS v4u*)(ws + WS_DFTC + i * 16) = o; }
      for (size_t i = gt; i < (size_t)256 * 64; i += NGT) { const int k = (int)(i >> 6), c8 = (int)(i & 63) * 8; float v[8];
#pragma unroll
          for (int j = 0; j < 8; ++j) { const int col = c8 + j, l = col & 255, r = (k * l) & 255; float s, c; sincospif((float)r * (1.0f / 128.0f), &s, &c); v[j] = (col < 256 ? c : -s) * (1.0f / 256.0f); }
          v4u o; o.x = pk2(v[0], v[1]); o.y = pk2(v[2], v[3]); o.z = pk2(v[4], v[5]); o.w = pk2(v[6], v[7]); *(GAS v4u*)(ws + WS_DMC + i * 16) = o; }
      for (size_t i = gt; i < (size_t)4096 * 1024; i += NGT) { const int k = (int)(i >> 10), c8 = (int)(i & 1023) * 8; float v[8];
#pragma unroll
          for (int j = 0; j < 8; ++j) { const int col = c8 + j, l = col & 4095, r = (k * l) & 4095; float s, c; sincospif((float)r * (1.0f / 2048.0f), &s, &c); v[j] = (col < 4096 ? c : -s) * (1.0f / 1024.0f); }
          v4u o; o.x = pk2(v[0], v[1]); o.y = pk2(v[2], v[3]); o.z = pk2(v[4], v[5]); o.w = pk2(v[6], v[7]); *(GAS v4u*)(ws + WS_DML + i * 16) = o; } }
    { f32x2* rope = (f32x2*)(ws + WS_ROPE);
      for (size_t i = gt; i < (size_t)4096 * 32; i += NGT) { const int t = (int)(i >> 5), p = (int)(i & 31); const float inv = exp2f(-(float)(p & 15) * (13.287712379549449f / 16.0f));
          const float ang = (float)(p < 16 ? (t >> 6) : (t & 63)) * inv; float s, c; sincosf(ang, &s, &c); rope[i] = (f32x2){c, s}; } }
    { for (size_t i = gt; i < (size_t)2 * 2 * 512 * 64; i += NGT) { const int r8 = (int)(i & 63) * 8, p = (int)(i >> 6) & 511, lb = (int)(i >> 15) & 1, j = (int)(i >> 16);
          const float* s = a.in[I_CCKV] + ((size_t)(lb * 2 + j) * 512 + p) * 512 + r8; const f32x4 x0 = *(const f32x4*)s, x1 = *(const f32x4*)(s + 4);
          v4u o; o.x = pk2(x0[0], x0[1]); o.y = pk2(x0[2], x0[3]); o.z = pk2(x1[0], x1[1]); o.w = pk2(x1[2], x1[3]);
          *(GAS v4u*)(ws + WS_CKVN + (size_t)j * NKV * 512 * 2 + ((size_t)(4096 + lb * 4608 + 4096 + p) * 512 + r8) * 2) = o; }
      for (size_t i = gt; i < (size_t)2 * 2 * 512 * 8; i += NGT) { const int r8 = (int)(i & 7) * 8, p = (int)(i >> 3) & 511, lb = (int)(i >> 12) & 1, j = (int)(i >> 13);
          const float* s = a.in[I_CKR] + ((size_t)(lb * 2 + j) * 512 + p) * 64 + r8; const f32x4 x0 = *(const f32x4*)s, x1 = *(const f32x4*)(s + 4);
          v4u o; o.x = pk2(x0[0], x0[1]); o.y = pk2(x0[2], x0[3]); o.z = pk2(x1[0], x1[1]); o.w = pk2(x1[2], x1[3]);
          *(GAS v4u*)(ws + WS_KR + (size_t)j * al256((size_t)NKV * 64 * 2) + ((size_t)(4096 + lb * 4608 + 4096 + p) * 64 + r8) * 2) = o; } }
    { const float* w1 = a.in[I_HW1]; const float* w2 = a.in[I_HW2]; bf16_t* hf2 = (bf16_t*)(ws + WS_HF2);
      const float b1 = a.in[I_HB1][lane], fr1 = a.in[I_HFR1][lane], b2 = a.in[I_HB2][lane], fr2 = a.in[I_HFR2][lane];
      for (int pos = gw; pos < FILT_LD; pos += NGW) { const int L = pos < 4096 ? 4096 : 256, t = pos < 4096 ? pos : pos - 4096;
          float feat = 0.f;
          if (lane == 0) feat = (float)t / (float)(L - 1);
          else if (lane <= 32) { const int b = (lane - 1) & 15; const float band = 1e-4f + (float)b * ((15.0f - 1e-4f) / 15.0f); const float turns = (float)t * band / (float)L; float s, c; sincospif(2.0f * turns, &s, &c); feat = lane <= 16 ? c : -s; }
          float z = b1;
#pragma unroll
          for (int k = 0; k < 33; ++k) z += __shfl(feat, k) * w1[k * 64 + lane];
          const float h1 = sinf(fr1 * z); float z2 = b2;
#pragma unroll 8
          for (int k = 0; k < 64; ++k) z2 += __shfl(h1, k) * w2[k * 64 + lane];
          const float h2 = sinf(fr2 * z2);
          bf16_t* row = hf2 + (size_t)pos * 256; row[lane] = (bf16_t)f2bf(h2); row[64 + lane] = 0; row[128 + lane] = 0; row[192 + lane] = 0; } }
    __syncthreads();
    { LAS float* S = (LAS float*)lds; LAS float* red = (LAS float*)(lds + 24576); float* mod = (float*)(ws + WS_MOD);
      for (int i = tid; i < 3 * 2048; i += NTHREADS) { const int g = i >> 11, k = i & 2047; const float x = g == 0 ? a.in[I_CCTX][k] : a.in[I_C][(g - 1) * 2048 + k]; S[i] = x / (1.0f + __expf(-x)); }
      __syncthreads();
      const int q = tid & 15, kc = tid >> 4;
      for (int it = vcu; it < 768; it += G) { const int l = it / 192, n0 = (it % 192) * 64;
          const float* Wp = a.in[I_ADAW] + (size_t)l * 2048 * 12288 + (size_t)(kc * 64) * 12288 + n0 + 4 * q;
          f32x4 a0 = {0.f, 0.f, 0.f, 0.f}, a1 = a0, a2 = a0;
#pragma unroll 8
          for (int kk = 0; kk < 64; ++kk) { const f32x4 w = *(const f32x4*)(Wp + (size_t)kk * 12288); const int k = kc * 64 + kk; a0 += w * S[k]; a1 += w * S[2048 + k]; a2 += w * S[4096 + k]; }
#pragma unroll
          for (int j = 0; j < 4; ++j) { red[(kc * 3 + 0) * 64 + 4 * q + j] = a0[j]; red[(kc * 3 + 1) * 64 + 4 * q + j] = a1[j]; red[(kc * 3 + 2) * 64 + 4 * q + j] = a2[j]; }
          __syncthreads();
          if (tid < 192) { const int g = tid >> 6, col = tid & 63; float s = a.in[I_ADAB][l * 12288 + n0 + col];
#pragma unroll 8
              for (int k2 = 0; k2 < 32; ++k2) s += red[(k2 * 3 + g) * 64 + col];
              mod[(size_t)(l * 3 + g) * 12288 + n0 + col] = s; }
          __syncthreads(); } }
}

__device__ __forceinline__ void p1_embed(const Args& a, int lane, int wave, int vcu, int G) {
    unsigned char* ws = a.ws; const float* mod = (const float*)(ws + WS_MOD); bf16_t* H = (bf16_t*)(ws + WS_H); bf16_t* U = (bf16_t*)(ws + WS_U);
    for (int row = vcu * NWAVES + wave; row < NTOK; row += G * NWAVES) {
        const float* x = row < NCTX ? a.in[I_XP] + (size_t)row * D : a.in[I_XS] + (size_t)(row - NCTX) * D; const int g = group_of_row(row);
        const float* sh = mod + (size_t)(0 * 3 + g) * 12288 + 0 * 2048; const float* sc = sh + 2048;
#pragma unroll
        for (int j = 0; j < 4; ++j) { const int c = 512 * j + 8 * lane; float v[8], u[8];
#pragma unroll
            for (int h = 0; h < 2; ++h) { const f32x4 xv = *(const f32x4*)(x + c + 4 * h), s1 = *(const f32x4*)(sc + c + 4 * h), s0 = *(const f32x4*)(sh + c + 4 * h);
#pragma unroll
                for (int e = 0; e < 4; ++e) { v[4 * h + e] = xv[e]; u[4 * h + e] = xv[e] * (1.0f + s1[e]) + s0[e]; } }
            v4u o; o.x = pk2(v[0], v[1]); o.y = pk2(v[2], v[3]); o.z = pk2(v[4], v[5]); o.w = pk2(v[6], v[7]); *(GAS v4u*)(H + (size_t)row * D + c) = o;
            o.x = pk2(u[0], u[1]); o.y = pk2(u[2], u[3]); o.z = pk2(u[4], u[5]); o.w = pk2(u[6], u[7]); *(GAS v4u*)(U + (size_t)row * D + c) = o; }
    }
}

__device__ __forceinline__ void ln_phase(const Args& a, LAS unsigned char* lds, int tid, int lane, int wave, int vcu, int G, int l, int gi, int lni, const float* bias, int ln, int si, bool final) {
    unsigned char* ws = a.ws; const float* mod = (const float*)(ws + WS_MOD); bf16_t* H = (bf16_t*)(ws + WS_H); bf16_t* U = (bf16_t*)(ws + WS_U);
    const float* P0 = (const float*)(ws + WS_PART); const float* P1 = P0 + (size_t)NTOK * D;
    LAS float* V = (LAS float*)lds;
    for (int blk = vcu; blk < NTOK / 16; blk += G) {
        const int g = group_of_row(blk * 16);
        __syncthreads();
        for (int i = tid; i < 6 * 2048; i += NTHREADS) { const int v = i >> 11, c = i & 2047; float x;
            if (v == 0) x = mod[(size_t)(l * 3 + g) * 12288 + gi * 2048 + c]; else if (v == 1) x = bias ? bias[c] : 0.f; else if (v == 2) x = a.in[I_LNG][(l * 2 + lni) * 2048 + c];
            else if (v == 3) x = a.in[I_LNB][(l * 2 + lni) * 2048 + c]; else if (v == 4) x = final ? 0.f : mod[(size_t)(ln * 3 + g) * 12288 + si * 2048 + c]; else x = final ? 0.f : mod[(size_t)(ln * 3 + g) * 12288 + (si + 1) * 2048 + c];
            V[i] = x; }
        __syncthreads();
#pragma unroll 1
        for (int rr = 0; rr < 2; ++rr) { const int row = blk * 16 + wave * 2 + rr; float x[32]; float s = 0.f;
            v4u hv[4]; f32x4 pa[4][2], pb[4][2];
#pragma unroll
            for (int j = 0; j < 4; ++j) { const int c = 512 * j + 8 * lane; hv[j] = *(const GAS v4u*)(H + (size_t)row * D + c);
#pragma unroll
                for (int h = 0; h < 2; ++h) { pa[j][h] = *(const f32x4*)(P0 + (size_t)row * D + c + 4 * h); pb[j][h] = *(const f32x4*)(P1 + (size_t)row * D + c + 4 * h); } }
            asm volatile("" ::: "memory");
#pragma unroll
            for (int j = 0; j < 4; ++j) { const int c = 512 * j + 8 * lane; const unsigned hw[4] = {hv[j].x, hv[j].y, hv[j].z, hv[j].w};
#pragma unroll
                for (int h = 0; h < 2; ++h) { const f32x4 gt = *(const LAS f32x4*)(V + c + 4 * h), bs = *(const LAS f32x4*)(V + 2048 + c + 4 * h);
#pragma unroll
                    for (int e = 0; e < 4; ++e) { const float hh = (e & 1) ? bfhi(hw[2 * h + (e >> 1)]) : bflo(hw[2 * h + (e >> 1)]);
                        const float v = DN_ALPHA * hh + gt[e] * (pa[j][h][e] + pb[j][h][e] + bs[e]); x[8 * j + 4 * h + e] = v; s += v; } }
                asm volatile("" ::: "memory"); }
            const float mean = wave_sum(s) * (1.0f / D); float q = 0.f;
#pragma unroll
            for (int i = 0; i < 32; ++i) { x[i] -= mean; q += x[i] * x[i]; }
            const float rstd = 1.0f / sqrtf(wave_sum(q) * (1.0f / D) + LN_EPS);
#pragma unroll
            for (int j = 0; j < 4; ++j) { const int c = 512 * j + 8 * lane; float hn[8], u[8];
#pragma unroll
                for (int h = 0; h < 2; ++h) { const f32x4 lg = *(const LAS f32x4*)(V + 2 * 2048 + c + 4 * h), lb = *(const LAS f32x4*)(V + 3 * 2048 + c + 4 * h), sh = *(const LAS f32x4*)(V + 4 * 2048 + c + 4 * h), sc = *(const LAS f32x4*)(V + 5 * 2048 + c + 4 * h);
#pragma unroll
                    for (int e = 0; e < 4; ++e) { hn[4 * h + e] = x[8 * j + 4 * h + e] * rstd * lg[e] + lb[e]; u[4 * h + e] = hn[4 * h + e] * (1.0f + sc[e]) + sh[e]; } }
                if (final) { float* o = a.out + (size_t)row * D + c; *(f32x4*)o = (f32x4){hn[0], hn[1], hn[2], hn[3]}; *(f32x4*)(o + 4) = (f32x4){hn[4], hn[5], hn[6], hn[7]}; }
                else { v4u o; o.x = pk2(hn[0], hn[1]); o.y = pk2(hn[2], hn[3]); o.z = pk2(hn[4], hn[5]); o.w = pk2(hn[6], hn[7]); *(GAS v4u*)(H + (size_t)row * D + c) = o;
                    o.x = pk2(u[0], u[1]); o.y = pk2(u[2], u[3]); o.z = pk2(u[4], u[5]); o.w = pk2(u[6], u[7]); *(GAS v4u*)(U + (size_t)row * D + c) = o; }
                asm volatile("" ::: "memory"); }
        }
    }
    __syncthreads();
}

__device__ __forceinline__ void mla_norm_phase(const Args& a, int lane, int wave, int vcu, int G, int j) {
    unsigned char* ws = a.ws; const float* T1 = (const float*)(ws + WS_T1); bf16_t* QL = (bf16_t*)(ws + WS_QL);
    bf16_t* CK = (bf16_t*)(ws + WS_CKVN + (size_t)j * NKV * 512 * 2); bf16_t* KR = (bf16_t*)(ws + WS_KR + (size_t)j * al256((size_t)NKV * 64 * 2)); const f32x2* rope = (const f32x2*)(ws + WS_ROPE);
    const float* qn = a.in[I_QN] + j * 512 + 8 * lane; const float* kn = a.in[I_KVN] + j * 512 + 8 * lane;
    for (int row = vcu * NWAVES + wave; row < NTOK; row += G * NWAVES) {
        const float* t = T1 + (size_t)row * 1280; const int kvr = kvrow_of_row(row);
        float q[8], k[8]; float sq = 0.f, sk = 0.f;
        { const f32x4 a0 = *(const f32x4*)(t + 8 * lane), a1 = *(const f32x4*)(t + 8 * lane + 4), b0 = *(const f32x4*)(t + 512 + 8 * lane), b1 = *(const f32x4*)(t + 512 + 8 * lane + 4);
#pragma unroll
          for (int e = 0; e < 4; ++e) { q[e] = a0[e]; q[4 + e] = a1[e]; k[e] = b0[e]; k[4 + e] = b1[e]; } }
#pragma unroll
        for (int e = 0; e < 8; ++e) { sq += q[e] * q[e]; sk += k[e] * k[e]; }
        const float rq = 1.0f / sqrtf(wave_sum(sq) * (1.0f / 512.0f) + RMS_EPS), rk = 1.0f / sqrtf(wave_sum(sk) * (1.0f / 512.0f) + RMS_EPS);
#pragma unroll
        for (int e = 0; e < 8; ++e) { q[e] = q[e] * rq * qn[e]; k[e] = k[e] * rk * kn[e]; }
        v4u o; o.x = pk2(q[0], q[1]); o.y = pk2(q[2], q[3]); o.z = pk2(q[4], q[5]); o.w = pk2(q[6], q[7]); *(GAS v4u*)(QL + (size_t)row * 512 + 8 * lane) = o;
        o.x = pk2(k[0], k[1]); o.y = pk2(k[2], k[3]); o.z = pk2(k[4], k[5]); o.w = pk2(k[6], k[7]); *(GAS v4u*)(CK + (size_t)kvr * 512 + 8 * lane) = o;
        float kr = t[1024 + lane];
        if (row < NCTX) { const int b = row >> 8, tt = row & 255; float* oc = a.out + OUT_CKV + ((size_t)(b * 2 + j) * 256 + tt) * 512 + 8 * lane;
            *(f32x4*)oc = (f32x4){k[0], k[1], k[2], k[3]}; *(f32x4*)(oc + 4) = (f32x4){k[4], k[5], k[6], k[7]};
            a.out[OUT_KR + ((size_t)(b * 2 + j) * 256 + tt) * 64 + lane] = kr; }
        else { const int tp = (row - NCTX) & 4095; const f32x2 cs = rope[(size_t)tp * 32 + (lane >> 1)]; const float other = __shfl_xor(kr, 1);
            kr = (lane & 1) ? (other * cs[1] + kr * cs[0]) : (kr * cs[0] - other * cs[1]); }
        KR[(size_t)kvr * 64 + lane] = (bf16_t)f2bf(kr);
    }
}

__device__ __forceinline__ void attn_naive_phase(const Args& a, int lane, int wave, int vcu, int G, int j) {
    unsigned char* ws = a.ws; const bf16_t* Q = (const bf16_t*)(ws + WS_Q); const bf16_t* KV = (const bf16_t*)(ws + WS_KV);
    const bf16_t* KR = (const bf16_t*)(ws + WS_KR + (size_t)j * al256((size_t)NKV * 64 * 2)); bf16_t* O = (bf16_t*)(ws + WS_MIXO);
    for (int pair = vcu * NWAVES + wave; pair < NTOK * 16; pair += G * NWAVES) {
        const int row = pair >> 4, h = pair & 15; int kv0, nk;
        if (row < NCTX) { kv0 = (row >> 8) * 256; nk = 256; } else { const int lb = (row - NCTX) >> 12; kv0 = 4096 + lb * 4608; nk = 4608; }
        const bf16_t* qp = Q + (size_t)row * 3072 + h * 192; const float q0 = bf2f(qp[lane]), q1 = bf2f(qp[64 + lane]), q2 = bf2f(qp[128 + lane]);
        float m = -1e30f, l = 0.f, o0 = 0.f, o1 = 0.f;
        for (int key = 0; key < nk; key += 4) { float s[4], v0[4], v1[4];
#pragma unroll
            for (int u = 0; u < 4; ++u) { const bf16_t* kp = KV + (size_t)(kv0 + key + u) * 4096 + h * 256;
                s[u] = q0 * bf2f(kp[lane]) + q1 * bf2f(kp[64 + lane]) + q2 * bf2f(KR[(size_t)(kv0 + key + u) * 64 + lane]); v0[u] = bf2f(kp[128 + lane]); v1[u] = bf2f(kp[192 + lane]); }
#pragma unroll
            for (int u = 0; u < 4; ++u) s[u] = wave_sum(s[u]);
#pragma unroll
            for (int u = 0; u < 4; ++u) { const float mn = fmaxf(m, s[u]), al = exp2f(m - mn), p = exp2f(s[u] - mn); l = l * al + p; o0 = o0 * al + p * v0[u]; o1 = o1 * al + p * v1[u]; m = mn; }
        }
        const float il = 1.0f / l; O[(size_t)row * D + h * 128 + lane] = (bf16_t)f2bf(o0 * il); O[(size_t)row * D + h * 128 + 64 + lane] = (bf16_t)f2bf(o1 * il);
    }
}

__device__ __forceinline__ void transpose_zt_phase(const Args& a, LAS unsigned char* lds, int lane, int wave, int vcu, int G) {
    const bf16_t* ZT = (const bf16_t*)(a.ws + WS_ZT); bf16_t* Z = (bf16_t*)(a.ws + WS_MIXO); LAS bf16_t* scr = (LAS bf16_t*)(lds + wave * 16384);
    for (int tile = vcu * NWAVES + wave; tile < 32 * 192; tile += G * NWAVES) { const int c0 = (tile / 192) * 64, t0 = (tile % 192) * 64;
#pragma unroll 8
        for (int i = 0; i < 64; ++i) scr[i * 66 + lane] = ZT[(size_t)(c0 + i) * NTOK + t0 + lane];
        LDS_WAIT(); asm volatile("" ::: "memory");
#pragma unroll 8
        for (int t = 0; t < 64; ++t) Z[(size_t)(t0 + t) * D + c0 + lane] = scr[lane * 66 + t];
        LDS_WAIT(); asm volatile("" ::: "memory"); }
}

struct SchedGrid {
    const char* A; const char* B; char* O;
    size_t a_pm, b_pn, a_s, b_s, o_pm, o_pn, o_s;
    int ldc, nM, nN, nS, G, c;
    __device__ __forceinline__ bool next(int i, pg8::Unit& u) const {
        const int L = i * G + c, per = nM * nN; if (L >= per * nS) return false;
        const int s = L / per; int pm, pn; pg8::tile_of(L - s * per, nM, nN, pm, pn);
        u.A = A + pm * a_pm + s * a_s; u.B = B + pn * b_pn + s * b_s; u.O = O + pm * o_pm + pn * o_pn + s * o_s; u.ldc = ldc; u.pm = pm; u.pn = pn; u.aux = s; return true;
    }
};
struct SchedPair {
    SchedGrid g0, g1; int G, c;
    __device__ __forceinline__ bool next(int i, pg8::Unit& u) const {
        const int L = i * G + c, n0 = g0.nM * g0.nN;
        if (L < n0) { int pm, pn; pg8::tile_of(L, g0.nM, g0.nN, pm, pn); u.A = g0.A + pm * g0.a_pm; u.B = g0.B + pn * g0.b_pn; u.O = g0.O + pm * g0.o_pm + pn * g0.o_pn; u.ldc = g0.ldc; u.pm = pm; u.pn = pn; u.aux = 0; return true; }
        const int L1 = L - n0; if (L1 >= g1.nM * g1.nN) return false;
        int pm, pn; pg8::tile_of(L1, g1.nM, g1.nN, pm, pn); u.A = g1.A + pm * g1.a_pm; u.B = g1.B + pn * g1.b_pn; u.O = g1.O + pm * g1.o_pm + pn * g1.o_pn; u.ldc = g1.ldc; u.pm = pm; u.pn = pn; u.aux = 1; return true;
    }
};
struct SchedF1 {
    const char* dftc; const char* U; char* atc; char* atl; int G, c;
    __device__ __forceinline__ bool next(int i, pg8::Unit& u) const {
        const int L = i * G + c; if (L >= 768) return false;
        const int part = L & 1, g = (L >> 1) & 7, tt = L >> 4;
        u.A = dftc + (size_t)part * 256 * 256 * 2; u.B = U + ((size_t)tt * 256 * D + g * 256) * 2;
        if (tt < 16) { u.O = atc + ((size_t)tt * 2048 * 512 + (size_t)(g * 256) * 512 + part * 256) * 2; u.ldc = 512; }
        else { const int lb = (tt - 16) >> 4, l0 = ((tt - 16) & 15) * 256; u.O = atl + ((size_t)lb * 2048 * 8192 + (size_t)(g * 256) * 8192 + part * 4096 + l0) * 2; u.ldc = 8192; }
        u.pm = part; u.pn = tt; u.aux = g; return true;
    }
};

#define DEVFN __device__ __forceinline__
#define C2_TYPEDEF typedef float c2 __attribute__((ext_vector_type(2)));
#define LDSP LAS
#define OPAQUE(x) asm volatile("" : "+v"(x))
#define U32X4 v4u
#define U32X2 v2u
#define LOAD16(p) (*(const v4u*)(p))
#define LOAD8(p) (*(const v2u*)(p))
#define STORE16(p, v) (*(v4u*)(p) = (v))
#define STORE8(p, v) (*(v2u*)(p) = (v))
#define BFLO(w) bflo(w)
#define BFHI(w) bfhi(w)
#define PK2(a, b) pk2(a, b)
#define BF2F(x) bf2f(x)
#define F2BF(x) ((bf16_t)f2bf(x))
#define COS_TURNS(x) __builtin_amdgcn_cosf(x)
#define SIN_TURNS(x) __builtin_amdgcn_sinf(x)
#define EXPF(x) __expf(x)
#define RSQRTF(x) (1.0f / sqrtf(x))
#define WAVE_SUM(v) wave_sum(v)
#define BLOCK_SYNC() __syncthreads()
C2_TYPEDEF
DEVFN c2 cmul(c2 a, c2 b) { c2 r; r.x = a.x * b.x - a.y * b.y; r.y = a.x * b.y + a.y * b.x; return r; }
DEVFN c2 cmulc(c2 a, c2 b) { c2 r; r.x = a.x * b.x + a.y * b.y; r.y = a.y * b.x - a.x * b.y; return r; }
template <int LOGN, int S, int G, bool INV>
DEVFN void fft_pass(LDSP c2* x, int total, int tid) {
    OPAQUE(tid);
    constexpr int N = 1 << LOGN, R = 1 << G, H3 = N >> (S + G);
    const int ngroups = total / R;
#pragma unroll 1
    for (int j = tid; j < ngroups; j += NTHREADS) {
        const int tr = j / (N / R), jj = j % (N / R), blk = jj / H3, pos = jj % H3;
        const int i0 = tr * N + blk * (R * H3) + pos;
        c2 v[R];
#pragma unroll
        for (int q = 0; q < R; ++q) v[q] = x[i0 + q * H3];
#pragma unroll
        for (int gg = 0; gg < G; ++gg) {
            const int g = INV ? (G - 1 - gg) : gg;
            const int hq = R >> (g + 1);
            const float inv_bs = 1.0f / (float)(H3 * 2 * hq);
#pragma unroll
            for (int q = 0; q < R; ++q) {
                if ((q & hq) == 0) {
                    const int p = pos + (q & (hq - 1)) * H3;
                    const float fr = (float)p * inv_bs;
                    c2 w; w.x = COS_TURNS(fr); w.y = -SIN_TURNS(fr);
                    const c2 a = v[q], b = v[q + hq];
                    if (!INV) { c2 d; d.x = a.x - b.x; d.y = a.y - b.y; v[q].x = a.x + b.x; v[q].y = a.y + b.y; v[q + hq] = cmul(d, w); }
                    else { const c2 bw = cmulc(b, w); v[q].x = a.x + bw.x; v[q].y = a.y + bw.y; v[q + hq].x = a.x - bw.x; v[q + hq].y = a.y - bw.y; }
                }
            }
        }
#pragma unroll
        for (int q = 0; q < R; ++q) x[i0 + q * H3] = v[q];
    }
}
template <int LOGN, bool INV> DEVFN void fft_all(LDSP c2* x, int total, int tid) {
    if constexpr (LOGN == 13) {
        if (!INV) { fft_pass<13, 0, 3, false>(x, total, tid); BLOCK_SYNC(); fft_pass<13, 3, 3, false>(x, total, tid); BLOCK_SYNC(); fft_pass<13, 6, 3, false>(x, total, tid); BLOCK_SYNC(); fft_pass<13, 9, 2, false>(x, total, tid); BLOCK_SYNC(); fft_pass<13, 11, 2, false>(x, total, tid); BLOCK_SYNC(); }
        else { fft_pass<13, 11, 2, true>(x, total, tid); BLOCK_SYNC(); fft_pass<13, 9, 2, true>(x, total, tid); BLOCK_SYNC(); fft_pass<13, 6, 3, true>(x, total, tid); BLOCK_SYNC(); fft_pass<13, 3, 3, true>(x, total, tid); BLOCK_SYNC(); fft_pass<13, 0, 3, true>(x, total, tid); BLOCK_SYNC(); }
    } else {
        static_assert(LOGN == 9 || LOGN == 13, "fft sizes");
        if (!INV) { fft_pass<9, 0, 3, false>(x, total, tid); BLOCK_SYNC(); fft_pass<9, 3, 3, false>(x, total, tid); BLOCK_SYNC(); fft_pass<9, 6, 3, false>(x, total, tid); BLOCK_SYNC(); }
        else { fft_pass<9, 6, 3, true>(x, total, tid); BLOCK_SYNC(); fft_pass<9, 3, 3, true>(x, total, tid); BLOCK_SYNC(); fft_pass<9, 0, 3, true>(x, total, tid); BLOCK_SYNC(); }
    }
}
struct HyParams {
    float dec[2][2];
    float skip[2];
    float cw[3][3];
    float cb[3];
};
template <int NV>
DEVFN void hy_short_vec(const bf16_t* Pcol, unsigned o, int t0, int L, float w0, float w1, float w2, float cb, float (&out)[NV]) {
    float x[NV + 2];
    if constexpr (NV == 8) { const U32X4 r = LOAD16(Pcol + o); const unsigned w[4] = {r.x, r.y, r.z, r.w};
#pragma unroll
        for (int e = 0; e < 4; ++e) { x[1 + 2 * e] = BFLO(w[e]); x[2 + 2 * e] = BFHI(w[e]); } }
    else { const U32X2 r = LOAD8(Pcol + o); x[1] = BFLO(r.x); x[2] = BFHI(r.x); x[3] = BFLO(r.y); x[4] = BFHI(r.y); }
    const bool hl = t0 > 0, hr = t0 + NV < L;
    const float xl = BF2F(Pcol[hl ? o - 1u : o]), xr = BF2F(Pcol[hr ? o + (unsigned)NV : o]);
    x[0] = hl ? xl : 0.f; x[NV + 1] = hr ? xr : 0.f;
#pragma unroll
    for (int e = 0; e < NV; ++e) out[e] = w0 * x[e] + w1 * x[e + 1] + w2 * x[e + 2] + cb;
}
template <int LOGN, int NB, int O>
DEVFN void hy_conv_order(LDSP c2* XB, LDSP c2* KB, LDSP float* red, int c, int region_base, int fpos, const bf16_t* PT, const bf16_t* FILT, const HyParams& hp, bf16_t* ZT, int tid,
                         float (&za)[(NB << (LOGN - 1)) / NTHREADS], float (&zb)[(NB << (LOGN - 1)) / NTHREADS]) {
    constexpr int N = 1 << LOGN, L = N / 2, P = NB * N, PPT = P / NTHREADS, NV = NB * L / NTHREADS;
    static_assert(NV == 8 || NV == 4, "points per thread");
    const bf16_t* Pv = PT + (size_t)c * NTOK; const bf16_t* Pg = PT + (size_t)((1 + O) * 2048 + c) * NTOK;
    const int v0 = NV * tid, pair = v0 / L, t0 = v0 % L, sb = region_base + (2 * pair) * L;
    const bf16_t* Ff = FILT + (size_t)(0 * 4096 + O * 2048 + c) * FILT_LD + fpos; const bf16_t* Fb = FILT + (size_t)(1 * 4096 + O * 2048 + c) * FILT_LD + fpos;
    float ss = 0.f; const float tsc = 1.0f / (float)(L - 1); const float d0 = hp.dec[0][O], d1 = hp.dec[1][O];
#pragma unroll 2
    for (int idx = tid; idx < N; idx += NTHREADS) {
        float kv = 0.f;
        if (idx < L) { const float f = BF2F(Ff[idx]) * (EXPF(-(float)idx * tsc * d0) + 0.05f); ss += f * f; kv = f; }
        else { const int t = (idx == L) ? 0 : (N - idx); const float b = BF2F(Fb[t]) * (EXPF(-(float)t * tsc * d1) + 0.05f); ss += b * b; kv = (idx == L) ? 0.f : b; }
        c2 k; k.x = kv; k.y = 0.f; KB[idx] = k;
    }
    ss = WAVE_SUM(ss);
    BLOCK_SYNC();
    if ((tid & 63) == 0) red[tid >> 6] = ss;
    if (O == 0) { hy_short_vec<NV>(Pv, (unsigned)(sb + t0), t0, L, hp.cw[0][0], hp.cw[0][1], hp.cw[0][2], hp.cb[0], za); hy_short_vec<NV>(Pv, (unsigned)(sb + L + t0), t0, L, hp.cw[0][0], hp.cw[0][1], hp.cw[0][2], hp.cb[0], zb); }
#pragma unroll
    for (int e = 0; e < NV; ++e) { c2 z; z.x = za[e]; z.y = zb[e]; XB[pair * N + t0 + e] = z; c2 zz; zz.x = 0.f; zz.y = 0.f; XB[pair * N + L + t0 + e] = zz; }
    BLOCK_SYNC();
    float tot = 0.f;
#pragma unroll
    for (int w = 0; w < NTHREADS / 64; ++w) tot += red[w];
    const float sc = RSQRTF(tot + 1e-12f) * (1.0f / (float)N);
    fft_all<LOGN, false>(KB, N, tid);
    fft_all<LOGN, false>(XB, P, tid);
#pragma unroll 4
    for (int i = 0; i < PPT; ++i) { const int p = tid + NTHREADS * i, j = p & (N - 1); c2 k = KB[j]; k.x *= sc; k.y *= sc; const c2 xv = XB[p]; XB[p] = cmul(xv, k); }
    BLOCK_SYNC();
    fft_all<LOGN, true>(XB, P, tid);
    { const float sk = hp.skip[O]; float ga[NV], gb[NV];
      hy_short_vec<NV>(Pg, (unsigned)(sb + t0), t0, L, hp.cw[1 + O][0], hp.cw[1 + O][1], hp.cw[1 + O][2], hp.cb[1 + O], ga); hy_short_vec<NV>(Pg, (unsigned)(sb + L + t0), t0, L, hp.cw[1 + O][0], hp.cw[1 + O][1], hp.cw[1 + O][2], hp.cb[1 + O], gb);
#pragma unroll
      for (int e = 0; e < NV; ++e) { const c2 y = XB[pair * N + t0 + e]; za[e] = ga[e] * (y.x + sk * za[e]); zb[e] = gb[e] * (y.y + sk * zb[e]); }
      if (O == 1) { bf16_t* Zc = ZT + (size_t)c * NTOK;
          if constexpr (NV == 8) { U32X4 wa, wb; wa.x = PK2(za[0], za[1]); wa.y = PK2(za[2], za[3]); wa.z = PK2(za[4], za[5]); wa.w = PK2(za[6], za[7]); wb.x = PK2(zb[0], zb[1]); wb.y = PK2(zb[2], zb[3]); wb.z = PK2(zb[4], zb[5]); wb.w = PK2(zb[6], zb[7]);
              STORE16(Zc + (unsigned)(sb + t0), wa); STORE16(Zc + (unsigned)(sb + L + t0), wb); }
          else { U32X2 wa, wb; wa.x = PK2(za[0], za[1]); wa.y = PK2(za[2], za[3]); wb.x = PK2(zb[0], zb[1]); wb.y = PK2(zb[2], zb[3]); STORE8(Zc + (unsigned)(sb + t0), wa); STORE8(Zc + (unsigned)(sb + L + t0), wb); } } }
    BLOCK_SYNC();
}
template <int LOGN, int NB>
DEVFN void hy_conv_unit(LDSP c2* XB, LDSP c2* KB, LDSP float* red, int c, int region_base, int fpos, const bf16_t* PT, const bf16_t* FILT, const HyParams& hp, bf16_t* ZT, int tid) {
    constexpr int NV = (NB << (LOGN - 1)) / NTHREADS;
    float za[NV], zb[NV];
#pragma unroll
    for (int i = 0; i < NV; ++i) { za[i] = 0.f; zb[i] = 0.f; }
    hy_conv_order<LOGN, NB, 0>(XB, KB, red, c, region_base, fpos, PT, FILT, hp, ZT, tid, za, zb);
    hy_conv_order<LOGN, NB, 1>(XB, KB, red, c, region_base, fpos, PT, FILT, hp, ZT, tid, za, zb);
}
__device__ __forceinline__ void hy_conv_phase(const Args& a, LAS unsigned char* lds, int tid, int vcu, int G) {
    unsigned char* ws = a.ws; const bf16_t* PT = (const bf16_t*)(ws + WS_PT); const bf16_t* FILT = (const bf16_t*)(ws + WS_FILT); bf16_t* ZT = (bf16_t*)(ws + WS_ZT);
    LAS c2* XB = (LAS c2*)lds; LAS c2* KB = (LAS c2*)(lds + 65536); LAS float* red = (LAS float*)(lds + LDSCTL_OFF);
    for (int c = vcu; c < 2048; c += G) {
        HyParams hp;
#pragma unroll
        for (int d = 0; d < 2; ++d)
#pragma unroll
            for (int o = 0; o < 2; ++o) hp.dec[d][o] = __expf(a.in[I_HDEC][(d * 2 + o) * 2048 + c]);
        hp.skip[0] = a.in[I_HSKIP][c]; hp.skip[1] = a.in[I_HSKIP][2048 + c];
#pragma unroll
        for (int w = 0; w < 3; ++w) { hp.cb[w] = a.in[I_HCB][w * 2048 + c];
#pragma unroll
            for (int k = 0; k < 3; ++k) hp.cw[w][k] = a.in[I_HCW][k * 6144 + w * 2048 + c]; }
        hy_conv_unit<13, 1>(XB, KB, red, c, 4096, 0, PT, FILT, hp, ZT, tid);
        hy_conv_unit<9, 8>(XB, KB, red, c, 0, 4096, PT, FILT, hp, ZT, tid);
    }
}

constexpr int N_PHASES = 35;
#ifndef MK_PER_PHASE
#define MK_PER_PHASE 0
#endif
#ifndef ATTN_NAIVE
#define ATTN_NAIVE 1
#endif

__global__ void __launch_bounds__(NTHREADS, 2) trunk_fwd(Args args) {
    extern __shared__ __attribute__((aligned(16))) unsigned char lds_raw[];
    LAS unsigned char* lds = (LAS unsigned char*)lds_raw;
    volatile LAS unsigned* MISC = (volatile LAS unsigned*)(lds + MISC_OFF);
    const int tid = threadIdx.x, lane = tid & 63, wave = __builtin_amdgcn_readfirstlane(tid >> 6);
    const int G = gridDim.x, bx = blockIdx.x, vcu = (G % 8 == 0) ? (bx % 8) * (G / 8) + bx / 8 : bx;
    unsigned char* ws = args.ws;
    for (int u = tid; u < (LDS_BYTES - LDSCTL_OFF) / 4; u += NTHREADS) ((LAS unsigned*)(lds + LDSCTL_OFF))[u] = 0u;
    __syncthreads();
    XcdBarrier bar; bar.bar = (unsigned*)(ws + WS_CTL) + 4096; bar.x = 0; bar.st = nullptr;
    if (!MK_PER_PHASE) bar = xcd_barrier_post((unsigned*)(ws + WS_CTL) + 4096, MISC + 8);
    const int lo = args.ph_lo, hi = args.ph_hi;
#ifndef PH_ONLY_LO
#define PH_ONLY_LO 0
#define PH_ONLY_HI 1000
#endif
#define IN(k) ((k) >= PH_ONLY_LO && (k) < PH_ONLY_HI && lo <= (k) && (k) < hi)
#define SEAM(k) do { if (IN(k) && IN((k) + 1)) xcd_barrier(bar); } while (0)
    const char* U = (const char*)(ws + WS_U); const char* MIXO = (const char*)(ws + WS_MIXO); char* PART = (char*)(ws + WS_PART);

#define OUTPROJ(Aptr, Wptr, KTOT) do { SchedGrid S{(const char*)(Aptr), (const char*)(Wptr), PART, (size_t)256 * (KTOT) * 2, (size_t)256 * (KTOT) * 2, (size_t)((KTOT) / 2) * 2, (size_t)((KTOT) / 2) * 2, \
        (size_t)256 * D * 4, (size_t)256 * 4, (size_t)NTOK * D * 4, D, 48, 8, 2, G, bx}; pg8::EpiF32 E; pg8::gemm_phase<pg8::EpiF32, SchedGrid, false, true>(lds, (KTOT) / 2, (KTOT), (KTOT), S, E); } while (0)
#define FFN_BLOCK(l, p, lnext, final) do { \
    if (IN(p)) { SchedGrid S{U, (const char*)(ws + WS_WGU + (size_t)(l) * SZ_WGU), (char*)(ws + WS_ACT), (size_t)256 * D * 2, (size_t)256 * D * 2, 0, 0, (size_t)256 * DFF * 2, (size_t)128 * 2, 0, DFF, 48, 44, 1, G, bx}; \
        pg8::EpiSwiglu E; pg8::gemm_phase<pg8::EpiSwiglu, SchedGrid, false, true>(lds, D, D, D, S, E); } SEAM(p); \
    if (IN((p) + 1)) { OUTPROJ(ws + WS_ACT, ws + WS_WD + (size_t)(l) * SZ_WD, DFF); } SEAM((p) + 1); \
    if (IN((p) + 2)) { ln_phase(args, lds, tid, lane, wave, vcu, G, (l), 5, 1, nullptr, (lnext), 0, (final)); } if (!(final)) SEAM((p) + 2); } while (0)
#define MLA_BLOCK(j, l, p) do { \
    if (IN(p)) { SchedGrid S{U, (const char*)(ws + WS_W1 + (size_t)(j) * SZ_W1), (char*)(ws + WS_T1), (size_t)256 * D * 2, (size_t)256 * D * 2, 0, 0, (size_t)256 * 1280 * 4, (size_t)256 * 4, 0, 1280, 48, 5, 1, G, bx}; \
        pg8::EpiF32 E; pg8::gemm_phase<pg8::EpiF32, SchedGrid, false, true>(lds, D, D, D, S, E); } SEAM(p); \
    if (IN((p) + 1)) { mla_norm_phase(args, lane, wave, vcu, G, (j)); } SEAM((p) + 1); \
    if (IN((p) + 2)) { SchedPair S; \
        S.g0 = SchedGrid{(const char*)(ws + WS_QL), (const char*)(ws + WS_WUQ + (size_t)(j) * SZ_WUQ), (char*)(ws + WS_Q), (size_t)256 * 512 * 2, (size_t)256 * 512 * 2, 0, 0, (size_t)256 * 3072 * 2, (size_t)256 * 2, 0, 3072, 48, 12, 1, G, bx}; \
        S.g1 = SchedGrid{(const char*)(ws + WS_CKVN + (size_t)(j) * NKV * 512 * 2), (const char*)(ws + WS_WUKV + (size_t)(j) * SZ_WUKV), (char*)(ws + WS_KV), (size_t)256 * 512 * 2, (size_t)256 * 512 * 2, 0, 0, (size_t)256 * 4096 * 2, (size_t)256 * 2, 0, 4096, 52, 16, 1, G, bx}; \
        S.G = G; S.c = bx; pg8::EpiQKV E{(const pg8::f32x2*)(ws + WS_ROPE), QSCALE}; pg8::gemm_phase<pg8::EpiQKV, SchedPair, false, true>(lds, 512, 512, 512, S, E); } SEAM((p) + 2); \
    if (IN((p) + 3)) { attn_naive_phase(args, lane, wave, vcu, G, (j)); } SEAM((p) + 3); \
    if (IN((p) + 4)) { OUTPROJ(MIXO, ws + WS_WO + (size_t)(l) * SZ_WO, D); } SEAM((p) + 4); \
    if (IN((p) + 5)) { ln_phase(args, lds, tid, lane, wave, vcu, G, (l), 2, 0, nullptr, (l), 3, false); } SEAM((p) + 5); } while (0)

    if (IN(0)) { p0_prologue(args, lds, tid, lane, wave, vcu, G); } SEAM(0);
    if (IN(1)) { p1_embed(args, lane, wave, vcu, G);
        { SchedGrid S{(const char*)(ws + WS_W3), (const char*)(ws + WS_HF2), (char*)(ws + WS_FILT), (size_t)256 * 256 * 2, (size_t)256 * 256 * 2, 0, 0, (size_t)256 * FILT_LD * 2, (size_t)256 * 2, 0, FILT_LD, 32, 17, 1, G, bx};
          pg8::EpiBf16<0> E{nullptr}; pg8::gemm_phase<pg8::EpiBf16<0>, SchedGrid, false, true>(lds, 256, 256, 256, S, E); }
    } SEAM(1);
    MLA_BLOCK(0, 0, 2);
    FFN_BLOCK(0, 8, 1, false);
    if (IN(11)) {
        { SchedGrid S{(const char*)(ws + WS_WIN), U, (char*)(ws + WS_PT), (size_t)256 * D * 2, (size_t)256 * D * 2, 0, 0, (size_t)256 * NTOK * 2, (size_t)256 * 2, 0, NTOK, 24, 48, 1, G, bx};
          pg8::EpiBf16<1> E{args.in[I_HBIN]}; pg8::gemm_phase<pg8::EpiBf16<1>, SchedGrid, false, true>(lds, D, D, D, S, E); }
    } SEAM(11);
    if (IN(12)) { hy_conv_phase(args, lds, tid, vcu, G); } SEAM(12);
    if (IN(13)) { transpose_zt_phase(args, lds, lane, wave, vcu, G); } SEAM(13);
    if (IN(14)) { OUTPROJ(MIXO, ws + WS_WO + (size_t)1 * SZ_WO, D); } SEAM(14);
    if (IN(15)) { ln_phase(args, lds, tid, lane, wave, vcu, G, 1, 2, 0, args.in[I_HBOUT], 1, 3, false); } SEAM(15);
    FFN_BLOCK(1, 16, 2, false);
    if (IN(19)) { SchedF1 S{(const char*)(ws + WS_DFTC), U, (char*)(ws + WS_ATC), (char*)(ws + WS_ATL), G, bx}; pg8::EpiBf16<0> E{nullptr}; pg8::gemm_phase<pg8::EpiBf16<0>, SchedF1, false, true>(lds, 256, 256, D, S, E); } SEAM(19);
    if (IN(20)) {
        { SchedGrid S{(const char*)(ws + WS_DML), (const char*)(ws + WS_ATL), (char*)(ws + WS_MIXO) + (size_t)NCTX * D * 2, (size_t)256 * 8192 * 2, (size_t)256 * 8192 * 2, 0, (size_t)2048 * 8192 * 2, (size_t)256 * D * 2, (size_t)256 * 2, (size_t)4096 * D * 2, D, 16, 8, 2, G, bx};
          pg8::EpiBf16<0> E{nullptr}; pg8::gemm_phase<pg8::EpiBf16<0>, SchedGrid, false, true>(lds, 8192, 8192, 8192, S, E); }
        { SchedGrid S{(const char*)(ws + WS_DMC), (const char*)(ws + WS_ATC), (char*)(ws + WS_MIXO), 0, (size_t)256 * 512 * 2, 0, (size_t)2048 * 512 * 2, 0, (size_t)256 * 2, (size_t)256 * D * 2, D, 1, 8, 16, G, bx};
          pg8::EpiBf16<0> E{nullptr}; pg8::gemm_phase<pg8::EpiBf16<0>, SchedGrid, false, true>(lds, 512, 512, 512, S, E); }
    } SEAM(20);
    if (IN(21)) { OUTPROJ(MIXO, ws + WS_WO + (size_t)2 * SZ_WO, D); } SEAM(21);
    if (IN(22)) { ln_phase(args, lds, tid, lane, wave, vcu, G, 2, 2, 0, args.in[I_FNB], 2, 3, false); } SEAM(22);
    FFN_BLOCK(2, 23, 3, false);
    MLA_BLOCK(1, 3, 26);
    FFN_BLOCK(3, 32, 3, true);
#undef IN
#undef SEAM
}

extern "C" void kernel_launch(void* const* d_in, const int* in_sizes, int n_in, void* d_out, int out_size, void* d_ws, size_t ws_size, hipStream_t stream) {
    static int grid = 0;
    if (grid == 0) {
        if (n_in != 38 || ws_size < WS_END) { fprintf(stderr, "kernel_launch: expected 38 inputs and >= %zu bytes of workspace; got %d, %zu\n", (size_t)WS_END, n_in, ws_size); grid = -1; return; }
        int dev = 0, cus = 0, per_cu = 0;
        if (hipGetDevice(&dev) != hipSuccess || hipDeviceGetAttribute(&cus, hipDeviceAttributeMultiprocessorCount, dev) != hipSuccess) { grid = -1; return; }
        if (hipFuncSetAttribute((const void*)trunk_fwd, hipFuncAttributeMaxDynamicSharedMemorySize, LDS_BYTES) != hipSuccess) { fprintf(stderr, "kernel_launch: hipFuncSetAttribute failed\n"); grid = -1; return; }
        if (hipOccupancyMaxActiveBlocksPerMultiprocessor(&per_cu, (const void*)trunk_fwd, NTHREADS, LDS_BYTES) != hipSuccess || per_cu < 1) { fprintf(stderr, "kernel_launch: occupancy query reports %d workgroups per CU\n", per_cu); }
        (void)hipGetLastError();
        grid = cus;
    }
    if (grid < 0) return;
    if (hipMemsetAsync((char*)d_ws + WS_CTL, 0, CTL_ZERO_BYTES, stream) != hipSuccess) return;
    Args a{};
    for (int i = 0; i < 38; ++i) a.in[i] = (const float*)d_in[i];
    a.out = (float*)d_out; a.ws = (unsigned char*)d_ws; a.li = 0; a.pad = 0;
#if MK_PER_PHASE
    for (int p = 0; p < N_PHASES; ++p) { a.ph_lo = p; a.ph_hi = p + 1; hipLaunchKernelGGL(trunk_fwd, dim3(grid), dim3(NTHREADS), LDS_BYTES, stream, a); }
#else
    a.ph_lo = 0; a.ph_hi = N_PHASES; hipLaunchKernelGGL(trunk_fwd, dim3(grid), dim3(NTHREADS), LDS_BYTES, stream, a);
#endif
    const hipError_t le = hipPeekAtLastError();
    if (le != hipSuccess) fprintf(stderr, "kernel_launch: launch failed: %s\n", hipGetErrorName(le));
}
```

```cpp
#include <hip/hip_runtime.h>
#include <cstdio>
#include <cstdint>
#define GAS __attribute__((address_space(1)))
#define LAS __attribute__((address_space(3)))
typedef unsigned short bf16_t;
typedef unsigned v4u __attribute__((ext_vector_type(4)));
typedef unsigned v2u __attribute__((ext_vector_type(2)));
typedef float f32x4 __attribute__((ext_vector_type(4)));
typedef float f32x2 __attribute__((ext_vector_type(2)));

constexpr int D = 2048, NCTX = 4096, NLAT = 8192, NTOK = 12288, DFF = 5632, NKV = 13312;
constexpr int NTHREADS = 512, NWAVES = 8;
constexpr float DN_ALPHA = 1.681792830507429f;
constexpr float LN_EPS = 1e-5f, RMS_EPS = 1e-6f;
constexpr float QSCALE = 0.07216878364870322f * 1.4426950408889634f;
constexpr int FILT_LD = 4352;

constexpr size_t al256(size_t x) { return (x + 255) & ~(size_t)255; }
constexpr size_t SZ_WGU = (size_t)11264 * 2048 * 2, SZ_WD = (size_t)2048 * 5632 * 2;
constexpr size_t SZ_W1 = (size_t)1280 * 2048 * 2, SZ_WUQ = (size_t)3072 * 512 * 2, SZ_WUKV = (size_t)4096 * 512 * 2, SZ_WO = (size_t)2048 * 2048 * 2;
constexpr size_t SZ_WIN = (size_t)6144 * 2048 * 2, SZ_W3 = (size_t)8192 * 256 * 2;
constexpr size_t SZ_DFTC = (size_t)512 * 256 * 2, SZ_DML = (size_t)4096 * 8192 * 2, SZ_DMC = (size_t)256 * 512 * 2;
constexpr size_t SZ_ROWS = (size_t)NTOK * D * 2;
constexpr size_t WS_CTL = 0, CTL_ZERO_BYTES = 1u << 20;
constexpr size_t WS_MOD = WS_CTL + CTL_ZERO_BYTES;
constexpr size_t WS_ROPE = WS_MOD + al256((size_t)4 * 3 * 12288 * 4);
constexpr size_t WS_HF2 = WS_ROPE + al256((size_t)4096 * 32 * 8);
constexpr size_t WS_WGU = WS_HF2 + al256((size_t)FILT_LD * 256 * 2);
constexpr size_t WS_WD = WS_WGU + 4 * SZ_WGU;
constexpr size_t WS_W1 = WS_WD + 4 * SZ_WD;
constexpr size_t WS_WUQ = WS_W1 + 2 * SZ_W1;
constexpr size_t WS_WUKV = WS_WUQ + 2 * SZ_WUQ;
constexpr size_t WS_WO = WS_WUKV + 2 * SZ_WUKV;
constexpr size_t WS_WIN = WS_WO + 4 * SZ_WO;
constexpr size_t WS_W3 = WS_WIN + SZ_WIN;
constexpr size_t WS_DFTC = WS_W3 + SZ_W3;
constexpr size_t WS_DML = WS_DFTC + SZ_DFTC;
constexpr size_t WS_DMC = WS_DML + SZ_DML;
constexpr size_t WS_H = WS_DMC + al256(SZ_DMC);
constexpr size_t WS_U = WS_H + SZ_ROWS;
constexpr size_t WS_PART = WS_U + SZ_ROWS;
constexpr size_t WS_ACT = WS_PART + (size_t)2 * NTOK * D * 4;
constexpr size_t WS_CKVN = WS_ACT + (size_t)NTOK * DFF * 2;
constexpr size_t WS_KR = WS_CKVN + 2 * (size_t)NKV * 512 * 2;
constexpr size_t WS_MIXO = WS_KR + 2 * al256((size_t)NKV * 64 * 2);
constexpr size_t WS_FILT = WS_MIXO + SZ_ROWS;
constexpr size_t WS_X = WS_FILT + (size_t)8192 * FILT_LD * 2;
constexpr size_t WS_T1 = WS_X;
constexpr size_t WS_QL = WS_T1 + (size_t)NTOK * 1280 * 4;
constexpr size_t WS_Q = WS_QL + (size_t)NTOK * 512 * 2;
constexpr size_t WS_KV = WS_Q + (size_t)NTOK * 3072 * 2;
constexpr size_t WS_XEND_MLA = WS_KV + (size_t)NKV * 4096 * 2;
constexpr size_t WS_PT = WS_X;
constexpr size_t WS_ZT = WS_PT + (size_t)6144 * NTOK * 2;
constexpr size_t WS_XEND_HY = WS_ZT + (size_t)2048 * NTOK * 2;
constexpr size_t WS_ATC = WS_X;
constexpr size_t WS_ATL = WS_ATC + (size_t)16 * 2048 * 512 * 2;
constexpr size_t WS_XEND_FN = WS_ATL + (size_t)2 * 2048 * 8192 * 2;
constexpr size_t cmax(size_t a, size_t b) { return a > b ? a : b; }
constexpr size_t WS_END = cmax(WS_XEND_MLA, cmax(WS_XEND_HY, WS_XEND_FN));
static_assert(WS_END <= (size_t)1610612736, "d_ws map exceeds 4 x largest tensor");

constexpr int RING_OFF = 0, RING_BYTES = 131072;
constexpr int LDSCTL_OFF = RING_BYTES, MISC_OFF = LDSCTL_OFF + 320;
constexpr int LDS_BYTES = 147456;
static_assert(MISC_OFF + 128 <= LDS_BYTES, "LDS map");

__device__ __forceinline__ unsigned f2bf(float f) { unsigned u = __builtin_bit_cast(unsigned, f); return (u + 0x7fffu + ((u >> 16) & 1u)) >> 16; }
__device__ __forceinline__ unsigned pk2(float lo, float hi) { return f2bf(lo) | (f2bf(hi) << 16); }
__device__ __forceinline__ float bf2f(unsigned short b) { return __builtin_bit_cast(float, ((unsigned)b) << 16); }
__device__ __forceinline__ float bflo(unsigned w) { return __builtin_bit_cast(float, w << 16); }
__device__ __forceinline__ float bfhi(unsigned w) { return __builtin_bit_cast(float, w & 0xffff0000u); }
#define LDS_WAIT() asm volatile("s_waitcnt lgkmcnt(0)" ::: "memory")
#define VM_WAIT() asm volatile("s_waitcnt vmcnt(0)" ::: "memory")
__device__ __forceinline__ float wave_sum(float v) {
#pragma unroll
    for (int o = 1; o < 64; o <<= 1) v += __shfl_xor(v, o);
    return v;
}

namespace pg8 {
typedef short bf16x8 __attribute__((ext_vector_type(8)));
typedef float f32x4 __attribute__((ext_vector_type(4)));
typedef float f32x2 __attribute__((ext_vector_type(2)));
typedef unsigned u32x4 __attribute__((ext_vector_type(4)));
constexpr int BM = 256, BK = 64, HALF = 128, HTB = HALF * BK * 2  , STAGE_BYTES = 8 * HTB, NXCD = 8, WGM = 8;

__host__ __device__ __forceinline__ int lds_byte(int r, int c) { const int st = (r >> 4) * 2 + (c >> 5), rr = r & 15, cc = c & 31, ob = rr * 64 + cc * 2; return st * 1024 + (ob ^ (((ob >> 9) & 1) << 5)); }
__host__ __device__ __forceinline__ void stage_rc(int b, int& R, int& C) { const int st = b / 1024, sb = b % 1024, swz = sb ^ (((sb >> 9) & 1) << 5); R = (st >> 1) * 16 + swz / 64; C = (st & 1) * 32 + (swz % 64) / 2; }
__host__ __device__ __forceinline__ int perm32(int rho) { const int n = rho >> 4, i = rho & 15; return 8 * (i >> 2) + 4 * n + (i & 3); }

struct Unit { const char* A; const char* B; char* O; int ldc; int pm, pn, aux; };

__device__ __forceinline__ void tile_of(int L, int nM, int nN, int& pm, int& pn) {
    const int nwg = nM * nN; int wgid = L; { const int q = nwg / NXCD, r = nwg % NXCD, xcd = wgid % NXCD, off = wgid / NXCD; wgid = (xcd < r ? xcd * (q + 1) : r * (q + 1) + (xcd - r) * q) + off; }
    const int nig = WGM * nN, gid = wgid / nig, fm = gid * WGM, gsz = (nM - fm) < WGM ? (nM - fm) : WGM;
    pm = fm + ((wgid % nig) % gsz); pn = (wgid % nig) / gsz;
}

__device__ __forceinline__ unsigned cvt_pk_bf16(float lo, float hi) { unsigned r; asm volatile("v_cvt_pk_bf16_f32 %0, %1, %2" : "=v"(r) : "v"(lo), "v"(hi)); return r; }

struct EpiF32 {
    static constexpr bool PERM = false;
    __device__ __forceinline__ void operator()(const f32x4 (&acc)[2][2][4][2], const Unit& u, int wr, int wc, int fr, int fq) const {
        const int row0 = wr * 64 + fr, col0 = wc * 32 + 4 * fq; float* O = (float*)u.O;
#pragma unroll
        for (int ai = 0; ai < 2; ++ai)
#pragma unroll
            for (int m = 0; m < 4; ++m) { float* rowp = O + (size_t)(row0 + ai * HALF + m * 16) * u.ldc + col0;
#pragma unroll
                for (int bj = 0; bj < 2; ++bj)
#pragma unroll
                    for (int n = 0; n < 2; ++n) *(f32x4*)(rowp + bj * HALF + n * 16) = acc[ai][bj][m][n]; }
    }
};
template <int BIAS  > struct EpiBf16 {
    static constexpr bool PERM = true;
    const float* bias;
    __device__ __forceinline__ void operator()(const f32x4 (&acc)[2][2][4][2], const Unit& u, int wr, int wc, int fr, int fq) const {
        const int row0 = wr * 64 + fr, col0 = wc * 32 + 8 * fq; bf16_t* O = (bf16_t*)u.O;
#pragma unroll
        for (int ai = 0; ai < 2; ++ai)
#pragma unroll
            for (int m = 0; m < 4; ++m) { const int r = row0 + ai * HALF + m * 16; bf16_t* rowp = O + (size_t)r * u.ldc + col0; const float b = BIAS == 1 ? bias[u.pm * BM + r] : 0.f;
#pragma unroll
                for (int bj = 0; bj < 2; ++bj) { const f32x4 v0 = acc[ai][bj][m][0] + b, v1 = acc[ai][bj][m][1] + b;
                    u32x4 w; w.x = cvt_pk_bf16(v0[0], v0[1]); w.y = cvt_pk_bf16(v0[2], v0[3]); w.z = cvt_pk_bf16(v1[0], v1[1]); w.w = cvt_pk_bf16(v1[2], v1[3]);
                    *(u32x4*)(rowp + bj * HALF) = w; } }
    }
};
struct EpiSwiglu {
    static constexpr bool PERM = true;
    __device__ __forceinline__ void operator()(const f32x4 (&acc)[2][2][4][2], const Unit& u, int wr, int wc, int fr, int fq) const {
        const int row0 = wr * 64 + fr, col0 = wc * 32 + 8 * fq; bf16_t* O = (bf16_t*)u.O;
#pragma unroll
        for (int ai = 0; ai < 2; ++ai)
#pragma unroll
            for (int m = 0; m < 4; ++m) { bf16_t* rowp = O + (size_t)(row0 + ai * HALF + m * 16) * u.ldc + col0; float v[8];
#pragma unroll
                for (int n = 0; n < 2; ++n)
#pragma unroll
                    for (int j = 0; j < 4; ++j) { const float g = acc[ai][0][m][n][j], up = acc[ai][1][m][n][j]; v[n * 4 + j] = g * __builtin_amdgcn_rcpf(1.0f + __expf(-g)) * up; }
                u32x4 w; w.x = cvt_pk_bf16(v[0], v[1]); w.y = cvt_pk_bf16(v[2], v[3]); w.z = cvt_pk_bf16(v[4], v[5]); w.w = cvt_pk_bf16(v[6], v[7]);
                *(u32x4*)rowp = w; }
    }
};
struct EpiQKV {
    static constexpr bool PERM = true;
    const f32x2* rope; float qscale;
    __device__ __forceinline__ void operator()(const f32x4 (&acc)[2][2][4][2], const Unit& u, int wr, int wc, int fr, int fq) const {
        const int row0 = wr * 64 + fr, col0 = wc * 32 + 8 * fq; bf16_t* O = (bf16_t*)u.O;
        const bool isq = (u.aux == 0); const float sc = isq ? qscale : 1.0f; const bool lat = isq && (u.pm >= 16);
        int pr[2]; bool rp[2];
#pragma unroll
        for (int bj = 0; bj < 2; ++bj) { const int c8 = u.pn * BM + bj * HALF + col0, d = c8 % 192; rp[bj] = lat && d >= 128; pr[bj] = (d - 128) >> 1; }
#pragma unroll
        for (int ai = 0; ai < 2; ++ai)
#pragma unroll
            for (int m = 0; m < 4; ++m) { const int r = row0 + ai * HALF + m * 16; bf16_t* rowp = O + (size_t)r * u.ldc + col0; const int t = (u.pm * BM + r) & 4095;
#pragma unroll
                for (int bj = 0; bj < 2; ++bj) { f32x4 v0 = acc[ai][bj][m][0] * sc, v1 = acc[ai][bj][m][1] * sc;
                    if (rp[bj]) { const f32x4* cs = (const f32x4*)(rope + (size_t)t * 32 + pr[bj]); const f32x4 c01 = cs[0], c23 = cs[1];
                        f32x4 a, b; a[0] = v0[0] * c01[0] - v0[1] * c01[1]; a[1] = v0[0] * c01[1] + v0[1] * c01[0]; a[2] = v0[2] * c01[2] - v0[3] * c01[3]; a[3] = v0[2] * c01[3] + v0[3] * c01[2];
                        b[0] = v1[0] * c23[0] - v1[1] * c23[1]; b[1] = v1[0] * c23[1] + v1[1] * c23[0]; b[2] = v1[2] * c23[2] - v1[3] * c23[3]; b[3] = v1[2] * c23[3] + v1[3] * c23[2]; v0 = a; v1 = b; }
                    u32x4 w; w.x = cvt_pk_bf16(v0[0], v0[1]); w.y = cvt_pk_bf16(v0[2], v0[3]); w.z = cvt_pk_bf16(v1[0], v1[1]); w.w = cvt_pk_bf16(v1[2], v1[3]);
                    *(u32x4*)(rowp + bj * HALF) = w; } }
    }
};

template <class Epi, class Sched, bool ALIGN_EPI = false, bool SP2 = false>
__device__ __forceinline__ void gemm_phase(LAS unsigned char* lds, const int K, const int lda, const int ldb, const Sched& S, const Epi& E) {
    const int tid = threadIdx.x, wid = __builtin_amdgcn_readfirstlane(tid >> 6), lane = tid & 63, wr = wid >> 2, wc = wid & 3, fr = lane & 15, fq = lane >> 4;
    const int nt = K / BK;
    unsigned voffA[2], voffB[2];
#pragma unroll
    for (int i = 0; i < 2; ++i) { int R, C; stage_rc(tid * 16 + i * 8192, R, C); const int Rb = Epi::PERM ? ((R & ~31) + perm32(R & 31)) : R;
        voffA[i] = (unsigned)(R * lda + C) * 2u; voffB[i] = (unsigned)(Rb * ldb + C) * 2u; }
    const size_t kstep = (size_t)(BK * 2);
    const size_t hstepA = (size_t)HALF * lda * 2, hstepB = (size_t)HALF * ldb * 2;
    const unsigned ldsw = (unsigned)wid * 1024u;
    const int aoff = lds_byte(wr * 64 + fr, fq * 8), boff = lds_byte(wc * 32 + fr, fq * 8);
#define PG8_SA(b, h) (((b) * 2 + (h)) * HTB)
#define PG8_SB(b, h) ((4 + (b) * 2 + (h)) * HTB)
#define PG8_STAGE(bufoff, gbase, voff) do { _Pragma("unroll") for (int _i = 0; _i < 2; ++_i) \
        __builtin_amdgcn_global_load_lds((const unsigned*)((const char*)(gbase) + (voff)[_i]), (LAS unsigned*)(lds + (bufoff) + ldsw + _i * 8192), 16, 0, 0); } while (0)
#define PG8_LDA(dst, b, h) do { _Pragma("unroll") for (int m = 0; m < 4; ++m) _Pragma("unroll") for (int k = 0; k < 2; ++k) dst[m][k] = *(const LAS bf16x8*)(lds + PG8_SA(b, h) + aoff + m * 2048 + k * 1024); } while (0)
#define PG8_LDB(dst, b, h) do { _Pragma("unroll") for (int n = 0; n < 2; ++n) _Pragma("unroll") for (int k = 0; k < 2; ++k) dst[n][k] = *(const LAS bf16x8*)(lds + PG8_SB(b, h) + boff + n * 2048 + k * 1024); } while (0)
#define PG8_MMA(ai, bj, At, Bt) do { __builtin_amdgcn_s_setprio(1); _Pragma("unroll") for (int m = 0; m < 4; ++m) _Pragma("unroll") for (int n = 0; n < 2; ++n) _Pragma("unroll") for (int k = 0; k < 2; ++k) \
        acc[ai][bj][m][n] = __builtin_amdgcn_mfma_f32_16x16x32_bf16(Bt[n][k], At[m][k], acc[ai][bj][m][n], 0, 0, 0); __builtin_amdgcn_s_setprio(0); } while (0)
#define PG8_WAIT_V(n) asm volatile("s_waitcnt vmcnt(" #n ")" ::: "memory")
#define PG8_WAIT_L(n) asm volatile("s_waitcnt lgkmcnt(" #n ")" ::: "memory")
#define PG8_BAR __builtin_amdgcn_s_barrier()
#define PG8_SCHED __builtin_amdgcn_sched_barrier(0)
    Unit cur, nxt; int ui = 0;
    if (!S.next(0, cur)) return;
    f32x4 acc[2][2][4][2];
#pragma unroll
    for (int a = 0; a < 2; ++a)
#pragma unroll
        for (int b = 0; b < 2; ++b)
#pragma unroll
            for (int m = 0; m < 4; ++m)
#pragma unroll
                for (int n = 0; n < 2; ++n) acc[a][b][m][n] = (f32x4){0.f, 0.f, 0.f, 0.f};
    bf16x8 At[4][2], B0[2][2], B1[2][2];
    const char* cA = cur.A; const char* cB = cur.B;
    if constexpr (SP2) {
        PG8_STAGE(PG8_SB(0, 0), cB, voffB); PG8_STAGE(PG8_SB(0, 1), cB + hstepB, voffB); PG8_STAGE(PG8_SA(0, 0), cA, voffA); PG8_STAGE(PG8_SA(0, 1), cA + hstepA, voffA);
        if (wr == 1) PG8_BAR;
        PG8_WAIT_V(2); PG8_BAR;
        PG8_STAGE(PG8_SB(1, 0), cB + kstep, voffB); PG8_STAGE(PG8_SA(1, 0), cA + kstep, voffA); PG8_STAGE(PG8_SB(1, 1), cB + hstepB + kstep, voffB);
        PG8_WAIT_V(6); PG8_BAR;
    } else {
        PG8_STAGE(PG8_SB(0, 0), cB, voffB); PG8_STAGE(PG8_SA(0, 0), cA, voffA); PG8_STAGE(PG8_SB(0, 1), cB + hstepB, voffB); PG8_STAGE(PG8_SA(0, 1), cA + hstepA, voffA);
        if (wr == 1) PG8_BAR;
        PG8_WAIT_V(4); PG8_BAR;
        PG8_STAGE(PG8_SB(1, 0), cB + kstep, voffB); PG8_STAGE(PG8_SA(1, 0), cA + kstep, voffA); PG8_STAGE(PG8_SB(1, 1), cB + hstepB + kstep, voffB);
        PG8_WAIT_V(6); PG8_BAR;
    }
    for (;;) {
        const bool has_next = S.next(ui + 1, nxt);
        const char* nA = has_next ? nxt.A : cA; const char* nB = has_next ? nxt.B : cB;
        for (int t = 0; t < nt; t += 2) {
            const bool last = (t == nt - 2);
            const char* a1 = cA + (size_t)(t + 1) * kstep;
            const char* a2 = last ? nA : cA + (size_t)(t + 2) * kstep; const char* b2 = last ? nB : cB + (size_t)(t + 2) * kstep;
            const char* a3 = a2 + kstep; const char* b3 = b2 + kstep;
            if constexpr (SP2) {
            PG8_LDB(B0, 0, 0); PG8_LDB(B1, 0, 1); PG8_SCHED; PG8_LDA(At, 0, 0); PG8_STAGE(PG8_SA(1, 1), a1 + hstepA, voffA);
            PG8_WAIT_V(8); PG8_WAIT_L(0); PG8_BAR; PG8_MMA(0, 0, At, B0); PG8_MMA(0, 1, At, B1); PG8_BAR; PG8_SCHED;
            PG8_LDA(At, 0, 1); PG8_STAGE(PG8_SB(0, 0), b2, voffB); PG8_STAGE(PG8_SB(0, 1), b2 + hstepB, voffB); PG8_STAGE(PG8_SA(0, 0), a2, voffA);
            PG8_WAIT_V(8); PG8_WAIT_L(0); PG8_BAR; PG8_MMA(1, 0, At, B0); PG8_MMA(1, 1, At, B1); PG8_BAR; PG8_SCHED;
            PG8_LDB(B0, 1, 0); PG8_LDB(B1, 1, 1); PG8_SCHED; PG8_LDA(At, 1, 0); PG8_STAGE(PG8_SA(0, 1), a2 + hstepA, voffA);
            PG8_WAIT_V(8); PG8_WAIT_L(0); PG8_BAR; PG8_MMA(0, 0, At, B0); PG8_MMA(0, 1, At, B1); PG8_BAR; PG8_SCHED;
            PG8_LDA(At, 1, 1); PG8_STAGE(PG8_SB(1, 0), b3, voffB); PG8_STAGE(PG8_SB(1, 1), b3 + hstepB, voffB); PG8_STAGE(PG8_SA(1, 0), a3, voffA);
            PG8_WAIT_V(8); PG8_WAIT_L(0); PG8_BAR; PG8_MMA(1, 0, At, B0); PG8_MMA(1, 1, At, B1); PG8_BAR; PG8_SCHED;
            } else {
            PG8_LDB(B0, 0, 0); PG8_SCHED; PG8_LDA(At, 0, 0); PG8_STAGE(PG8_SA(1, 1), a1 + hstepA, voffA);
            PG8_WAIT_L(8); PG8_BAR; PG8_WAIT_L(0); PG8_MMA(0, 0, At, B0); PG8_BAR; PG8_SCHED;
            PG8_LDB(B1, 0, 1); PG8_STAGE(PG8_SB(0, 0), b2, voffB);
            PG8_BAR; PG8_WAIT_L(0); PG8_MMA(0, 1, At, B1); PG8_BAR;
            PG8_LDA(At, 0, 1); PG8_STAGE(PG8_SA(0, 0), a2, voffA);
            PG8_BAR; PG8_WAIT_L(0); PG8_MMA(1, 0, At, B0); PG8_BAR; PG8_SCHED;
            PG8_STAGE(PG8_SB(0, 1), b2 + hstepB, voffB);
            PG8_WAIT_V(6); PG8_BAR; PG8_MMA(1, 1, At, B1); PG8_BAR;
            PG8_LDB(B0, 1, 0); PG8_SCHED; PG8_LDA(At, 1, 0); PG8_STAGE(PG8_SA(0, 1), a2 + hstepA, voffA);
            PG8_WAIT_L(8); PG8_BAR; PG8_WAIT_L(0); PG8_MMA(0, 0, At, B0); PG8_BAR; PG8_SCHED;
            PG8_LDB(B1, 1, 1); PG8_STAGE(PG8_SB(1, 0), b3, voffB);
            PG8_BAR; PG8_WAIT_L(0); PG8_MMA(0, 1, At, B1); PG8_BAR;
            PG8_LDA(At, 1, 1); PG8_STAGE(PG8_SA(1, 0), a3, voffA);
            PG8_BAR; PG8_WAIT_L(0); PG8_MMA(1, 0, At, B0); PG8_BAR; PG8_SCHED;
            PG8_STAGE(PG8_SB(1, 1), b3 + hstepB, voffB);
            PG8_WAIT_V(6); PG8_BAR; PG8_MMA(1, 1, At, B1); PG8_BAR;
            }
        }
        if constexpr (ALIGN_EPI) { if (wr == 0) PG8_BAR; }
        E(acc, cur, wr, wc, fr, fq);
        if (!has_next) break;
#pragma unroll
        for (int a = 0; a < 2; ++a)
#pragma unroll
            for (int b = 0; b < 2; ++b)
#pragma unroll
                for (int m = 0; m < 4; ++m)
#pragma unroll
                    for (int n = 0; n < 2; ++n) acc[a][b][m][n] = (f32x4){0.f, 0.f, 0.f, 0.f};
        cur = nxt; cA = nA; cB = nB; ++ui;
        if constexpr (ALIGN_EPI) { if (wr == 1) PG8_BAR; }
    }
    PG8_WAIT_V(0);
    if constexpr (!ALIGN_EPI) { if (wr == 0) PG8_BAR; }
    PG8_BAR;
#undef PG8_SA
#undef PG8_SB
#undef PG8_STAGE
#undef PG8_LDA
#undef PG8_LDB
#undef PG8_MMA
#undef PG8_WAIT_V
#undef PG8_WAIT_L
#undef PG8_BAR
#undef PG8_SCHED
}
}

#define XB_TMO      128
#define XB_XCNT(j)  (256  + 64 * (j))
#define XB_XSUB(j)  (1280 + 64 * (j))
#define XB_XGEN(j)  (2304 + 64 * (j))
#define XB_TOP      3328
#define XB_TOPGEN   3392
#define XCD_BAR_WORDS 3456
#define XB_SPIN_CAP (1u << 24)

__device__ __forceinline__ unsigned xb_ld(unsigned* p)              { return __hip_atomic_load(p, __ATOMIC_RELAXED, __HIP_MEMORY_SCOPE_AGENT); }
__device__ __forceinline__ unsigned xb_add(unsigned* p, unsigned v) { return __hip_atomic_fetch_add(p, v, __ATOMIC_RELAXED, __HIP_MEMORY_SCOPE_AGENT); }
__device__ __forceinline__ unsigned xb_xcc_id() { return (unsigned)__builtin_amdgcn_s_getreg((3 << 11) | 20) & 0xFu; }
#define XB_SPIN(cond, bar) do { unsigned _sp = 0; while (cond) { __builtin_amdgcn_s_sleep(1); \
    if ((++_sp & 255u) == 0u) { if (xb_ld(&(bar)[XB_TMO])) break; if (_sp > XB_SPIN_CAP) { atomicAdd(&(bar)[XB_TMO], 1u); break; } } } } while (0)

struct XcdBarrier {
    unsigned* bar; unsigned x;
    volatile LAS unsigned* st;
};
__device__ __forceinline__ XcdBarrier xcd_barrier_post(unsigned* bar, volatile LAS unsigned* st) {
    XcdBarrier b; b.bar = bar; b.x = xb_xcc_id(); b.st = st;
    if (threadIdx.x == 0) (void)xb_add(&bar[XB_XCNT(b.x)], 1u);
    return b;
}
__device__ __forceinline__ void xcd_barrier_complete(unsigned* bar, unsigned x, unsigned& nloc, unsigned& nx) {
    const unsigned G = gridDim.x * gridDim.y * gridDim.z;
    unsigned sum, cnt, mine, sp = 0u;
    for (;;) {
        sum = 0u; cnt = 0u; mine = 0u;
#pragma unroll
        for (unsigned j = 0; j < 16; ++j) { const unsigned c = xb_ld(&bar[XB_XCNT(j)]); sum += c; cnt += (c > 0u) ? 1u : 0u; mine = (j == x) ? c : mine; }
        if (sum == G) break;
        __builtin_amdgcn_s_sleep(1);
        if ((++sp & 255u) == 0u) { if (xb_ld(&bar[XB_TMO])) break; if (sp > XB_SPIN_CAP) { atomicAdd(&bar[XB_TMO], 1u); break; } }
    }
    nloc = mine > 0u ? mine : 1u; nx = cnt > 0u ? cnt : 1u;
}
__device__ __forceinline__ void xcd_barrier(const XcdBarrier& b) {
    asm volatile("s_waitcnt vmcnt(0)" ::: "memory");
    __syncthreads();
    if (threadIdx.x == 0) {
        unsigned* bar = b.bar;
        __builtin_amdgcn_s_waitcnt(0);
        unsigned nloc = b.st[0], nx = b.st[1];
        if (nloc == 0u) { xcd_barrier_complete(bar, b.x, nloc, nx); b.st[0] = nloc; b.st[1] = nx; }
        const unsigned old = xb_add(&bar[XB_XSUB(b.x)], 1u);
        const unsigned gen = old / nloc;
        if (old + 1u == (gen + 1u) * nloc) {
            __builtin_amdgcn_fence(__ATOMIC_RELEASE, "agent");
            asm volatile("s_waitcnt vmcnt(0)" ::: "memory");
            const unsigned og = xb_add(&bar[XB_TOP], 1u);
            const unsigned tg = og / nx;
            if (og + 1u == (tg + 1u) * nx) xb_add(&bar[XB_TOPGEN], 1u);
            else XB_SPIN(xb_ld(&bar[XB_TOPGEN]) == tg, bar);
            __builtin_amdgcn_fence(__ATOMIC_ACQUIRE, "agent");
            xb_add(&bar[XB_XGEN(b.x)], 1u);
            asm volatile("s_waitcnt vmcnt(0)" ::: "memory");
        } else {
            XB_SPIN(xb_ld(&bar[XB_XGEN(b.x)]) == gen, bar);
            __builtin_amdgcn_fence(__ATOMIC_ACQUIRE, "agent");
            asm volatile("s_waitcnt vmcnt(0)" ::: "memory");
        }
    }
    __syncthreads();
}

struct XDesc { int in_idx; long long src_off; int K, N; long long dst; int ldt; int mode; int row_off; };
constexpr int NXD = 28;
__constant__ XDesc c_xd[NXD] = {
    {10, 0LL * 2048 * 5632, 2048, 5632, (long long)(WS_WGU + 0 * SZ_WGU), 2048, 1, 0}, {11, 0LL * 2048 * 5632, 2048, 5632, (long long)(WS_WGU + 0 * SZ_WGU), 2048, 2, 0}, {12, 0LL * 5632 * 2048, 5632, 2048, (long long)(WS_WD + 0 * SZ_WD), 5632, 0, 0},
    {10, 1LL * 2048 * 5632, 2048, 5632, (long long)(WS_WGU + 1 * SZ_WGU), 2048, 1, 0}, {11, 1LL * 2048 * 5632, 2048, 5632, (long long)(WS_WGU + 1 * SZ_WGU), 2048, 2, 0}, {12, 1LL * 5632 * 2048, 5632, 2048, (long long)(WS_WD + 1 * SZ_WD), 5632, 0, 0},
    {10, 2LL * 2048 * 5632, 2048, 5632, (long long)(WS_WGU + 2 * SZ_WGU), 2048, 1, 0}, {11, 2LL * 2048 * 5632, 2048, 5632, (long long)(WS_WGU + 2 * SZ_WGU), 2048, 2, 0}, {12, 2LL * 5632 * 2048, 5632, 2048, (long long)(WS_WD + 2 * SZ_WD), 5632, 0, 0},
    {10, 3LL * 2048 * 5632, 2048, 5632, (long long)(WS_WGU + 3 * SZ_WGU), 2048, 1, 0}, {11, 3LL * 2048 * 5632, 2048, 5632, (long long)(WS_WGU + 3 * SZ_WGU), 2048, 2, 0}, {12, 3LL * 5632 * 2048, 5632, 2048, (long long)(WS_WD + 3 * SZ_WD), 5632, 0, 0},
    {13, 0LL * 2048 * 512, 2048, 512, (long long)(WS_W1 + 0 * SZ_W1), 2048, 0, 0}, {16, 0LL * 2048 * 512, 2048, 512, (long long)(WS_W1 + 0 * SZ_W1), 2048, 0, 512}, {18, 0LL * 2048 * 64, 2048, 64, (long long)(WS_W1 + 0 * SZ_W1), 2048, 0, 1024},
    {15, 0LL * 512 * 3072, 512, 3072, (long long)(WS_WUQ + 0 * SZ_WUQ), 512, 0, 0}, {19, 0LL * 512 * 4096, 512, 4096, (long long)(WS_WUKV + 0 * SZ_WUKV), 512, 0, 0}, {20, 0LL * 2048 * 2048, 2048, 2048, (long long)(WS_WO + 0 * SZ_WO), 2048, 0, 0},
    {13, 1LL * 2048 * 512, 2048, 512, (long long)(WS_W1 + 1 * SZ_W1), 2048, 0, 0}, {16, 1LL * 2048 * 512, 2048, 512, (long long)(WS_W1 + 1 * SZ_W1), 2048, 0, 512}, {18, 1LL * 2048 * 64, 2048, 64, (long long)(WS_W1 + 1 * SZ_W1), 2048, 0, 1024},
    {15, 1LL * 512 * 3072, 512, 3072, (long long)(WS_WUQ + 1 * SZ_WUQ), 512, 0, 0}, {19, 1LL * 512 * 4096, 512, 4096, (long long)(WS_WUKV + 1 * SZ_WUKV), 512, 0, 0}, {20, 1LL * 2048 * 2048, 2048, 2048, (long long)(WS_WO + 3 * SZ_WO), 2048, 0, 0},
    {21, 0, 2048, 6144, (long long)WS_WIN, 2048, 0, 0}, {34, 0, 2048, 2048, (long long)(WS_WO + 1 * SZ_WO), 2048, 0, 0}, {31, 0, 64, 8192, (long long)WS_W3, 256, 0, 0},
    {36, 0, 2048, 2048, (long long)(WS_WO + 2 * SZ_WO), 2048, 0, 0},
};
__device__ __forceinline__ void transpose_item(const float* W, int ldw, bf16_t* WT, int ldt, int k0, int n0, int drow0, LAS float* scr, int lane) {
#pragma unroll 8
    for (int i = 0; i < 32; ++i) { const int kk = 2 * i + (lane >> 5); scr[kk * 33 + (lane & 31)] = W[(size_t)(k0 + kk) * ldw + n0 + (lane & 31)]; }
    LDS_WAIT(); asm volatile("" ::: "memory");
    const int c = lane & 7;
#pragma unroll
    for (int j = 0; j < 4; ++j) { const int n = (lane >> 3) + 8 * j; const LAS float* s = scr + (8 * c) * 33 + n;
        v4u o; o.x = pk2(s[0 * 33], s[1 * 33]); o.y = pk2(s[2 * 33], s[3 * 33]); o.z = pk2(s[4 * 33], s[5 * 33]); o.w = pk2(s[6 * 33], s[7 * 33]);
        *(GAS v4u*)(WT + (size_t)(drow0 + n) * ldt + k0 + 8 * c) = o; }
    LDS_WAIT(); asm volatile("" ::: "memory");
}

struct Args { const float* in[38]; float* out; unsigned char* ws; int ph_lo, ph_hi, li, pad; };
enum { I_XP = 0, I_XS, I_C, I_CCKV, I_CKR, I_CCTX, I_ADAW, I_ADAB, I_LNG, I_LNB, I_FG, I_FU, I_FD, I_DQ, I_QN, I_UQ, I_DKV, I_KVN, I_WKR, I_UKV, I_WOM,
       I_HWIN, I_HBIN, I_HCW, I_HCB, I_HW1, I_HB1, I_HFR1, I_HW2, I_HB2, I_HFR2, I_HW3, I_HDEC, I_HSKIP, I_HWOUT, I_HBOUT, I_FNW, I_FNB };
constexpr size_t OUT_CKV = (size_t)NTOK * D, OUT_KR = OUT_CKV + (size_t)16 * 2 * 256 * 512;

__device__ __forceinline__ int group_of_row(int row) { return row < NCTX ? 0 : (row < NCTX + 4096 ? 1 : 2); }
__device__ __forceinline__ int kvrow_of_row(int row) { return row < NCTX ? row : (row < NCTX + 4096 ? row : row + 512); }

__device__ __forceinline__ void p0_prologue(const Args& a, LAS unsigned char* lds, int tid, int lane, int wave, int vcu, int G) {
    unsigned char* ws = a.ws;
    const int gw = vcu * NWAVES + wave, NGW = G * NWAVES; const size_t gt = (size_t)vcu * NTHREADS + tid, NGT = (size_t)G * NTHREADS;
    { LAS float* scr = (LAS float*)(lds + wave * 16384);
      for (int d = 0; d < NXD; ++d) {
        const XDesc x = c_xd[d]; const float* W = a.in[x.in_idx] + x.src_off; bf16_t* WT = (bf16_t*)(ws + x.dst); const int nnb = x.N / 32, items = (x.K / 64) * nnb;
        for (int it = gw; it < items; it += NGW) { const int kb = it / nnb, nb = it - kb * nnb, n0 = 32 * nb;
            const int drow0 = x.mode == 0 ? x.row_off + n0 : ((n0 >> 7) * 256 + (n0 & 127) + (x.mode == 2 ? 128 : 0));
            transpose_item(W, x.N, WT, x.ldt, 64 * kb, n0, drow0, scr, lane); }
      } }
    { const v4u z = {0u, 0u, 0u, 0u};
      for (size_t i = gt; i < (size_t)2 * 192 * 256; i += NGT) { const int j = (int)(i / (192 * 256)); const size_t r = i % (192 * 256); *(GAS v4u*)(ws + WS_W1 + j * SZ_W1 + (size_t)1088 * 2048 * 2 + r * 16) = z; }
      for (size_t i = gt; i < (size_t)8192 * 24; i += NGT) { const size_t row = i / 24, ch = i % 24; *(GAS v4u*)(ws + WS_W3 + row * 512 + 128 + ch * 16) = z; } }
    { for (size_t i = gt; i < (size_t)512 * 32; i += NGT) { const int row = (int)(i >> 5), c8 = (int)(i & 31) * 8, part = row >> 8, m = row & 255; float v[8];
#pragma unroll
          for (int j = 0; j < 8; ++j) { const int r = (m * (c8 + j)) & 255; float s, c; sincospif((float)r * (1.0f / 128.0f), &s, &c); v[j] = part ? s : c; }
          v4u o; o.x = pk2(v[0], v[1]); o.y = pk2(v[2], v[3]); o.z = pk2(v[4], v[5]); o.w = pk2(v[6], v[7]); *(GAS v4u*)(ws + WS_DFTC + i * 16) = o; }
      for (size_t i = gt; i < (size_t)256 * 64; i += NGT) { const int k = (int)(i >> 6), c8 = (int)(i & 63) * 8; float v[8];
#pragma unroll
          for (int j = 0; j < 8; ++j) { const int col = c8 + j, l = col & 255, r = (k * l) & 255; float s, c; sincospif((float)r * (1.0f / 128.0f), &s, &c); v[j] = (col < 256 ? c : -s) * (1.0f / 256.0f); }
          v4u o; o.x = pk2(v[0], v[1]); o.y = pk2(v[2], v[3]); o.z = pk2(v[4], v[5]); o.w = pk2(v[6], v[7]); *(GAS v4u*)(ws + WS_DMC + i * 16) = o; }
      for (size_t i = gt; i < (size_t)4096 * 1024; i += NGT) { const int k = (int)(i >> 10), c8 = (int)(i & 1023) * 8; float v[8];
#pragma unroll
          for (int j = 0; j < 8; ++j) { const int col = c8 + j, l = col & 4095, r = (k * l) & 4095; float s, c; sincospif((float)r * (1.0f / 2048.0f), &s, &c); v[j] = (col < 4096 ? c : -s) * (1.0f / 1024.0f); }
          v4u o; o.x = pk2(v[0], v[1]); o.y = pk2(v[2], v[3]); o.z = pk2(v[4], v[5]); o.w = pk2(v[6], v[7]); *(GAS v4u*)(ws + WS_DML + i * 16) = o; } }
    { f32x2* rope = (f32x2*)(ws + WS_ROPE);
      for (size_t i = gt; i < (size_t)4096 * 32; i += NGT) { const int t = (int)(i >> 5), p = (int)(i & 31); const float inv = exp2f(-(float)(p & 15) * (13.287712379549449f / 16.0f));
          const float ang = (float)(p < 16 ? (t >> 6) : (t & 63)) * inv; float s, c; sincosf(ang, &s, &c); rope[i] = (f32x2){c, s}; } }
    { for (size_t i = gt; i < (size_t)2 * 2 * 512 * 64; i += NGT) { const int r8 = (int)(i & 63) * 8, p = (int)(i >> 6) & 511, lb = (int)(i >> 15) & 1, j = (int)(i >> 16);
          const float* s = a.in[I_CCKV] + ((size_t)(lb * 2 + j) * 512 + p) * 512 + r8; const f32x4 x0 = *(const f32x4*)s, x1 = *(const f32x4*)(s + 4);
          v4u o; o.x = pk2(x0[0], x0[1]); o.y = pk2(x0[2], x0[3]); o.z = pk2(x1[0], x1[1]); o.w = pk2(x1[2], x1[3]);
          *(GAS v4u*)(ws + WS_CKVN + (size_t)j * NKV * 512 * 2 + ((size_t)(4096 + lb * 4608 + 4096 + p) * 512 + r8) * 2) = o; }
      for (size_t i = gt; i < (size_t)2 * 2 * 512 * 8; i += NGT) { const int r8 = (int)(i & 7) * 8, p = (int)(i >> 3) & 511, lb = (int)(i >> 12) & 1, j = (int)(i >> 13);
          const float* s = a.in[I_CKR] + ((size_t)(lb * 2 + j) * 512 + p) * 64 + r8; const f32x4 x0 = *(const f32x4*)s, x1 = *(const f32x4*)(s + 4);
          v4u o; o.x = pk2(x0[0], x0[1]); o.y = pk2(x0[2], x0[3]); o.z = pk2(x1[0], x1[1]); o.w = pk2(x1[2], x1[3]);
          *(GAS v4u*)(ws + WS_KR + (size_t)j * al256((size_t)NKV * 64 * 2) + ((size_t)(4096 + lb * 4608 + 4096 + p) * 64 + r8) * 2) = o; } }
    { const float* w1 = a.in[I_HW1]; const float* w2 = a.in[I_HW2]; bf16_t* hf2 = (bf16_t*)(ws + WS_HF2);
      const float b1 = a.in[I_HB1][lane], fr1 = a.in[I_HFR1][lane], b2 = a.in[I_HB2][lane], fr2 = a.in[I_HFR2][lane];
      for (int pos = gw; pos < FILT_LD; pos += NGW) { const int L = pos < 4096 ? 4096 : 256, t = pos < 4096 ? pos : pos - 4096;
          float feat = 0.f;
          if (lane == 0) feat = (float)t / (float)(L - 1);
          else if (lane <= 32) { const int b = (lane - 1) & 15; const float band = 1e-4f + (float)b * ((15.0f - 1e-4f) / 15.0f); const float turns = (float)t * band / (float)L; float s, c; sincospif(2.0f * turns, &s, &c); feat = lane <= 16 ? c : -s; }
          float z = b1;
#pragma unroll
          for (int k = 0; k < 33; ++k) z += __shfl(feat, k) * w1[k * 64 + lane];
          const float h1 = sinf(fr1 * z); float z2 = b2;
#pragma unroll 8
          for (int k = 0; k < 64; ++k) z2 += __shfl(h1, k) * w2[k * 64 + lane];
          const float h2 = sinf(fr2 * z2);
          bf16_t* row = hf2 + (size_t)pos * 256; row[lane] = (bf16_t)f2bf(h2); row[64 + lane] = 0; row[128 + lane] = 0; row[192 + lane] = 0; } }
    __syncthreads();
    { LAS float* S = (LAS float*)lds; LAS float* red = (LAS float*)(lds + 24576); float* mod = (float*)(ws + WS_MOD);
      for (int i = tid; i < 3 * 2048; i += NTHREADS) { const int g = i >> 11, k = i & 2047; const float x = g == 0 ? a.in[I_CCTX][k] : a.in[I_C][(g - 1) * 2048 + k]; S[i] = x / (1.0f + __expf(-x)); }
      __syncthreads();
      const int q = tid & 15, kc = tid >> 4;
      for (int it = vcu; it < 768; it += G) { const int l = it / 192, n0 = (it % 192) * 64;
          const float* Wp = a.in[I_ADAW] + (size_t)l * 2048 * 12288 + (size_t)(kc * 64) * 12288 + n0 + 4 * q;
          f32x4 a0 = {0.f, 0.f, 0.f, 0.f}, a1 = a0, a2 = a0;
#pragma unroll 8
          for (int kk = 0; kk < 64; ++kk) { const f32x4 w = *(const f32x4*)(Wp + (size_t)kk * 12288); const int k = kc * 64 + kk; a0 += w * S[k]; a1 += w * S[2048 + k]; a2 += w * S[4096 + k]; }
#pragma unroll
          for (int j = 0; j < 4; ++j) { red[(kc * 3 + 0) * 64 + 4 * q + j] = a0[j]; red[(kc * 3 + 1) * 64 + 4 * q + j] = a1[j]; red[(kc * 3 + 2) * 64 + 4 * q + j] = a2[j]; }
          __syncthreads();
          if (tid < 192) { const int g = tid >> 6, col = tid & 63; float s = a.in[I_ADAB][l * 12288 + n0 + col];
#pragma unroll 8
              for (int k2 = 0; k2 < 32; ++k2) s += red[(k2 * 3 + g) * 64 + col];
              mod[(size_t)(l * 3 + g) * 12288 + n0 + col] = s; }
          __syncthreads(); } }
}

__device__ __forceinline__ void p1_embed(const Args& a, int lane, int wave, int vcu, int G) {
    unsigned char* ws = a.ws; const float* mod = (const float*)(ws + WS_MOD); bf16_t* H = (bf16_t*)(ws + WS_H); bf16_t* U = (bf16_t*)(ws + WS_U);
    for (int row = vcu * NWAVES + wave; row < NTOK; row += G * NWAVES) {
        const float* x = row < NCTX ? a.in[I_XP] + (size_t)row * D : a.in[I_XS] + (size_t)(row - NCTX) * D; const int g = group_of_row(row);
        const float* sh = mod + (size_t)(0 * 3 + g) * 12288 + 0 * 2048; const float* sc = sh + 2048;
#pragma unroll
        for (int j = 0; j < 4; ++j) { const int c = 512 * j + 8 * lane; float v[8], u[8];
#pragma unroll
            for (int h = 0; h < 2; ++h) { const f32x4 xv = *(const f32x4*)(x + c + 4 * h), s1 = *(const f32x4*)(sc + c + 4 * h), s0 = *(const f32x4*)(sh + c + 4 * h);
#pragma unroll
                for (int e = 0; e < 4; ++e) { v[4 * h + e] = xv[e]; u[4 * h + e] = xv[e] * (1.0f + s1[e]) + s0[e]; } }
            v4u o; o.x = pk2(v[0], v[1]); o.y = pk2(v[2], v[3]); o.z = pk2(v[4], v[5]); o.w = pk2(v[6], v[7]); *(GAS v4u*)(H + (size_t)row * D + c) = o;
            o.x = pk2(u[0], u[1]); o.y = pk2(u[2], u[3]); o.z = pk2(u[4], u[5]); o.w = pk2(u[6], u[7]); *(GAS v4u*)(U + (size_t)row * D + c) = o; }
    }
}

__device__ __forceinline__ void ln_phase(const Args& a, LAS unsigned char* lds, int tid, int lane, int wave, int vcu, int G, int l, int gi, int lni, const float* bias, int ln, int si, bool final) {
    unsigned char* ws = a.ws; const float* mod = (const float*)(ws + WS_MOD); bf16_t* H = (bf16_t*)(ws + WS_H); bf16_t* U = (bf16_t*)(ws + WS_U);
    const float* P0 = (const float*)(ws + WS_PART); const float* P1 = P0 + (size_t)NTOK * D;
    LAS float* V = (LAS float*)lds;
    for (int blk = vcu; blk < NTOK / 16; blk += G) {
        const int g = group_of_row(blk * 16);
        __syncthreads();
        for (int i = tid; i < 6 * 2048; i += NTHREADS) { const int v = i >> 11, c = i & 2047; float x;
            if (v == 0) x = mod[(size_t)(l * 3 + g) * 12288 + gi * 2048 + c]; else if (v == 1) x = bias ? bias[c] : 0.f; else if (v == 2) x = a.in[I_LNG][(l * 2 + lni) * 2048 + c];
            else if (v == 3) x = a.in[I_LNB][(l * 2 + lni) * 2048 + c]; else if (v == 4) x = final ? 0.f : mod[(size_t)(ln * 3 + g) * 12288 + si * 2048 + c]; else x = final ? 0.f : mod[(size_t)(ln * 3 + g) * 12288 + (si + 1) * 2048 + c];
            V[i] = x; }
        __syncthreads();
#pragma unroll 1
        for (int rr = 0; rr < 2; ++rr) { const int row = blk * 16 + wave * 2 + rr; float x[32]; float s = 0.f;
            v4u hv[4]; f32x4 pa[4][2], pb[4][2];
#pragma unroll
            for (int j = 0; j < 4; ++j) { const int c = 512 * j + 8 * lane; hv[j] = *(const GAS v4u*)(H + (size_t)row * D + c);
#pragma unroll
                for (int h = 0; h < 2; ++h) { pa[j][h] = *(const f32x4*)(P0 + (size_t)row * D + c + 4 * h); pb[j][h] = *(const f32x4*)(P1 + (size_t)row * D + c + 4 * h); } }
            asm volatile("" ::: "memory");
#pragma unroll
            for (int j = 0; j < 4; ++j) { const int c = 512 * j + 8 * lane; const unsigned hw[4] = {hv[j].x, hv[j].y, hv[j].z, hv[j].w};
#pragma unroll
                for (int h = 0; h < 2; ++h) { const f32x4 gt = *(const LAS f32x4*)(V + c + 4 * h), bs = *(const LAS f32x4*)(V + 2048 + c + 4 * h);
#pragma unroll
                    for (int e = 0; e < 4; ++e) { const float hh = (e & 1) ? bfhi(hw[2 * h + (e >> 1)]) : bflo(hw[2 * h + (e >> 1)]);
                        const float v = DN_ALPHA * hh + gt[e] * (pa[j][h][e] + pb[j][h][e] + bs[e]); x[8 * j + 4 * h + e] = v; s += v; } }
                asm volatile("" ::: "memory"); }
            const float mean = wave_sum(s) * (1.0f / D); float q = 0.f;
#pragma unroll
            for (int i = 0; i < 32; ++i) { x[i] -= mean; q += x[i] * x[i]; }
            const float rstd = 1.0f / sqrtf(wave_sum(q) * (1.0f / D) + LN_EPS);
#pragma unroll
            for (int j = 0; j < 4; ++j) { const int c = 512 * j + 8 * lane; float hn[8], u[8];
#pragma unroll
                for (int h = 0; h < 2; ++h) { const f32x4 lg = *(const LAS f32x4*)(V + 2 * 2048 + c + 4 * h), lb = *(const LAS f32x4*)(V + 3 * 2048 + c + 4 * h), sh = *(const LAS f32x4*)(V + 4 * 2048 + c + 4 * h), sc = *(const LAS f32x4*)(V + 5 * 2048 + c + 4 * h);
#pragma unroll
                    for (int e = 0; e < 4; ++e) { hn[4 * h + e] = x[8 * j + 4 * h + e] * rstd * lg[e] + lb[e]; u[4 * h + e] = hn[4 * h + e] * (1.0f + sc[e]) + sh[e]; } }
                if (final) { float* o = a.out + (size_t)row * D + c; *(f32x4*)o = (f32x4){hn[0], hn[1], hn[2], hn[3]}; *(f32x4*)(o + 4) = (f32x4){hn[4], hn[5], hn[6], hn[7]}; }
                else { v4u o; o.x = pk2(hn[0], hn[1]); o.y = pk2(hn[2], hn[3]); o.z = pk2(hn[4], hn[5]); o.w = pk2(hn[6], hn[7]); *(GAS v4u*)(H + (size_t)row * D + c) = o;
                    o.x = pk2(u[0], u[1]); o.y = pk2(u[2], u[3]); o.z = pk2(u[4], u[5]); o.w = pk2(u[6], u[7]); *(GAS v4u*)(U + (size_t)row * D + c) = o; }
                asm volatile("" ::: "memory"); }
        }
    }
    __syncthreads();
}

__device__ __forceinline__ void mla_norm_phase(const Args& a, int lane, int wave, int vcu, int G, int j) {
    unsigned char* ws = a.ws; const float* T1 = (const float*)(ws + WS_T1); bf16_t* QL = (bf16_t*)(ws + WS_QL);
    bf16_t* CK = (bf16_t*)(ws + WS_CKVN + (size_t)j * NKV * 512 * 2); bf16_t* KR = (bf16_t*)(ws + WS_KR + (size_t)j * al256((size_t)NKV * 64 * 2)); const f32x2* rope = (const f32x2*)(ws + WS_ROPE);
    const float* qn = a.in[I_QN] + j * 512 + 8 * lane; const float* kn = a.in[I_KVN] + j * 512 + 8 * lane;
    for (int row = vcu * NWAVES + wave; row < NTOK; row += G * NWAVES) {
        const float* t = T1 + (size_t)row * 1280; const int kvr = kvrow_of_row(row);
        float q[8], k[8]; float sq = 0.f, sk = 0.f;
        { const f32x4 a0 = *(const f32x4*)(t + 8 * lane), a1 = *(const f32x4*)(t + 8 * lane + 4), b0 = *(const f32x4*)(t + 512 + 8 * lane), b1 = *(const f32x4*)(t + 512 + 8 * lane + 4);
#pragma unroll
          for (int e = 0; e < 4; ++e) { q[e] = a0[e]; q[4 + e] = a1[e]; k[e] = b0[e]; k[4 + e] = b1[e]; } }
#pragma unroll
        for (int e = 0; e < 8; ++e) { sq += q[e] * q[e]; sk += k[e] * k[e]; }
        const float rq = 1.0f / sqrtf(wave_sum(sq) * (1.0f / 512.0f) + RMS_EPS), rk = 1.0f / sqrtf(wave_sum(sk) * (1.0f / 512.0f) + RMS_EPS);
#pragma unroll
        for (int e = 0; e < 8; ++e) { q[e] = q[e] * rq * qn[e]; k[e] = k[e] * rk * kn[e]; }
        v4u o; o.x = pk2(q[0], q[1]); o.y = pk2(q[2], q[3]); o.z = pk2(q[4], q[5]); o.w = pk2(q[6], q[7]); *(GAS v4u*)(QL + (size_t)row * 512 + 8 * lane) = o;
        o.x = pk2(k[0], k[1]); o.y = pk2(k[2], k[3]); o.z = pk2(k[4], k[5]); o.w = pk2(k[6], k[7]); *(GAS v4u*)(CK + (size_t)kvr * 512 + 8 * lane) = o;
        float kr = t[1024 + lane];
        if (row < NCTX) { const int b = row >> 8, tt = row & 255; float* oc = a.out + OUT_CKV + ((size_t)(b * 2 + j) * 256 + tt) * 512 + 8 * lane;
            *(f32x4*)oc = (f32x4){k[0], k[1], k[2], k[3]}; *(f32x4*)(oc + 4) = (f32x4){k[4], k[5], k[6], k[7]};
            a.out[OUT_KR + ((size_t)(b * 2 + j) * 256 + tt) * 64 + lane] = kr; }
        else { const int tp = (row - NCTX) & 4095; const f32x2 cs = rope[(size_t)tp * 32 + (lane >> 1)]; const float other = __shfl_xor(kr, 1);
            kr = (lane & 1) ? (other * cs[1] + kr * cs[0]) : (kr * cs[0] - other * cs[1]); }
        KR[(size_t)kvr * 64 + lane] = (bf16_t)f2bf(kr);
    }
}

__device__ __forceinline__ void attn_naive_phase(const Args& a, int lane, int wave, int vcu, int G, int j) {
    unsigned char* ws = a.ws; const bf16_t* Q = (const bf16_t*)(ws + WS_Q); const bf16_t* KV = (const bf16_t*)(ws + WS_KV);
    const bf16_t* KR = (const bf16_t*)(ws + WS_KR + (size_t)j * al256((size_t)NKV * 64 * 2)); bf16_t* O = (bf16_t*)(ws + WS_MIXO);
    for (int pair = vcu * NWAVES + wave; pair < NTOK * 16; pair += G * NWAVES) {
        const int row = pair >> 4, h = pair & 15; int kv0, nk;
        if (row < NCTX) { kv0 = (row >> 8) * 256; nk = 256; } else { const int lb = (row - NCTX) >> 12; kv0 = 4096 + lb * 4608; nk = 4608; }
        const bf16_t* qp = Q + (size_t)row * 3072 + h * 192; const float q0 = bf2f(qp[lane]), q1 = bf2f(qp[64 + lane]), q2 = bf2f(qp[128 + lane]);
        float m = -1e30f, l = 0.f, o0 = 0.f, o1 = 0.f;
        for (int key = 0; key < nk; key += 4) { float s[4], v0[4], v1[4];
#pragma unroll
            for (int u = 0; u < 4; ++u) { const bf16_t* kp = KV + (size_t)(kv0 + key + u) * 4096 + h * 256;
                s[u] = q0 * bf2f(kp[lane]) + q1 * bf2f(kp[64 + lane]) + q2 * bf2f(KR[(size_t)(kv0 + key + u) * 64 + lane]); v0[u] = bf2f(kp[128 + lane]); v1[u] = bf2f(kp[192 + lane]); }
#pragma unroll
            for (int u = 0; u < 4; ++u) s[u] = wave_sum(s[u]);
#pragma unroll
            for (int u = 0; u < 4; ++u) { const float mn = fmaxf(m, s[u]), al = exp2f(m - mn), p = exp2f(s[u] - mn); l = l * al + p; o0 = o0 * al + p * v0[u]; o1 = o1 * al + p * v1[u]; m = mn; }
        }
        const float il = 1.0f / l; O[(size_t)row * D + h * 128 + lane] = (bf16_t)f2bf(o0 * il); O[(size_t)row * D + h * 128 + 64 + lane] = (bf16_t)f2bf(o1 * il);
    }
}

__device__ __forceinline__ void transpose_zt_phase(const Args& a, LAS unsigned char* lds, int lane, int wave, int vcu, int G) {
    const bf16_t* ZT = (const bf16_t*)(a.ws + WS_ZT); bf16_t* Z = (bf16_t*)(a.ws + WS_MIXO); LAS bf16_t* scr = (LAS bf16_t*)(lds + wave * 16384);
    for (int tile = vcu * NWAVES + wave; tile < 32 * 192; tile += G * NWAVES) { const int c0 = (tile / 192) * 64, t0 = (tile % 192) * 64;
#pragma unroll 8
        for (int i = 0; i < 64; ++i) scr[i * 66 + lane] = ZT[(size_t)(c0 + i) * NTOK + t0 + lane];
        LDS_WAIT(); asm volatile("" ::: "memory");
#pragma unroll 8
        for (int t = 0; t < 64; ++t) Z[(size_t)(t0 + t) * D + c0 + lane] = scr[lane * 66 + t];
        LDS_WAIT(); asm volatile("" ::: "memory"); }
}

namespace att {
using bf16x8 = __attribute__((ext_vector_type(8))) short;
using s16x4  = __attribute__((ext_vector_type(4))) short;
using f32x16 = __attribute__((ext_vector_type(16))) float;
using u32x4  = __attribute__((ext_vector_type(4))) unsigned;
constexpr int NW = 8, QBLK = 32, KVBLK = 64;
constexpr int LDQ = 3072, LDKV = 4096, LDKR = 64, LDO = 2048;
constexpr int SHM_V = KVBLK * 128 * 2, SHM_KN = KVBLK * 128 * 2, SHM_KR = KVBLK * 64 * 2, SHM_QR = NW * 32 * 64 * 2;
constexpr int OFF_KN = 2 * SHM_V, OFF_KR = OFF_KN + 2 * SHM_KN, OFF_QR = OFF_KR + 2 * SHM_KR, OFF_WS = OFF_QR + SHM_QR, SHM_ATTN = OFF_WS + NW * 64 * 4;
constexpr float THR2 = 11.5f;
#define AT_KSWZ(row, colB) ((row) * 256 + ((colB) ^ (((row) & 7) << 4)))
#define AT_RSWZ(row, chunk) ((row) * 128 + ((((chunk) ^ (((row) >> 1) & 7))) << 4))
#define AT_SBAR() __builtin_amdgcn_sched_barrier(0)
__device__ __forceinline__ int crow(int r, int hi) { return (r & 3) + 8 * (r >> 2) + 4 * hi; }
__device__ __forceinline__ unsigned cvtpk(float lo, float hi) { unsigned r; asm volatile("v_cvt_pk_bf16_f32 %0, %1, %2" : "=v"(r) : "v"(lo), "v"(hi)); return r; }

__device__ __forceinline__ void partialSM(f32x16& p0, f32x16& p1, float& m_reg, float& mn, float& alpha) {
  float pmax = p0[0];
#pragma unroll
  for (int r = 1; r < 16; ++r) pmax = fmaxf(pmax, p0[r]);
#pragma unroll
  for (int r = 0; r < 16; ++r) pmax = fmaxf(pmax, p1[r]);
  { auto rr = __builtin_amdgcn_permlane32_swap(__float_as_uint(pmax), __float_as_uint(pmax), false, false);
    pmax = fmaxf(__uint_as_float(rr[0]), __uint_as_float(rr[1])); }
  if (__builtin_expect(__all(pmax - m_reg <= THR2), 1)) { mn = m_reg; alpha = 1.f; }
  else { mn = fmaxf(m_reg, pmax); alpha = __builtin_amdgcn_exp2f(m_reg - mn); m_reg = mn; }
#pragma unroll
  for (int r = 0; r < 16; ++r) p0[r] = p0[r] - mn;
#pragma unroll
  for (int r = 0; r < 16; ++r) p1[r] = p1[r] - mn;
#pragma unroll
  for (int r = 0; r < 16; ++r) p0[r] = __builtin_amdgcn_exp2f(p0[r]);
}
__device__ __forceinline__ void finishSM(f32x16& p0, f32x16& p1, float alpha, float& l_reg, bf16x8& pa0, bf16x8& pa1, bf16x8& pa2, bf16x8& pa3) {
#pragma unroll
  for (int r = 0; r < 16; ++r) p1[r] = __builtin_amdgcn_exp2f(p1[r]);
  float ps = 0;
#pragma unroll
  for (int r = 0; r < 16; ++r) ps += p0[r];
#pragma unroll
  for (int r = 0; r < 16; ++r) ps += p1[r];
  { auto rr = __builtin_amdgcn_permlane32_swap(__float_as_uint(ps), __float_as_uint(ps), false, false);
    ps = __uint_as_float(rr[0]) + __uint_as_float(rr[1]); }
  l_reg = l_reg * alpha + ps;
#define AT_PK4(P, BASE, OUT) do { unsigned a0 = cvtpk(P[BASE + 0], P[BASE + 1]), a1 = cvtpk(P[BASE + 2], P[BASE + 3]);   \
    unsigned b0 = cvtpk(P[BASE + 4], P[BASE + 5]), b1 = cvtpk(P[BASE + 6], P[BASE + 7]);                              \
    auto r0 = __builtin_amdgcn_permlane32_swap(a0, b0, false, false); auto r1 = __builtin_amdgcn_permlane32_swap(a1, b1, false, false); \
    u32x4 w = {r0[0], r1[0], r0[1], r1[1]}; OUT = *reinterpret_cast<bf16x8*>(&w); } while (0)
  AT_PK4(p0, 0, pa0); AT_PK4(p0, 8, pa1); AT_PK4(p1, 0, pa2); AT_PK4(p1, 8, pa3);
#undef AT_PK4
}
__device__ __forceinline__ void qkt(f32x16& p0, f32x16& p1, const LAS char* Kn, const LAS char* Kr, const bf16x8* qr, const LAS char* Qr, int r32, int hi) {
  p0 = f32x16{}; p1 = f32x16{};
#pragma unroll
  for (int d0 = 0; d0 < 8; ++d0) { const int cb = (d0 * 16 + hi * 8) * 2;
    const bf16x8 b0 = *reinterpret_cast<const LAS bf16x8*>(Kn + AT_KSWZ(r32, cb));
    const bf16x8 b1 = *reinterpret_cast<const LAS bf16x8*>(Kn + AT_KSWZ(32 + r32, cb));
    p0 = __builtin_amdgcn_mfma_f32_32x32x16_bf16(b0, qr[d0], p0, 0, 0, 0);
    p1 = __builtin_amdgcn_mfma_f32_32x32x16_bf16(b1, qr[d0], p1, 0, 0, 0); }
#pragma unroll
  for (int d0 = 0; d0 < 4; ++d0) { const int ch = 2 * d0 + hi;
    const bf16x8 b0 = *reinterpret_cast<const LAS bf16x8*>(Kr + AT_RSWZ(r32, ch));
    const bf16x8 b1 = *reinterpret_cast<const LAS bf16x8*>(Kr + AT_RSWZ(32 + r32, ch));
    const bf16x8 q = *reinterpret_cast<const LAS bf16x8*>(Qr + AT_RSWZ(r32, ch));
    p0 = __builtin_amdgcn_mfma_f32_32x32x16_bf16(b0, q, p0, 0, 0, 0);
    p1 = __builtin_amdgcn_mfma_f32_32x32x16_bf16(b1, q, p1, 0, 0, 0); }
}
__device__ __forceinline__ int v_st(int k, int c) { const int kk = (k & ~0xC) | ((k & 4) << 1) | ((k & 8) >> 1); return ((kk >> 3) * 4 + (c >> 5)) * 512 + ((kk & 7) * 32 + (c & 31)) * 2; }
__device__ __forceinline__ int v_rd_base(int lane) { return ((lane & 3) << 3) | (((lane >> 2) & 3) << 6) | (((lane >> 4) & 1) << 5) | (((lane >> 5) & 1) << 8); }
constexpr int v_rd_off(int d0, int ks, int half) { return d0 * 512 + ks * 4096 + half * 2048; }
template <int OFF> __device__ __forceinline__ s16x4 tr_read(int vb) {
  s16x4 r; asm volatile("ds_read_b64_tr_b16 %0, %1 offset:%2" : "=&v"(r) : "v"(vb), "i"(OFF) : "memory"); return r;
}
template <int D0> __device__ __forceinline__ void pv_one(f32x16& od, int vb, bf16x8 pa0, bf16x8 pa1, bf16x8 pa2, bf16x8 pa3) {
  const s16x4 l0 = tr_read<v_rd_off(D0, 0, 0)>(vb), h0 = tr_read<v_rd_off(D0, 0, 1)>(vb), l1 = tr_read<v_rd_off(D0, 1, 0)>(vb), h1 = tr_read<v_rd_off(D0, 1, 1)>(vb);
  const s16x4 l2 = tr_read<v_rd_off(D0, 2, 0)>(vb), h2 = tr_read<v_rd_off(D0, 2, 1)>(vb), l3 = tr_read<v_rd_off(D0, 3, 0)>(vb), h3 = tr_read<v_rd_off(D0, 3, 1)>(vb);
  asm volatile("s_waitcnt lgkmcnt(0)" ::: "memory"); AT_SBAR();
#define AT_PK(L, H) (bf16x8){L[0], L[1], L[2], L[3], H[0], H[1], H[2], H[3]}
  od = __builtin_amdgcn_mfma_f32_32x32x16_bf16(pa0, AT_PK(l0, h0), od, 0, 0, 0);
  od = __builtin_amdgcn_mfma_f32_32x32x16_bf16(pa1, AT_PK(l1, h1), od, 0, 0, 0);
  od = __builtin_amdgcn_mfma_f32_32x32x16_bf16(pa2, AT_PK(l2, h2), od, 0, 0, 0);
  od = __builtin_amdgcn_mfma_f32_32x32x16_bf16(pa3, AT_PK(l3, h3), od, 0, 0, 0);
#undef AT_PK
}
__device__ __forceinline__ void pv_d0(f32x16* o, int vb, bf16x8 pa0, bf16x8 pa1, bf16x8 pa2, bf16x8 pa3) {
  pv_one<0>(o[0], vb, pa0, pa1, pa2, pa3); pv_one<1>(o[1], vb, pa0, pa1, pa2, pa3); pv_one<2>(o[2], vb, pa0, pa1, pa2, pa3); pv_one<3>(o[3], vb, pa0, pa1, pa2, pa3);
}

__device__ __forceinline__ void attn_unit(const bf16_t* __restrict__ Qb, const bf16_t* __restrict__ KVh, const bf16_t* __restrict__ KRb, bf16_t* __restrict__ Ob, int seq, LAS char* lds) {
  const int tid = threadIdx.x, wid = __builtin_amdgcn_readfirstlane(tid >> 6), lane = tid & 63, r32 = lane & 31, hi = lane >> 5;
  LAS char* V_lds = lds; LAS char* Kn_lds = lds + OFF_KN; LAS char* Kr_lds = lds + OFF_KR; LAS char* Qr = lds + OFF_QR + wid * 4096;
  LAS float* ws = (LAS float*)(lds + OFF_WS) + wid * 64; LAS float* li_l = ws; LAS float* al_l = ws + 32;
  float m_reg = -1e30f, l_reg = 0; f32x16 o[4] = {}; bf16x8 qr[8];
  const bf16_t* Qw = Qb + (long)(wid * QBLK + r32) * LDQ + hi * 8;
#pragma unroll
  for (int d0 = 0; d0 < 8; ++d0) qr[d0] = *reinterpret_cast<const bf16x8*>(Qw + d0 * 16);
#pragma unroll
  for (int d0 = 0; d0 < 4; ++d0) *reinterpret_cast<LAS bf16x8*>(Qr + AT_RSWZ(r32, 2 * d0 + hi)) = *reinterpret_cast<const bf16x8*>(Qw + 128 + d0 * 16);
  const int sr = tid >> 4, sc = (tid & 15) * 8, vst0 = v_st(sr, sc), vst1 = v_st(32 + sr, sc);
  const int vb0 = (int)(uintptr_t)V_lds + v_rd_base(lane);
  const bf16_t* Vg = KVh + 128 + (long)sr * LDKV + sc;
  const int kn_row = wid * 4 + (lane >> 4), kn_ch = (lane & 15) ^ (kn_row & 7);
  const int kr_row = wid * 8 + (lane >> 3), kr_ch = (lane & 7) ^ ((kr_row >> 1) & 7);
  const bf16_t* Kg = KVh + (long)kn_row * LDKV + kn_ch * 8; const bf16_t* Rg = KRb + (long)kr_row * LDKR + kr_ch * 8;
  bf16x8 vs0, vs1;
#define AT_KDMA(b, k0) do { \
    __builtin_amdgcn_global_load_lds((const unsigned*)(Kg + (long)(k0) * LDKV), (LAS unsigned*)(Kn_lds + (b) * SHM_KN + wid * 1024), 16, 0, 0); \
    __builtin_amdgcn_global_load_lds((const unsigned*)(Kg + (long)((k0) + 32) * LDKV), (LAS unsigned*)(Kn_lds + (b) * SHM_KN + 8192 + wid * 1024), 16, 0, 0); \
    __builtin_amdgcn_global_load_lds((const unsigned*)(Rg + (long)(k0) * LDKR), (LAS unsigned*)(Kr_lds + (b) * SHM_KR + wid * 1024), 16, 0, 0); } while (0)
#define AT_SLOAD(b, k0) do { AT_KDMA(b, k0); vs0 = *reinterpret_cast<const bf16x8*>(Vg + (long)(k0) * LDKV); vs1 = *reinterpret_cast<const bf16x8*>(Vg + (long)((k0) + 32) * LDKV); } while (0)
#define AT_SWRITE(b) do { *(LAS bf16x8*)(V_lds + (b) * SHM_V + vst0) = vs0; *(LAS bf16x8*)(V_lds + (b) * SHM_V + vst1) = vs1; } while (0)
#define AT_SWAIT() asm volatile("s_waitcnt vmcnt(0)" ::: "memory")
#define AT_RESC(a) do { if (__any((a) < 1.f)) { if (hi == 0) al_l[r32] = (a); asm volatile("s_waitcnt lgkmcnt(0)" ::: "memory"); \
    _Pragma("unroll") for (int d = 0; d < 4; ++d) _Pragma("unroll") for (int r = 0; r < 16; ++r) o[d][r] *= al_l[crow(r, hi)]; } } while (0)
  f32x16 pA0, pA1, pB0, pB1; float mnA, mnB, alA, alB; bf16x8 pa0, pa1, pa2, pa3; const int NT = seq / KVBLK;
  AT_SLOAD(0, 0); AT_SWAIT(); AT_SWRITE(0); __syncthreads();
  qkt(pA0, pA1, Kn_lds, Kr_lds, qr, Qr, r32, hi); partialSM(pA0, pA1, m_reg, mnA, alA);
  AT_SLOAD(1, KVBLK);
  AT_SWAIT(); AT_SWRITE(1); __syncthreads();
  for (int j = 1; j + 1 < NT; j += 2) {
    AT_SBAR(); qkt(pB0, pB1, Kn_lds + SHM_KN, Kr_lds + SHM_KR, qr, Qr, r32, hi);
    finishSM(pA0, pA1, alA, l_reg, pa0, pa1, pa2, pa3); AT_SBAR();
    AT_SLOAD(0, (j + 1) * KVBLK); AT_SBAR();
    pv_d0(o, vb0, pa0, pa1, pa2, pa3); partialSM(pB0, pB1, m_reg, mnB, alB);
    AT_SWAIT(); __syncthreads(); AT_SWRITE(0);
    AT_RESC(alB); __syncthreads();
    AT_SBAR(); qkt(pA0, pA1, Kn_lds, Kr_lds, qr, Qr, r32, hi);
    finishSM(pB0, pB1, alB, l_reg, pa0, pa1, pa2, pa3); AT_SBAR();
    AT_SLOAD(1, (j + 2) * KVBLK); AT_SBAR();
    pv_d0(o, vb0 + SHM_V, pa0, pa1, pa2, pa3); partialSM(pA0, pA1, m_reg, mnA, alA);
    AT_SWAIT(); __syncthreads(); AT_SWRITE(1);
    AT_RESC(alA); __syncthreads();
  }
  AT_SBAR(); qkt(pB0, pB1, Kn_lds + SHM_KN, Kr_lds + SHM_KR, qr, Qr, r32, hi);
  finishSM(pA0, pA1, alA, l_reg, pa0, pa1, pa2, pa3); AT_SBAR();
  pv_d0(o, vb0, pa0, pa1, pa2, pa3); partialSM(pB0, pB1, m_reg, mnB, alB);
  __syncthreads(); AT_RESC(alB);
  finishSM(pB0, pB1, alB, l_reg, pa0, pa1, pa2, pa3); AT_SBAR();
  pv_d0(o, vb0 + SHM_V, pa0, pa1, pa2, pa3);
  if (hi == 0) li_l[r32] = l_reg; asm volatile("s_waitcnt lgkmcnt(0)" ::: "memory");
  float rli[16];
#pragma unroll
  for (int r = 0; r < 16; ++r) rli[r] = __builtin_amdgcn_rcpf(li_l[crow(r, hi)]);
  bf16_t* Ow = Ob + (long)(wid * QBLK) * LDO;
  const int odd = lane & 1;
#pragma unroll
  for (int r = 0; r < 16; r += 2) {
#pragma unroll
    for (int d0 = 0; d0 < 4; ++d0) { const float a = o[d0][r] * rli[r], b = o[d0][r + 1] * rli[r + 1];
      const float recv = __shfl_xor(odd ? a : b, 1);
      const unsigned w = odd ? cvtpk(recv, b) : cvtpk(a, recv); const int orow = crow(odd ? r + 1 : r, hi);
      *(unsigned*)(Ow + (long)orow * LDO + d0 * 32 + (r32 & ~1)) = w; } }
#undef AT_SLOAD
#undef AT_KDMA
#undef AT_SWRITE
#undef AT_SWAIT
#undef AT_RESC
}
}

__device__ __forceinline__ void attn_phase(const Args& a, LAS unsigned char* lds, int vcu, int G, int j) {
    unsigned char* ws = a.ws; const bf16_t* Q = (const bf16_t*)(ws + WS_Q); const bf16_t* KV = (const bf16_t*)(ws + WS_KV);
    const bf16_t* KR = (const bf16_t*)(ws + WS_KR + (size_t)j * al256((size_t)NKV * 64 * 2)); bf16_t* O = (bf16_t*)(ws + WS_MIXO);
    for (int u = vcu; u < 768; u += G) {
        int qrow0, kv0, seq, h;
        if (u < 512) { const int lb = u >> 8, qb = u & 15; h = (u >> 4) & 15; qrow0 = NCTX + lb * 4096 + qb * 256; kv0 = 4096 + lb * 4608; seq = 4608; }
        else { const int c = u - 512, b = c >> 4; h = c & 15; qrow0 = b * 256; kv0 = b * 256; seq = 256; }
        __syncthreads();
        att::attn_unit(Q + (size_t)qrow0 * 3072 + h * 192, KV + (size_t)kv0 * 4096 + h * 256, KR + (size_t)kv0 * 64, O + (size_t)qrow0 * D + h * 128, seq, (LAS char*)lds);
    }
    __syncthreads();
}

struct SchedGrid {
    const char* A; const char* B; char* O;
    size_t a_pm, b_pn, a_s, b_s, o_pm, o_pn, o_s;
    int ldc, nM, nN, nS, G, c;
    __device__ __forceinline__ bool next(int i, pg8::Unit& u) const {
        const int L = i * G + c, per = nM * nN; if (L >= per * nS) return false;
        const int s = L / per; int pm, pn; pg8::tile_of(L - s * per, nM, nN, pm, pn);
        u.A = A + pm * a_pm + s * a_s; u.B = B + pn * b_pn + s * b_s; u.O = O + pm * o_pm + pn * o_pn + s * o_s; u.ldc = ldc; u.pm = pm; u.pn = pn; u.aux = s; return true;
    }
};
struct SchedPair {
    SchedGrid g0, g1; int G, c;
    __device__ __forceinline__ bool next(int i, pg8::Unit& u) const {
        const int L = i * G + c, n0 = g0.nM * g0.nN;
        if (L < n0) { int pm, pn; pg8::tile_of(L, g0.nM, g0.nN, pm, pn); u.A = g0.A + pm * g0.a_pm; u.B = g0.B + pn * g0.b_pn; u.O = g0.O + pm * g0.o_pm + pn * g0.o_pn; u.ldc = g0.ldc; u.pm = pm; u.pn = pn; u.aux = 0; return true; }
        const int L1 = L - n0; if (L1 >= g1.nM * g1.nN) return false;
        int pm, pn; pg8::tile_of(L1, g1.nM, g1.nN, pm, pn); u.A = g1.A + pm * g1.a_pm; u.B = g1.B + pn * g1.b_pn; u.O = g1.O + pm * g1.o_pm + pn * g1.o_pn; u.ldc = g1.ldc; u.pm = pm; u.pn = pn; u.aux = 1; return true;
    }
};
struct SchedF1 {
    const char* dftc; const char* U; char* atc; char* atl; int G, c;
    __device__ __forceinline__ bool next(int i, pg8::Unit& u) const {
        const int L = i * G + c; if (L >= 768) return false;
        const int part = L & 1, g = (L >> 1) & 7, tt = L >> 4;
        u.A = dftc + (size_t)part * 256 * 256 * 2; u.B = U + ((size_t)tt * 256 * D + g * 256) * 2;
        if (tt < 16) { u.O = atc + ((size_t)tt * 2048 * 512 + (size_t)(g * 256) * 512 + part * 256) * 2; u.ldc = 512; }
        else { const int lb = (tt - 16) >> 4, l0 = ((tt - 16) & 15) * 256; u.O = atl + ((size_t)lb * 2048 * 8192 + (size_t)(g * 256) * 8192 + part * 4096 + l0) * 2; u.ldc = 8192; }
        u.pm = part; u.pn = tt; u.aux = g; return true;
    }
};

#define DEVFN __device__ __forceinline__
#define C2_TYPEDEF typedef float c2 __attribute__((ext_vector_type(2)));
#define LDSP LAS
#define OPAQUE(x) asm volatile("" : "+v"(x))
#define U32X4 v4u
#define U32X2 v2u
#define LOAD16(p) (*(const v4u*)(p))
#define LOAD8(p) (*(const v2u*)(p))
#define STORE16(p, v) (*(v4u*)(p) = (v))
#define STORE8(p, v) (*(v2u*)(p) = (v))
#define BFLO(w) bflo(w)
#define BFHI(w) bfhi(w)
#define PK2(a, b) pk2(a, b)
#define BF2F(x) bf2f(x)
#define F2BF(x) ((bf16_t)f2bf(x))
#define COS_TURNS(x) __builtin_amdgcn_cosf(x)
#define SIN_TURNS(x) __builtin_amdgcn_sinf(x)
#define EXPF(x) __expf(x)
#define RSQRTF(x) (1.0f / sqrtf(x))
#define WAVE_SUM(v) wave_sum(v)
#define BLOCK_SYNC() __syncthreads()
C2_TYPEDEF
DEVFN c2 cmul(c2 a, c2 b) { c2 r; r.x = a.x * b.x - a.y * b.y; r.y = a.x * b.y + a.y * b.x; return r; }
DEVFN c2 cmulc(c2 a, c2 b) { c2 r; r.x = a.x * b.x + a.y * b.y; r.y = a.y * b.x - a.x * b.y; return r; }
template <int LOGN, int S, int G, bool INV>
DEVFN void fft_pass(LDSP c2* x, int total, int tid) {
    OPAQUE(tid);
    constexpr int N = 1 << LOGN, R = 1 << G, H3 = N >> (S + G);
    const int ngroups = total / R;
#pragma unroll 1
    for (int j = tid; j < ngroups; j += NTHREADS) {
        const int tr = j / (N / R), jj = j % (N / R), blk = jj / H3, pos = jj % H3;
        const int i0 = tr * N + blk * (R * H3) + pos;
        c2 v[R];
#pragma unroll
        for (int q = 0; q < R; ++q) v[q] = x[i0 + q * H3];
#pragma unroll
        for (int gg = 0; gg < G; ++gg) {
            const int g = INV ? (G - 1 - gg) : gg;
            const int hq = R >> (g + 1);
            const float inv_bs = 1.0f / (float)(H3 * 2 * hq);
#pragma unroll
            for (int q = 0; q < R; ++q) {
                if ((q & hq) == 0) {
                    const int p = pos + (q & (hq - 1)) * H3;
                    const float fr = (float)p * inv_bs;
                    c2 w; w.x = COS_TURNS(fr); w.y = -SIN_TURNS(fr);
                    const c2 a = v[q], b = v[q + hq];
                    if (!INV) { c2 d; d.x = a.x - b.x; d.y = a.y - b.y; v[q].x = a.x + b.x; v[q].y = a.y + b.y; v[q + hq] = cmul(d, w); }
                    else { const c2 bw = cmulc(b, w); v[q].x = a.x + bw.x; v[q].y = a.y + bw.y; v[q + hq].x = a.x - bw.x; v[q + hq].y = a.y - bw.y; }
                }
            }
        }
#pragma unroll
        for (int q = 0; q < R; ++q) x[i0 + q * H3] = v[q];
    }
}
template <int LOGN, bool INV> DEVFN void fft_all(LDSP c2* x, int total, int tid) {
    if constexpr (LOGN == 13) {
        if (!INV) { fft_pass<13, 0, 3, false>(x, total, tid); BLOCK_SYNC(); fft_pass<13, 3, 3, false>(x, total, tid); BLOCK_SYNC(); fft_pass<13, 6, 3, false>(x, total, tid); BLOCK_SYNC(); fft_pass<13, 9, 2, false>(x, total, tid); BLOCK_SYNC(); fft_pass<13, 11, 2, false>(x, total, tid); BLOCK_SYNC(); }
        else { fft_pass<13, 11, 2, true>(x, total, tid); BLOCK_SYNC(); fft_pass<13, 9, 2, true>(x, total, tid); BLOCK_SYNC(); fft_pass<13, 6, 3, true>(x, total, tid); BLOCK_SYNC(); fft_pass<13, 3, 3, true>(x, total, tid); BLOCK_SYNC(); fft_pass<13, 0, 3, true>(x, total, tid); BLOCK_SYNC(); }
    } else {
        static_assert(LOGN == 9 || LOGN == 13, "fft sizes");
        if (!INV) { fft_pass<9, 0, 3, false>(x, total, tid); BLOCK_SYNC(); fft_pass<9, 3, 3, false>(x, total, tid); BLOCK_SYNC(); fft_pass<9, 6, 3, false>(x, total, tid); BLOCK_SYNC(); }
        else { fft_pass<9, 6, 3, true>(x, total, tid); BLOCK_SYNC(); fft_pass<9, 3, 3, true>(x, total, tid); BLOCK_SYNC(); fft_pass<9, 0, 3, true>(x, total, tid); BLOCK_SYNC(); }
    }
}
struct HyParams {
    float dec[2][2];
    float skip[2];
    float cw[3][3];
    float cb[3];
};
template <int NV>
DEVFN void hy_short_vec(const bf16_t* Pcol, unsigned o, int t0, int L, float w0, float w1, float w2, float cb, float (&out)[NV]) {
    float x[NV + 2];
    if constexpr (NV == 8) { const U32X4 r = LOAD16(Pcol + o); const unsigned w[4] = {r.x, r.y, r.z, r.w};
#pragma unroll
        for (int e = 0; e < 4; ++e) { x[1 + 2 * e] = BFLO(w[e]); x[2 + 2 * e] = BFHI(w[e]); } }
    else { const U32X2 r = LOAD8(Pcol + o); x[1] = BFLO(r.x); x[2] = BFHI(r.x); x[3] = BFLO(r.y); x[4] = BFHI(r.y); }
    const bool hl = t0 > 0, hr = t0 + NV < L;
    const float xl = BF2F(Pcol[hl ? o - 1u : o]), xr = BF2F(Pcol[hr ? o + (unsigned)NV : o]);
    x[0] = hl ? xl : 0.f; x[NV + 1] = hr ? xr : 0.f;
#pragma unroll
    for (int e = 0; e < NV; ++e) out[e] = w0 * x[e] + w1 * x[e + 1] + w2 * x[e + 2] + cb;
}
template <int LOGN, int NB, int O>
DEVFN void hy_conv_order(LDSP c2* XB, LDSP c2* KB, LDSP float* red, int c, int region_base, int fpos, const bf16_t* PT, const bf16_t* FILT, const HyParams& hp, bf16_t* ZT, int tid,
                         float (&za)[(NB << (LOGN - 1)) / NTHREADS], float (&zb)[(NB << (LOGN - 1)) / NTHREADS]) {
    constexpr int N = 1 << LOGN, L = N / 2, P = NB * N, PPT = P / NTHREADS, NV = NB * L / NTHREADS;
    static_assert(NV == 8 || NV == 4, "points per thread");
    const bf16_t* Pv = PT + (size_t)c * NTOK; const bf16_t* Pg = PT + (size_t)((1 + O) * 2048 + c) * NTOK;
    const int v0 = NV * tid, pair = v0 / L, t0 = v0 % L, sb = region_base + (2 * pair) * L;
    const bf16_t* Ff = FILT + (size_t)(0 * 4096 + O * 2048 + c) * FILT_LD + fpos; const bf16_t* Fb = FILT + (size_t)(1 * 4096 + O * 2048 + c) * FILT_LD + fpos;
    float ss = 0.f; const float tsc = 1.0f / (float)(L - 1); const float d0 = hp.dec[0][O], d1 = hp.dec[1][O];
#pragma unroll 2
    for (int idx = tid; idx < N; idx += NTHREADS) {
        float kv = 0.f;
        if (idx < L) { const float f = BF2F(Ff[idx]) * (EXPF(-(float)idx * tsc * d0) + 0.05f); ss += f * f; kv = f; }
        else { const int t = (idx == L) ? 0 : (N - idx); const float b = BF2F(Fb[t]) * (EXPF(-(float)t * tsc * d1) + 0.05f); ss += b * b; kv = (idx == L) ? 0.f : b; }
        c2 k; k.x = kv; k.y = 0.f; KB[idx] = k;
    }
    ss = WAVE_SUM(ss);
    BLOCK_SYNC();
    if ((tid & 63) == 0) red[tid >> 6] = ss;
    if (O == 0) { hy_short_vec<NV>(Pv, (unsigned)(sb + t0), t0, L, hp.cw[0][0], hp.cw[0][1], hp.cw[0][2], hp.cb[0], za); hy_short_vec<NV>(Pv, (unsigned)(sb + L + t0), t0, L, hp.cw[0][0], hp.cw[0][1], hp.cw[0][2], hp.cb[0], zb); }
#pragma unroll
    for (int e = 0; e < NV; ++e) { c2 z; z.x = za[e]; z.y = zb[e]; XB[pair * N + t0 + e] = z; c2 zz; zz.x = 0.f; zz.y = 0.f; XB[pair * N + L + t0 + e] = zz; }
    BLOCK_SYNC();
    float tot = 0.f;
#pragma unroll
    for (int w = 0; w < NTHREADS / 64; ++w) tot += red[w];
    const float sc = RSQRTF(tot + 1e-12f) * (1.0f / (float)N);
    fft_all<LOGN, false>(KB, N, tid);
    fft_all<LOGN, false>(XB, P, tid);
#pragma unroll 4
    for (int i = 0; i < PPT; ++i) { const int p = tid + NTHREADS * i, j = p & (N - 1); c2 k = KB[j]; k.x *= sc; k.y *= sc; const c2 xv = XB[p]; XB[p] = cmul(xv, k); }
    BLOCK_SYNC();
    fft_all<LOGN, true>(XB, P, tid);
    { const float sk = hp.skip[O]; float ga[NV], gb[NV];
      hy_short_vec<NV>(Pg, (unsigned)(sb + t0), t0, L, hp.cw[1 + O][0], hp.cw[1 + O][1], hp.cw[1 + O][2], hp.cb[1 + O], ga); hy_short_vec<NV>(Pg, (unsigned)(sb + L + t0), t0, L, hp.cw[1 + O][0], hp.cw[1 + O][1], hp.cw[1 + O][2], hp.cb[1 + O], gb);
#pragma unroll
      for (int e = 0; e < NV; ++e) { const c2 y = XB[pair * N + t0 + e]; za[e] = ga[e] * (y.x + sk * za[e]); zb[e] = gb[e] * (y.y + sk * zb[e]); }
      if (O == 1) { bf16_t* Zc = ZT + (size_t)c * NTOK;
          if constexpr (NV == 8) { U32X4 wa, wb; wa.x = PK2(za[0], za[1]); wa.y = PK2(za[2], za[3]); wa.z = PK2(za[4], za[5]); wa.w = PK2(za[6], za[7]); wb.x = PK2(zb[0], zb[1]); wb.y = PK2(zb[2], zb[3]); wb.z = PK2(zb[4], zb[5]); wb.w = PK2(zb[6], zb[7]);
              STORE16(Zc + (unsigned)(sb + t0), wa); STORE16(Zc + (unsigned)(sb + L + t0), wb); }
          else { U32X2 wa, wb; wa.x = PK2(za[0], za[1]); wa.y = PK2(za[2], za[3]); wb.x = PK2(zb[0], zb[1]); wb.y = PK2(zb[2], zb[3]); STORE8(Zc + (unsigned)(sb + t0), wa); STORE8(Zc + (unsigned)(sb + L + t0), wb); } } }
    BLOCK_SYNC();
}
template <int LOGN, int NB>
DEVFN void hy_conv_unit(LDSP c2* XB, LDSP c2* KB, LDSP float* red, int c, int region_base, int fpos, const bf16_t* PT, const bf16_t* FILT, const HyParams& hp, bf16_t* ZT, int tid) {
    constexpr int NV = (NB << (LOGN - 1)) / NTHREADS;
    float za[NV], zb[NV];
#pragma unroll
    for (int i = 0; i < NV; ++i) { za[i] = 0.f; zb[i] = 0.f; }
    hy_conv_order<LOGN, NB, 0>(XB, KB, red, c, region_base, fpos, PT, FILT, hp, ZT, tid, za, zb);
    hy_conv_order<LOGN, NB, 1>(XB, KB, red, c, region_base, fpos, PT, FILT, hp, ZT, tid, za, zb);
}
__device__ __forceinline__ void hy_conv_phase(const Args& a, LAS unsigned char* lds, int tid, int vcu, int G) {
    unsigned char* ws = a.ws; const bf16_t* PT = (const bf16_t*)(ws + WS_PT); const bf16_t* FILT = (const bf16_t*)(ws + WS_FILT); bf16_t* ZT = (bf16_t*)(ws + WS_ZT);
    LAS c2* XB = (LAS c2*)lds; LAS c2* KB = (LAS c2*)(lds + 65536); LAS float* red = (LAS float*)(lds + LDSCTL_OFF);
    for (int c = vcu; c < 2048; c += G) {
        HyParams hp;
#pragma unroll
        for (int d = 0; d < 2; ++d)
#pragma unroll
            for (int o = 0; o < 2; ++o) hp.dec[d][o] = __expf(a.in[I_HDEC][(d * 2 + o) * 2048 + c]);
        hp.skip[0] = a.in[I_HSKIP][c]; hp.skip[1] = a.in[I_HSKIP][2048 + c];
#pragma unroll
        for (int w = 0; w < 3; ++w) { hp.cb[w] = a.in[I_HCB][w * 2048 + c];
#pragma unroll
            for (int k = 0; k < 3; ++k) hp.cw[w][k] = a.in[I_HCW][k * 6144 + w * 2048 + c]; }
        hy_conv_unit<13, 1>(XB, KB, red, c, 4096, 0, PT, FILT, hp, ZT, tid);
        hy_conv_unit<9, 8>(XB, KB, red, c, 0, 4096, PT, FILT, hp, ZT, tid);
    }
}

constexpr int N_PHASES = 35;
#ifndef MK_PER_PHASE
#define MK_PER_PHASE 0
#endif
#ifndef ATTN_NAIVE
#define ATTN_NAIVE 0
#endif

__global__ void __launch_bounds__(NTHREADS, 2) trunk_fwd(Args args) {
    extern __shared__ __attribute__((aligned(16))) unsigned char lds_raw[];
    LAS unsigned char* lds = (LAS unsigned char*)lds_raw;
    volatile LAS unsigned* MISC = (volatile LAS unsigned*)(lds + MISC_OFF);
    const int tid = threadIdx.x, lane = tid & 63, wave = __builtin_amdgcn_readfirstlane(tid >> 6);
    const int G = gridDim.x, bx = blockIdx.x, vcu = (G % 8 == 0) ? (bx % 8) * (G / 8) + bx / 8 : bx;
    unsigned char* ws = args.ws;
    for (int u = tid; u < (LDS_BYTES - LDSCTL_OFF) / 4; u += NTHREADS) ((LAS unsigned*)(lds + LDSCTL_OFF))[u] = 0u;
    __syncthreads();
    XcdBarrier bar; bar.bar = (unsigned*)(ws + WS_CTL) + 4096; bar.x = 0; bar.st = nullptr;
    if (!MK_PER_PHASE) bar = xcd_barrier_post((unsigned*)(ws + WS_CTL) + 4096, MISC + 8);
    const int lo = args.ph_lo, hi = args.ph_hi;
#ifndef PH_ONLY_LO
#define PH_ONLY_LO 0
#define PH_ONLY_HI 1000
#endif
#define IN(k) ((k) >= PH_ONLY_LO && (k) < PH_ONLY_HI && lo <= (k) && (k) < hi)
#define SEAM(k) do { if (IN(k) && IN((k) + 1)) xcd_barrier(bar); } while (0)
    const char* U = (const char*)(ws + WS_U); const char* MIXO = (const char*)(ws + WS_MIXO); char* PART = (char*)(ws + WS_PART);

#define OUTPROJ(Aptr, Wptr, KTOT) do { SchedGrid S{(const char*)(Aptr), (const char*)(Wptr), PART, (size_t)256 * (KTOT) * 2, (size_t)256 * (KTOT) * 2, (size_t)((KTOT) / 2) * 2, (size_t)((KTOT) / 2) * 2, \
        (size_t)256 * D * 4, (size_t)256 * 4, (size_t)NTOK * D * 4, D, 48, 8, 2, G, bx}; pg8::EpiF32 E; pg8::gemm_phase<pg8::EpiF32, SchedGrid, false, true>(lds, (KTOT) / 2, (KTOT), (KTOT), S, E); } while (0)
#define FFN_BLOCK(l, p, lnext, final) do { \
    if (IN(p)) { SchedGrid S{U, (const char*)(ws + WS_WGU + (size_t)(l) * SZ_WGU), (char*)(ws + WS_ACT), (size_t)256 * D * 2, (size_t)256 * D * 2, 0, 0, (size_t)256 * DFF * 2, (size_t)128 * 2, 0, DFF, 48, 44, 1, G, bx}; \
        pg8::EpiSwiglu E; pg8::gemm_phase<pg8::EpiSwiglu, SchedGrid, false, true>(lds, D, D, D, S, E); } SEAM(p); \
    if (IN((p) + 1)) { OUTPROJ(ws + WS_ACT, ws + WS_WD + (size_t)(l) * SZ_WD, DFF); } SEAM((p) + 1); \
    if (IN((p) + 2)) { ln_phase(args, lds, tid, lane, wave, vcu, G, (l), 5, 1, nullptr, (lnext), 0, (final)); } if (!(final)) SEAM((p) + 2); } while (0)
#define MLA_BLOCK(j, l, p) do { \
    if (IN(p)) { SchedGrid S{U, (const char*)(ws + WS_W1 + (size_t)(j) * SZ_W1), (char*)(ws + WS_T1), (size_t)256 * D * 2, (size_t)256 * D * 2, 0, 0, (size_t)256 * 1280 * 4, (size_t)256 * 4, 0, 1280, 48, 5, 1, G, bx}; \
        pg8::EpiF32 E; pg8::gemm_phase<pg8::EpiF32, SchedGrid, false, true>(lds, D, D, D, S, E); } SEAM(p); \
    if (IN((p) + 1)) { mla_norm_phase(args, lane, wave, vcu, G, (j)); } SEAM((p) + 1); \
    if (IN((p) + 2)) { SchedPair S; \
        S.g0 = SchedGrid{(const char*)(ws + WS_QL), (const char*)(ws + WS_WUQ + (size_t)(j) * SZ_WUQ), (char*)(ws + WS_Q), (size_t)256 * 512 * 2, (size_t)256 * 512 * 2, 0, 0, (size_t)256 * 3072 * 2, (size_t)256 * 2, 0, 3072, 48, 12, 1, G, bx}; \
        S.g1 = SchedGrid{(const char*)(ws + WS_CKVN + (size_t)(j) * NKV * 512 * 2), (const char*)(ws + WS_WUKV + (size_t)(j) * SZ_WUKV), (char*)(ws + WS_KV), (size_t)256 * 512 * 2, (size_t)256 * 512 * 2, 0, 0, (size_t)256 * 4096 * 2, (size_t)256 * 2, 0, 4096, 52, 16, 1, G, bx}; \
        S.G = G; S.c = bx; pg8::EpiQKV E{(const pg8::f32x2*)(ws + WS_ROPE), QSCALE}; pg8::gemm_phase<pg8::EpiQKV, SchedPair, false, true>(lds, 512, 512, 512, S, E); } SEAM((p) + 2); \
    if (IN((p) + 3)) { if (ATTN_NAIVE) attn_naive_phase(args, lane, wave, vcu, G, (j)); else attn_phase(args, lds, vcu, G, (j)); } SEAM((p) + 3); \
    if (IN((p) + 4)) { OUTPROJ(MIXO, ws + WS_WO + (size_t)(l) * SZ_WO, D); } SEAM((p) + 4); \
    if (IN((p) + 5)) { ln_phase(args, lds, tid, lane, wave, vcu, G, (l), 2, 0, nullptr, (l), 3, false); } SEAM((p) + 5); } while (0)

    if (IN(0)) { p0_prologue(args, lds, tid, lane, wave, vcu, G); } SEAM(0);
    if (IN(1)) { p1_embed(args, lane, wave, vcu, G);
        { SchedGrid S{(const char*)(ws + WS_W3), (const char*)(ws + WS_HF2), (char*)(ws + WS_FILT), (size_t)256 * 256 * 2, (size_t)256 * 256 * 2, 0, 0, (size_t)256 * FILT_LD * 2, (size_t)256 * 2, 0, FILT_LD, 32, 17, 1, G, bx};
          pg8::EpiBf16<0> E{nullptr}; pg8::gemm_phase<pg8::EpiBf16<0>, SchedGrid, false, true>(lds, 256, 256, 256, S, E); }
    } SEAM(1);
    MLA_BLOCK(0, 0, 2);
    FFN_BLOCK(0, 8, 1, false);
    if (IN(11)) {
        { SchedGrid S{(const char*)(ws + WS_WIN), U, (char*)(ws + WS_PT), (size_t)256 * D * 2, (size_t)256 * D * 2, 0, 0, (size_t)256 * NTOK * 2, (size_t)256 * 2, 0, NTOK, 24, 48, 1, G, bx};
          pg8::EpiBf16<1> E{args.in[I_HBIN]}; pg8::gemm_phase<pg8::EpiBf16<1>, SchedGrid, false, true>(lds, D, D, D, S, E); }
    } SEAM(11);
    if (IN(12)) { hy_conv_phase(args, lds, tid, vcu, G); } SEAM(12);
    if (IN(13)) { transpose_zt_phase(args, lds, lane, wave, vcu, G); } SEAM(13);
    if (IN(14)) { OUTPROJ(MIXO, ws + WS_WO + (size_t)1 * SZ_WO, D); } SEAM(14);
    if (IN(15)) { ln_phase(args, lds, tid, lane, wave, vcu, G, 1, 2, 0, args.in[I_HBOUT], 1, 3, false); } SEAM(15);
    FFN_BLOCK(1, 16, 2, false);
    if (IN(19)) { SchedF1 S{(const char*)(ws + WS_DFTC), U, (char*)(ws + WS_ATC), (char*)(ws + WS_ATL), G, bx}; pg8::EpiBf16<0> E{nullptr}; pg8::gemm_phase<pg8::EpiBf16<0>, SchedF1, false, true>(lds, 256, 256, D, S, E); } SEAM(19);
    if (IN(20)) {
        { SchedGrid S{(const char*)(ws + WS_DML), (const char*)(ws + WS_ATL), (char*)(ws + WS_MIXO) + (size_t)NCTX * D * 2, (size_t)256 * 8192 * 2, (size_t)256 * 8192 * 2, 0, (size_t)2048 * 8192 * 2, (size_t)256 * D * 2, (size_t)256 * 2, (size_t)4096 * D * 2, D, 16, 8, 2, G, bx};
          pg8::EpiBf16<0> E{nullptr}; pg8::gemm_phase<pg8::EpiBf16<0>, SchedGrid, false, true>(lds, 8192, 8192, 8192, S, E); }
        { SchedGrid S{(const char*)(ws + WS_DMC), (const char*)(ws + WS_ATC), (char*)(ws + WS_MIXO), 0, (size_t)256 * 512 * 2, 0, (size_t)2048 * 512 * 2, 0, (size_t)256 * 2, (size_t)256 * D * 2, D, 1, 8, 16, G, bx};
          pg8::EpiBf16<0> E{nullptr}; pg8::gemm_phase<pg8::EpiBf16<0>, SchedGrid, false, true>(lds, 512, 512, 512, S, E); }
    } SEAM(20);
    if (IN(21)) { OUTPROJ(MIXO, ws + WS_WO + (size_t)2 * SZ_WO, D); } SEAM(21);
    if (IN(22)) { ln_phase(args, lds, tid, lane, wave, vcu, G, 2, 2, 0, args.in[I_FNB], 2, 3, false); } SEAM(22);
    FFN_BLOCK(2, 23, 3, false);
    MLA_BLOCK(1, 3, 26);
    FFN_BLOCK(3, 32, 3, true);
#undef IN
#undef SEAM
}

extern "C" void kernel_launch(void* const* d_in, const int* in_sizes, int n_in, void* d_out, int out_size, void* d_ws, size_t ws_size, hipStream_t stream) {
    static int grid = 0;
    if (grid == 0) {
        if (n_in != 38 || ws_size < WS_END) { fprintf(stderr, "kernel_launch: expected 38 inputs and >= %zu bytes of workspace; got %d, %zu\n", (size_t)WS_END, n_in, ws_size); grid = -1; return; }
        int dev = 0, cus = 0, per_cu = 0;
        if (hipGetDevice(&dev) != hipSuccess || hipDeviceGetAttribute(&cus, hipDeviceAttributeMultiprocessorCount, dev) != hipSuccess) { grid = -1; return; }
        if (hipFuncSetAttribute((const void*)trunk_fwd, hipFuncAttributeMaxDynamicSharedMemorySize, LDS_BYTES) != hipSuccess) { fprintf(stderr, "kernel_launch: hipFuncSetAttribute failed\n"); grid = -1; return; }
        if (hipOccupancyMaxActiveBlocksPerMultiprocessor(&per_cu, (const void*)trunk_fwd, NTHREADS, LDS_BYTES) != hipSuccess || per_cu < 1) { fprintf(stderr, "kernel_launch: occupancy query reports %d workgroups per CU\n", per_cu); }
        (void)hipGetLastError();
        grid = cus;
    }
    if (grid < 0) return;
    if (hipMemsetAsync((char*)d_ws + WS_CTL, 0, CTL_ZERO_BYTES, stream) != hipSuccess) return;
    Args a{};
    for (int i = 0; i < 38; ++i) a.in[i] = (const float*)d_in[i];
    a.out = (float*)d_out; a.ws = (unsigned char*)d_ws; a.li = 0; a.pad = 0;
#if MK_PER_PHASE
    for (int p = 0; p < N_PHASES; ++p) { a.ph_lo = p; a.ph_hi = p + 1; hipLaunchKernelGGL(trunk_fwd, dim3(grid), dim3(NTHREADS), LDS_BYTES, stream, a); }
#else
    a.ph_lo = 0; a.ph_hi = N_PHASES; hipLaunchKernelGGL(trunk_fwd, dim3(grid), dim3(NTHREADS), LDS_BYTES, stream, a);
#endif
    const hipError_t le = hipPeekAtLastError();
    if (le != hipSuccess) fprintf(stderr, "kernel_launch: launch failed: %s\n", hipGetErrorName(le));
}
```

```cpp
#include <hip/hip_runtime.h>
#include <cstdio>
#include <cstdint>
#define GAS __attribute__((address_space(1)))
#define LAS __attribute__((address_space(3)))
typedef unsigned short bf16_t;
typedef unsigned v4u __attribute__((ext_vector_type(4)));
typedef unsigned v2u __attribute__((ext_vector_type(2)));
typedef float f32x4 __attribute__((ext_vector_type(4)));
typedef float f32x2 __attribute__((ext_vector_type(2)));

constexpr int D = 2048, NCTX = 4096, NLAT = 8192, NTOK = 12288, DFF = 5632, NKV = 13312;
constexpr int NTHREADS = 512, NWAVES = 8;
constexpr int UP8 = 2048 + 128, WGP8 = 2048 + 128;
constexpr int QP8 = 512 + 64;
constexpr int MP = 2048 + 64;
constexpr int UP = 2048 + 64, WGP = 2048 + 64, AP = 5632 + 64;
constexpr float DN_ALPHA = 1.681792830507429f;
constexpr float LN_EPS = 1e-5f, RMS_EPS = 1e-6f;
constexpr float QSCALE = 0.07216878364870322f * 1.4426950408889634f;
constexpr int FILT_LD = 4352;

constexpr size_t al256(size_t x) { return (x + 255) & ~(size_t)255; }
constexpr size_t SZ_WGU = (size_t)11264 * WGP8,          SZ_WD = (size_t)2048 * AP * 2;
constexpr size_t SZ_W1 = (size_t)1280 * 2048 * 2, SZ_WUQ = (size_t)3072 * QP8  , SZ_WUKV = (size_t)4096 * QP8  , SZ_WO = (size_t)2048 * MP * 2;
constexpr size_t SZ_WIN = (size_t)6144 * 2048 * 2, SZ_W3 = (size_t)8192 * 256 * 2;
constexpr size_t SZ_DFTC = (size_t)512 * 256 * 2, SZ_DML = (size_t)4096 * 8192 * 2, SZ_DMC = (size_t)256 * 512 * 2;
constexpr size_t SZ_ROWS = (size_t)NTOK * D * 2;
constexpr size_t WS_CTL = 0, CTL_ZERO_BYTES = 1u << 20;
constexpr size_t WS_COLMAX = 65536;
constexpr size_t WS_MOD = WS_CTL + CTL_ZERO_BYTES;
constexpr size_t WS_ROPE = WS_MOD + al256((size_t)4 * 3 * 12288 * 4);
constexpr size_t WS_HF2 = WS_ROPE + al256((size_t)4096 * 32 * 8);
constexpr size_t WS_WGU = WS_HF2 + al256((size_t)FILT_LD * 256 * 2);
constexpr size_t WS_WD = WS_WGU + 4 * SZ_WGU;
constexpr size_t WS_W1 = WS_WD + 4 * SZ_WD;
constexpr size_t WS_WUQ = WS_W1 + 2 * SZ_W1;
constexpr size_t WS_WUKV = WS_WUQ + 2 * SZ_WUQ;
constexpr size_t WS_WO = WS_WUKV + 2 * SZ_WUKV;
constexpr size_t WS_WIN = WS_WO + 4 * SZ_WO;
constexpr size_t WS_W3 = WS_WIN + SZ_WIN;
constexpr size_t WS_DFTC = WS_W3 + SZ_W3;
constexpr size_t WS_DML = WS_DFTC + SZ_DFTC;
constexpr size_t WS_DMC = WS_DML + SZ_DML;
constexpr size_t WS_WSC = WS_DMC + al256(SZ_DMC);
constexpr size_t WS_WUQSC = WS_WSC + al256((size_t)4 * 11264 * 4);
constexpr size_t WS_WUKVSC = WS_WUQSC + al256((size_t)2 * 3072 * 4);
constexpr size_t WS_QSC = WS_WUKVSC + al256((size_t)2 * 4096 * 4);
constexpr size_t WS_KSC = WS_QSC + al256((size_t)NTOK * 4);
constexpr size_t WS_U8 = WS_KSC + al256((size_t)2 * NKV * 4);
constexpr size_t WS_USC = WS_U8 + (size_t)NTOK * UP8;
constexpr size_t WS_H = WS_USC + al256((size_t)NTOK * 4);
constexpr size_t WS_U = WS_H + SZ_ROWS;
constexpr size_t WS_PART = WS_U + (size_t)NTOK * UP * 2;
constexpr size_t WS_ACT = WS_PART + (size_t)2 * NTOK * D * 4;
constexpr size_t WS_CKVN = WS_ACT + (size_t)NTOK * AP * 2;
constexpr size_t WS_KR = WS_CKVN + 2 * (size_t)NKV * QP8;
constexpr size_t WS_MIXO = WS_KR + 2 * al256((size_t)NKV * 64 * 2);
constexpr size_t WS_FILT = WS_MIXO + (size_t)NTOK * MP * 2;
constexpr size_t WS_X = WS_FILT + (size_t)8192 * FILT_LD * 2;
constexpr size_t WS_T1 = WS_X;
constexpr size_t WS_QL = WS_T1 + (size_t)NTOK * 1280 * 4;
constexpr size_t WS_Q = WS_QL + (size_t)NTOK * QP8;
constexpr size_t WS_KV = WS_Q + (size_t)NTOK * 3072 * 2;
constexpr size_t WS_XEND_MLA = WS_KV + (size_t)NKV * 4096 * 2;
constexpr size_t WS_PT = WS_X;
constexpr size_t WS_ZT = WS_PT + (size_t)6144 * NTOK * 2;
constexpr size_t WS_XEND_HY = WS_ZT + (size_t)2048 * NTOK * 2;
constexpr size_t WS_ATC = WS_X;
constexpr size_t WS_ATL = WS_ATC + (size_t)16 * 2048 * 512 * 2;
constexpr size_t WS_PQ = WS_ATL + (size_t)2 * 2048 * 8192 * 2;
constexpr size_t WS_XEND_FN = WS_PQ + (size_t)2 * 2 * 2048 * 2048 * 2;
constexpr size_t cmax(size_t a, size_t b) { return a > b ? a : b; }
constexpr size_t WS_END = cmax(WS_XEND_MLA, cmax(WS_XEND_HY, WS_XEND_FN));
static_assert(WS_END <= (size_t)1610612736, "d_ws map exceeds 4 x largest tensor");

constexpr int RING_OFF = 0, RING_BYTES = 131072;
constexpr int LDSCTL_OFF = RING_BYTES, MISC_OFF = LDSCTL_OFF + 320;
constexpr int LDS_BYTES = 163840;
static_assert(MISC_OFF + 128 <= LDS_BYTES, "LDS map");

__device__ __forceinline__ unsigned pk2(float lo, float hi) { unsigned r; asm("v_cvt_pk_bf16_f32 %0, %1, %2" : "=v"(r) : "v"(lo), "v"(hi)); return r; }
__device__ __forceinline__ unsigned f2bf(float f) { return pk2(f, 0.f) & 0xffffu; }
__device__ __forceinline__ float bf2f(unsigned short b) { return __builtin_bit_cast(float, ((unsigned)b) << 16); }
__device__ __forceinline__ float bflo(unsigned w) { return __builtin_bit_cast(float, w << 16); }
__device__ __forceinline__ float bfhi(unsigned w) { return __builtin_bit_cast(float, w & 0xffff0000u); }
#define LDS_WAIT() asm volatile("s_waitcnt lgkmcnt(0)" ::: "memory")
#define VM_WAIT() asm volatile("s_waitcnt vmcnt(0)" ::: "memory")
__device__ __forceinline__ float wave_sum(float v) {
#pragma unroll
    for (int o = 1; o < 64; o <<= 1) v += __shfl_xor(v, o);
    return v;
}

namespace pg8 {
typedef short bf16x8 __attribute__((ext_vector_type(8)));
typedef float f32x4 __attribute__((ext_vector_type(4)));
typedef float f32x2 __attribute__((ext_vector_type(2)));
typedef unsigned u32x4 __attribute__((ext_vector_type(4)));
typedef int i32x4 __attribute__((ext_vector_type(4)));
constexpr int BM = 256, BK = 64, HALF = 128, HTB = HALF * BK * 2  , STAGE_BYTES = 8 * HTB, NXCD = 8, WGM = 8;

__host__ __device__ __forceinline__ int lds_byte(int r, int c) { const int st = (r >> 4) * 2 + (c >> 5), rr = r & 15, cc = c & 31, ob = rr * 64 + cc * 2; return st * 1024 + (ob ^ (((ob >> 9) & 1) << 5)); }
__host__ __device__ __forceinline__ void stage_rc(int b, int& R, int& C) { const int st = b / 1024, sb = b % 1024, swz = sb ^ (((sb >> 9) & 1) << 5); R = (st >> 1) * 16 + swz / 64; C = (st & 1) * 32 + (swz % 64) / 2; }
__host__ __device__ __forceinline__ int perm32(int rho) { const int n = rho >> 4, i = rho & 15; return 8 * (i >> 2) + 4 * n + (i & 3); }

struct Unit { const char* A; const char* B; char* O; int ldc; int pm, pn, aux; };

__device__ __forceinline__ void tile_of(int L, int nM, int nN, int& pm, int& pn) {
    const int nwg = nM * nN; int wgid = L; { const int q = nwg / NXCD, r = nwg % NXCD, xcd = wgid % NXCD, off = wgid / NXCD; wgid = (xcd < r ? xcd * (q + 1) : r * (q + 1) + (xcd - r) * q) + off; }
    const int nig = WGM * nN, gid = wgid / nig, fm = gid * WGM, gsz = (nM - fm) < WGM ? (nM - fm) : WGM;
    pm = fm + ((wgid % nig) % gsz); pn = (wgid % nig) / gsz;
}

__device__ __forceinline__ unsigned cvt_pk_bf16(float lo, float hi) { unsigned r; asm volatile("v_cvt_pk_bf16_f32 %0, %1, %2" : "=v"(r) : "v"(lo), "v"(hi)); return r; }

struct EpiF32 {
    static constexpr bool PERM = false;
    __device__ __forceinline__ void operator()(const f32x4 (&acc)[2][2][4][2], const Unit& u, int wr, int wc, int fr_, int fq_) const {
        int ln_ = threadIdx.x & 63; asm volatile("" : "+v"(ln_)); const int fr = ln_ & 15, fq = ln_ >> 4;
        const int row0 = wr * 64 + fr, col0 = wc * 32 + 4 * fq; float* O = (float*)u.O;
#pragma unroll
        for (int ai = 0; ai < 2; ++ai)
#pragma unroll
            for (int m = 0; m < 4; ++m) { float* rowp = O + (size_t)(row0 + ai * HALF + m * 16) * u.ldc + col0;
#pragma unroll
                for (int bj = 0; bj < 2; ++bj)
#pragma unroll
                    for (int n = 0; n < 2; ++n) *(f32x4*)(rowp + bj * HALF + n * 16) = acc[ai][bj][m][n]; }
    }
};
template <int BIAS  > struct EpiBf16 {
    static constexpr bool PERM = true;
    const float* bias;
    __device__ __forceinline__ void operator()(const f32x4 (&acc)[2][2][4][2], const Unit& u, int wr, int wc, int fr_, int fq_) const {
        int ln_ = threadIdx.x & 63; asm volatile("" : "+v"(ln_)); const int fr = ln_ & 15, fq = ln_ >> 4;
        const int row0 = wr * 64 + fr, col0 = wc * 32 + 8 * fq; bf16_t* O = (bf16_t*)u.O;
        float bv[2][4];
#pragma unroll
        for (int ai = 0; ai < 2; ++ai)
#pragma unroll
            for (int m = 0; m < 4; ++m) { bv[ai][m] = 0.f; if constexpr (BIAS == 1) bv[ai][m] = bias[u.pm * BM + row0 + ai * HALF + m * 16]; }
#pragma unroll
        for (int ai = 0; ai < 2; ++ai)
#pragma unroll
            for (int m = 0; m < 4; ++m) { const int r = row0 + ai * HALF + m * 16; bf16_t* rowp = O + (size_t)r * u.ldc + col0; const float b = bv[ai][m];
#pragma unroll
                for (int bj = 0; bj < 2; ++bj) { f32x4 v0 = acc[ai][bj][m][0], v1 = acc[ai][bj][m][1]; if constexpr (BIAS == 1) { v0 = v0 + b; v1 = v1 + b; }
                    u32x4 w; w.x = cvt_pk_bf16(v0[0], v0[1]); w.y = cvt_pk_bf16(v0[2], v0[3]); w.z = cvt_pk_bf16(v1[0], v1[1]); w.w = cvt_pk_bf16(v1[2], v1[3]);
                    *(u32x4*)(rowp + bj * HALF) = w; } }
    }
};
struct EpiSwiglu {
    static constexpr bool PERM = true;
    __device__ __forceinline__ void operator()(const f32x4 (&acc)[2][2][4][2], const Unit& u, int wr, int wc, int fr_, int fq_) const {
        int ln_ = threadIdx.x & 63; asm volatile("" : "+v"(ln_)); const int fr = ln_ & 15, fq = ln_ >> 4;
        const int row0 = wr * 64 + fr, col0 = wc * 32 + 8 * fq; bf16_t* O = (bf16_t*)u.O;
#pragma unroll
        for (int ai = 0; ai < 2; ++ai)
#pragma unroll
            for (int m = 0; m < 4; ++m) { bf16_t* rowp = O + (size_t)(row0 + ai * HALF + m * 16) * u.ldc + col0; float v[8];
#pragma unroll
                for (int n = 0; n < 2; ++n)
#pragma unroll
                    for (int j = 0; j < 4; ++j) { const float g = acc[ai][0][m][n][j], up = acc[ai][1][m][n][j]; v[n * 4 + j] = g * __builtin_amdgcn_rcpf(1.0f + __expf(-g)) * up; }
                u32x4 w; w.x = cvt_pk_bf16(v[0], v[1]); w.y = cvt_pk_bf16(v[2], v[3]); w.z = cvt_pk_bf16(v[4], v[5]); w.w = cvt_pk_bf16(v[6], v[7]);
                *(u32x4*)rowp = w; }
    }
};
struct EpiSwigluI8 {
    static constexpr bool PERM = true;
    const float* sa; const float* sb;
    __device__ __forceinline__ void operator()(const i32x4 (&acc)[2][2][4][2], const Unit& u, int wr, int wc, int fr_, int fq_) const {
        int ln_ = threadIdx.x & 63; asm volatile("" : "+v"(ln_)); const int fr = ln_ & 15, fq = ln_ >> 4;
        const int row0 = wr * 64 + fr, col0 = wc * 32 + 8 * fq; bf16_t* O = (bf16_t*)u.O;
        float sg[8], su[8];
        { const f32x4 g0 = *(const f32x4*)(sb + u.pn * BM + col0), g1 = *(const f32x4*)(sb + u.pn * BM + col0 + 4), u0 = *(const f32x4*)(sb + u.pn * BM + HALF + col0), u1 = *(const f32x4*)(sb + u.pn * BM + HALF + col0 + 4);
#pragma unroll
          for (int j = 0; j < 4; ++j) { sg[j] = g0[j]; sg[4 + j] = g1[j]; su[j] = u0[j]; su[4 + j] = u1[j]; } }
        float rav[2][4];
#pragma unroll
        for (int ai = 0; ai < 2; ++ai)
#pragma unroll
            for (int m = 0; m < 4; ++m) rav[ai][m] = sa[u.pm * BM + row0 + ai * HALF + m * 16];
#pragma unroll
        for (int ai = 0; ai < 2; ++ai)
#pragma unroll
            for (int m = 0; m < 4; ++m) { const int r = row0 + ai * HALF + m * 16; bf16_t* rowp = O + (size_t)r * u.ldc + col0; const float ra = rav[ai][m]; float v[8];
#pragma unroll
                for (int n = 0; n < 2; ++n)
#pragma unroll
                    for (int j = 0; j < 4; ++j) { const float gt = (float)acc[ai][0][m][n][j] * (ra * sg[n * 4 + j]), up = (float)acc[ai][1][m][n][j] * (ra * su[n * 4 + j]); v[n * 4 + j] = gt * __builtin_amdgcn_rcpf(1.0f + __expf(-gt)) * up; }
                u32x4 w; w.x = cvt_pk_bf16(v[0], v[1]); w.y = cvt_pk_bf16(v[2], v[3]); w.z = cvt_pk_bf16(v[4], v[5]); w.w = cvt_pk_bf16(v[6], v[7]);
                *(u32x4*)rowp = w; }
    }
};
struct EpiQKV {
    static constexpr bool PERM = true;
    const f32x2* rope; float qscale; const float* sa0; const float* sb0; const float* sa1; const float* sb1;
    __device__ __forceinline__ void operator()(const i32x4 (&acc)[2][2][4][2], const Unit& u, int wr, int wc, int fr_, int fq_) const {
        int ln_ = threadIdx.x & 63; asm volatile("" : "+v"(ln_)); const int fr = ln_ & 15, fq = ln_ >> 4;
        const int row0 = wr * 64 + fr, col0 = wc * 32 + 8 * fq; bf16_t* O = (bf16_t*)u.O;
        const bool isq = (u.aux == 0); const float sc = isq ? qscale : 1.0f; const bool lat = isq && (u.pm >= 16);
        const float* sa = isq ? sa0 : sa1; const float* sb = isq ? sb0 : sb1;
        int pr[2]; bool rp[2]; float cs_[2][8];
#pragma unroll
        for (int bj = 0; bj < 2; ++bj) { const int c8 = u.pn * BM + bj * HALF + col0, d = c8 % 192; rp[bj] = lat && d >= 128; pr[bj] = (d - 128) >> 1;
            const f32x4 c0 = *(const f32x4*)(sb + c8), c1 = *(const f32x4*)(sb + c8 + 4);
#pragma unroll
            for (int j = 0; j < 4; ++j) { cs_[bj][j] = c0[j] * sc; cs_[bj][4 + j] = c1[j] * sc; } }
        float rav[2][4];
#pragma unroll
        for (int ai = 0; ai < 2; ++ai)
#pragma unroll
            for (int m = 0; m < 4; ++m) rav[ai][m] = sa[u.pm * BM + row0 + ai * HALF + m * 16];
        const bool rpl = rp[0] || rp[1]; const int prl = rp[0] ? pr[0] : pr[1];
#pragma unroll
        for (int ai = 0; ai < 2; ++ai) {
            f32x4 rc[4][2];
            if (rpl) {
#pragma unroll
                for (int m = 0; m < 4; ++m) { const int t = (u.pm * BM + row0 + ai * HALF + m * 16) & 4095; const f32x4* cs = (const f32x4*)(rope + (size_t)t * 32 + prl); rc[m][0] = cs[0]; rc[m][1] = cs[1]; } }
            asm volatile("" ::: "memory");
#pragma unroll
            for (int m = 0; m < 4; ++m) { const int r = row0 + ai * HALF + m * 16; bf16_t* rowp = O + (size_t)r * u.ldc + col0; const float ra = rav[ai][m];
#pragma unroll
                for (int bj = 0; bj < 2; ++bj) { f32x4 v0, v1;
#pragma unroll
                    for (int j = 0; j < 4; ++j) { v0[j] = (float)acc[ai][bj][m][0][j] * (ra * cs_[bj][j]); v1[j] = (float)acc[ai][bj][m][1][j] * (ra * cs_[bj][4 + j]); }
                    if (rp[bj]) { const f32x4 c01 = rc[m][0], c23 = rc[m][1];
                        f32x4 a, b; a[0] = v0[0] * c01[0] - v0[1] * c01[1]; a[1] = v0[0] * c01[1] + v0[1] * c01[0]; a[2] = v0[2] * c01[2] - v0[3] * c01[3]; a[3] = v0[2] * c01[3] + v0[3] * c01[2];
                        b[0] = v1[0] * c23[0] - v1[1] * c23[1]; b[1] = v1[0] * c23[1] + v1[1] * c23[0]; b[2] = v1[2] * c23[2] - v1[3] * c23[3]; b[3] = v1[2] * c23[3] + v1[3] * c23[2]; v0 = a; v1 = b; }
                    u32x4 w; w.x = cvt_pk_bf16(v0[0], v0[1]); w.y = cvt_pk_bf16(v0[2], v0[3]); w.z = cvt_pk_bf16(v1[0], v1[1]); w.w = cvt_pk_bf16(v1[2], v1[3]);
                    *(u32x4*)(rowp + bj * HALF) = w; } } }
    }
};

template <bool I8> struct acc_sel { typedef f32x4 type; }; template <> struct acc_sel<true> { typedef i32x4 type; };
template <class Epi, class Sched, bool ALIGN_EPI = false, bool SP2 = false, bool I8 = false>
__device__ __forceinline__ void gemm_phase(LAS unsigned char* lds, const int K, const int lda, const int ldb, const Sched& S, const Epi& E) {
    const int tid = threadIdx.x, wid = __builtin_amdgcn_readfirstlane(tid >> 6), lane = tid & 63, wr = wid >> 2, wc = wid & 3, fr = lane & 15, fq = lane >> 4;
    const int nt = K / BK;
    unsigned voffA[2], voffB[2];
#pragma unroll
    for (int i = 0; i < 2; ++i) { int R, C; stage_rc(tid * 16 + i * 8192, R, C); const int Rb = Epi::PERM ? ((R & ~31) + perm32(R & 31)) : R;
        voffA[i] = (unsigned)(R * lda + C) * 2u; voffB[i] = (unsigned)(Rb * ldb + C) * 2u; }
    const size_t kstep = (size_t)(BK * 2);
    const size_t hstepA = (size_t)HALF * lda * 2, hstepB = (size_t)HALF * ldb * 2;
    const unsigned ldsw = (unsigned)wid * 1024u;
    const int aoff = lds_byte(wr * 64 + fr, fq * 8), boff = lds_byte(wc * 32 + fr, fq * 8);
#define PG8_SA(b, h) (((b) * 2 + (h)) * HTB)
#define PG8_SB(b, h) ((4 + (b) * 2 + (h)) * HTB)
#define PG8_STAGE(bufoff, gbase, voff) do { _Pragma("unroll") for (int _i = 0; _i < 2; ++_i) \
        __builtin_amdgcn_global_load_lds((const unsigned*)((const char*)(gbase) + (voff)[_i]), (LAS unsigned*)(lds + (bufoff) + ldsw + _i * 8192), 16, 0, 0); } while (0)
#define PG8_LDA(dst, b, h) do { _Pragma("unroll") for (int m = 0; m < 4; ++m) _Pragma("unroll") for (int k = 0; k < 2; ++k) dst[m][k] = *(const LAS bf16x8*)(lds + PG8_SA(b, h) + aoff + m * 2048 + k * 1024); } while (0)
#define PG8_LDB(dst, b, h) do { _Pragma("unroll") for (int n = 0; n < 2; ++n) _Pragma("unroll") for (int k = 0; k < 2; ++k) dst[n][k] = *(const LAS bf16x8*)(lds + PG8_SB(b, h) + boff + n * 2048 + k * 1024); } while (0)
#define PG8_MMA(ai, bj, At, Bt) do { __builtin_amdgcn_s_setprio(1); _Pragma("unroll") for (int m = 0; m < 4; ++m) _Pragma("unroll") for (int n = 0; n < 2; ++n) _Pragma("unroll") for (int k = 0; k < 2; ++k) { \
        if constexpr (I8) acc[ai][bj][m][n] = __builtin_bit_cast(acc_t, __builtin_amdgcn_mfma_i32_16x16x64_i8(__builtin_bit_cast(i32x4, Bt[n][k]), __builtin_bit_cast(i32x4, At[m][k]), __builtin_bit_cast(i32x4, acc[ai][bj][m][n]), 0, 0, 0)); \
        else acc[ai][bj][m][n] = __builtin_bit_cast(acc_t, __builtin_amdgcn_mfma_f32_16x16x32_bf16(Bt[n][k], At[m][k], __builtin_bit_cast(f32x4, acc[ai][bj][m][n]), 0, 0, 0)); } __builtin_amdgcn_s_setprio(0); } while (0)
#define PG8_WAIT_V(n) asm volatile("s_waitcnt vmcnt(" #n ")" ::: "memory")
#define PG8_WAIT_L(n) asm volatile("s_waitcnt lgkmcnt(" #n ")" ::: "memory")
#define PG8_BAR __builtin_amdgcn_s_barrier()
#define PG8_SCHED __builtin_amdgcn_sched_barrier(0)
    Unit cur, nxt; int ui = 0;
    if (!S.next(0, cur)) return;
    typedef typename acc_sel<I8>::type acc_t; acc_t acc[2][2][4][2];
#pragma unroll
    for (int a = 0; a < 2; ++a)
#pragma unroll
        for (int b = 0; b < 2; ++b)
#pragma unroll
            for (int m = 0; m < 4; ++m)
#pragma unroll
                for (int n = 0; n < 2; ++n) acc[a][b][m][n] = acc_t{};
    bf16x8 At[4][2], B0[2][2], B1[2][2];
    const char* cA = cur.A; const char* cB = cur.B;
    if constexpr (SP2) {
        PG8_STAGE(PG8_SB(0, 0), cB, voffB); PG8_STAGE(PG8_SB(0, 1), cB + hstepB, voffB); PG8_STAGE(PG8_SA(0, 0), cA, voffA); PG8_STAGE(PG8_SA(0, 1), cA + hstepA, voffA);
        if (wr == 1) PG8_BAR;
        PG8_WAIT_V(2); PG8_BAR;
        PG8_STAGE(PG8_SB(1, 0), cB + kstep, voffB); PG8_STAGE(PG8_SA(1, 0), cA + kstep, voffA); PG8_STAGE(PG8_SB(1, 1), cB + hstepB + kstep, voffB);
        PG8_WAIT_V(6); PG8_BAR;
    } else {
        PG8_STAGE(PG8_SB(0, 0), cB, voffB); PG8_STAGE(PG8_SA(0, 0), cA, voffA); PG8_STAGE(PG8_SB(0, 1), cB + hstepB, voffB); PG8_STAGE(PG8_SA(0, 1), cA + hstepA, voffA);
        if (wr == 1) PG8_BAR;
        PG8_WAIT_V(4); PG8_BAR;
        PG8_STAGE(PG8_SB(1, 0), cB + kstep, voffB); PG8_STAGE(PG8_SA(1, 0), cA + kstep, voffA); PG8_STAGE(PG8_SB(1, 1), cB + hstepB + kstep, voffB);
        PG8_WAIT_V(6); PG8_BAR;
    }
    for (;;) {
        const bool has_next = S.next(ui + 1, nxt);
        const char* nA = has_next ? nxt.A : cA; const char* nB = has_next ? nxt.B : cB;
        for (int t = 0; t < nt; t += 2) {
            const bool last = (t == nt - 2);
            const char* a1 = cA + (size_t)(t + 1) * kstep;
            const char* a2 = last ? nA : cA + (size_t)(t + 2) * kstep; const char* b2 = last ? nB : cB + (size_t)(t + 2) * kstep;
            const char* a3 = a2 + kstep; const char* b3 = b2 + kstep;
            if constexpr (SP2) {
            PG8_LDB(B0, 0, 0); PG8_LDB(B1, 0, 1); PG8_SCHED; PG8_LDA(At, 0, 0); PG8_STAGE(PG8_SA(1, 1), a1 + hstepA, voffA);
            PG8_WAIT_V(8); PG8_WAIT_L(0); PG8_BAR; PG8_MMA(0, 0, At, B0); PG8_MMA(0, 1, At, B1); PG8_BAR; PG8_SCHED;
            PG8_LDA(At, 0, 1); PG8_STAGE(PG8_SB(0, 0), b2, voffB); PG8_STAGE(PG8_SB(0, 1), b2 + hstepB, voffB); PG8_STAGE(PG8_SA(0, 0), a2, voffA);
            PG8_WAIT_V(8); PG8_WAIT_L(0); PG8_BAR; PG8_MMA(1, 0, At, B0); PG8_MMA(1, 1, At, B1); PG8_BAR; PG8_SCHED;
            PG8_LDB(B0, 1, 0); PG8_LDB(B1, 1, 1); PG8_SCHED; PG8_LDA(At, 1, 0); PG8_STAGE(PG8_SA(0, 1), a2 + hstepA, voffA);
            PG8_WAIT_V(8); PG8_WAIT_L(0); PG8_BAR; PG8_MMA(0, 0, At, B0); PG8_MMA(0, 1, At, B1); PG8_BAR; PG8_SCHED;
            PG8_LDA(At, 1, 1); PG8_STAGE(PG8_SB(1, 0), b3, voffB); PG8_STAGE(PG8_SB(1, 1), b3 + hstepB, voffB); PG8_STAGE(PG8_SA(1, 0), a3, voffA);
            PG8_WAIT_V(8); PG8_WAIT_L(0); PG8_BAR; PG8_MMA(1, 0, At, B0); PG8_MMA(1, 1, At, B1); PG8_BAR; PG8_SCHED;
            } else {
            PG8_LDB(B0, 0, 0); PG8_SCHED; PG8_LDA(At, 0, 0); PG8_STAGE(PG8_SA(1, 1), a1 + hstepA, voffA);
            PG8_WAIT_L(8); PG8_BAR; PG8_WAIT_L(0); PG8_MMA(0, 0, At, B0); PG8_BAR; PG8_SCHED;
            PG8_LDB(B1, 0, 1); PG8_STAGE(PG8_SB(0, 0), b2, voffB);
            PG8_BAR; PG8_WAIT_L(0); PG8_MMA(0, 1, At, B1); PG8_BAR;
            PG8_LDA(At, 0, 1); PG8_STAGE(PG8_SA(0, 0), a2, voffA);
            PG8_BAR; PG8_WAIT_L(0); PG8_MMA(1, 0, At, B0); PG8_BAR; PG8_SCHED;
            PG8_STAGE(PG8_SB(0, 1), b2 + hstepB, voffB);
            PG8_WAIT_V(6); PG8_BAR; PG8_MMA(1, 1, At, B1); PG8_BAR;
            PG8_LDB(B0, 1, 0); PG8_SCHED; PG8_LDA(At, 1, 0); PG8_STAGE(PG8_SA(0, 1), a2 + hstepA, voffA);
            PG8_WAIT_L(8); PG8_BAR; PG8_WAIT_L(0); PG8_MMA(0, 0, At, B0); PG8_BAR; PG8_SCHED;
            PG8_LDB(B1, 1, 1); PG8_STAGE(PG8_SB(1, 0), b3, voffB);
            PG8_BAR; PG8_WAIT_L(0); PG8_MMA(0, 1, At, B1); PG8_BAR;
            PG8_LDA(At, 1, 1); PG8_STAGE(PG8_SA(1, 0), a3, voffA);
            PG8_BAR; PG8_WAIT_L(0); PG8_MMA(1, 0, At, B0); PG8_BAR; PG8_SCHED;
            PG8_STAGE(PG8_SB(1, 1), b3 + hstepB, voffB);
            PG8_WAIT_V(6); PG8_BAR; PG8_MMA(1, 1, At, B1); PG8_BAR;
            }
        }
        if constexpr (ALIGN_EPI) { if (wr == 0) PG8_BAR; }
        E(acc, cur, wr, wc, fr, fq);
        if (!has_next) break;
#pragma unroll
        for (int a = 0; a < 2; ++a)
#pragma unroll
            for (int b = 0; b < 2; ++b)
#pragma unroll
                for (int m = 0; m < 4; ++m)
#pragma unroll
                    for (int n = 0; n < 2; ++n) acc[a][b][m][n] = acc_t{};
        cur = nxt; cA = nA; cB = nB; ++ui;
        if constexpr (ALIGN_EPI) { if (wr == 1) PG8_BAR; }
    }
    PG8_WAIT_V(0);
    if constexpr (!ALIGN_EPI) { if (wr == 0) PG8_BAR; }
    PG8_BAR;
#undef PG8_SA
#undef PG8_SB
#undef PG8_STAGE
#undef PG8_LDA
#undef PG8_LDB
#undef PG8_MMA
#undef PG8_WAIT_V
#undef PG8_WAIT_L
#undef PG8_BAR
#undef PG8_SCHED
}
}

#define XB_TMO      128
#define XB_XCNT(j)  (256  + 64 * (j))
#define XB_XSUB(j)  (1280 + 64 * (j))
#define XB_XGEN(j)  (2304 + 64 * (j))
#define XB_TOP      3328
#define XB_TOPGEN   3392
#define XCD_BAR_WORDS 3456
#define XB_SPIN_CAP (1u << 24)

__device__ __forceinline__ unsigned xb_ld(unsigned* p)              { return __hip_atomic_load(p, __ATOMIC_RELAXED, __HIP_MEMORY_SCOPE_AGENT); }
__device__ __forceinline__ unsigned xb_add(unsigned* p, unsigned v) { return __hip_atomic_fetch_add(p, v, __ATOMIC_RELAXED, __HIP_MEMORY_SCOPE_AGENT); }
__device__ __forceinline__ unsigned xb_xcc_id() { return (unsigned)__builtin_amdgcn_s_getreg((3 << 11) | 20) & 0xFu; }
#define XB_SPIN(cond, bar) do { unsigned _sp = 0; while (cond) { __builtin_amdgcn_s_sleep(1); \
    if ((++_sp & 255u) == 0u) { if (xb_ld(&(bar)[XB_TMO])) break; if (_sp > XB_SPIN_CAP) { atomicAdd(&(bar)[XB_TMO], 1u); break; } } } } while (0)

struct XcdBarrier {
    unsigned* bar; unsigned x;
    volatile LAS unsigned* st;
};
__device__ __forceinline__ XcdBarrier xcd_barrier_post(unsigned* bar, volatile LAS unsigned* st) {
    XcdBarrier b; b.bar = bar; b.x = xb_xcc_id(); b.st = st;
    if (threadIdx.x == 0) (void)xb_add(&bar[XB_XCNT(b.x)], 1u);
    return b;
}
__device__ __forceinline__ void xcd_barrier_complete(unsigned* bar, unsigned x, unsigned& nloc, unsigned& nx) {
    const unsigned G = gridDim.x * gridDim.y * gridDim.z;
    unsigned sum, cnt, mine, sp = 0u;
    for (;;) {
        sum = 0u; cnt = 0u; mine = 0u;
#pragma unroll
        for (unsigned j = 0; j < 16; ++j) { const unsigned c = xb_ld(&bar[XB_XCNT(j)]); sum += c; cnt += (c > 0u) ? 1u : 0u; mine = (j == x) ? c : mine; }
        if (sum == G) break;
        __builtin_amdgcn_s_sleep(1);
        if ((++sp & 255u) == 0u) { if (xb_ld(&bar[XB_TMO])) break; if (sp > XB_SPIN_CAP) { atomicAdd(&bar[XB_TMO], 1u); break; } }
    }
    nloc = mine > 0u ? mine : 1u; nx = cnt > 0u ? cnt : 1u;
}
__device__ __forceinline__ void xcd_barrier(const XcdBarrier& b) {
    asm volatile("s_waitcnt vmcnt(0)" ::: "memory");
    __syncthreads();
    if (threadIdx.x == 0) {
        unsigned* bar = b.bar;
        __builtin_amdgcn_s_waitcnt(0);
        unsigned nloc = b.st[0], nx = b.st[1];
        if (nloc == 0u) { xcd_barrier_complete(bar, b.x, nloc, nx); b.st[0] = nloc; b.st[1] = nx; }
        const unsigned old = xb_add(&bar[XB_XSUB(b.x)], 1u);
        const unsigned gen = old / nloc;
        if (old + 1u == (gen + 1u) * nloc) {
            __builtin_amdgcn_fence(__ATOMIC_RELEASE, "agent");
            asm volatile("s_waitcnt vmcnt(0)" ::: "memory");
            const unsigned og = xb_add(&bar[XB_TOP], 1u);
            const unsigned tg = og / nx;
            if (og + 1u == (tg + 1u) * nx) xb_add(&bar[XB_TOPGEN], 1u);
            else XB_SPIN(xb_ld(&bar[XB_TOPGEN]) == tg, bar);
            __builtin_amdgcn_fence(__ATOMIC_ACQUIRE, "agent");
            xb_add(&bar[XB_XGEN(b.x)], 1u);
            asm volatile("s_waitcnt vmcnt(0)" ::: "memory");
        } else {
            XB_SPIN(xb_ld(&bar[XB_XGEN(b.x)]) == gen, bar);
            __builtin_amdgcn_fence(__ATOMIC_ACQUIRE, "agent");
            asm volatile("s_waitcnt vmcnt(0)" ::: "memory");
        }
    }
    __syncthreads();
}

struct XDesc { int in_idx; long long src_off; int K, N; long long dst; int ldt; int mode; int row_off; };
constexpr int NXD = 28;
__constant__ XDesc c_xd[NXD] = {
    {10, 0LL * 2048 * 5632, 2048, 5632, (long long)(WS_WGU + 0 * SZ_WGU), WGP, 1, 0}, {11, 0LL * 2048 * 5632, 2048, 5632, (long long)(WS_WGU + 0 * SZ_WGU), WGP, 2, 0}, {12, 0LL * 5632 * 2048, 5632, 2048, (long long)(WS_WD + 0 * SZ_WD), AP, 0, 0},
    {10, 1LL * 2048 * 5632, 2048, 5632, (long long)(WS_WGU + 1 * SZ_WGU), WGP, 1, 0}, {11, 1LL * 2048 * 5632, 2048, 5632, (long long)(WS_WGU + 1 * SZ_WGU), WGP, 2, 0}, {12, 1LL * 5632 * 2048, 5632, 2048, (long long)(WS_WD + 1 * SZ_WD), AP, 0, 0},
    {10, 2LL * 2048 * 5632, 2048, 5632, (long long)(WS_WGU + 2 * SZ_WGU), WGP, 1, 0}, {11, 2LL * 2048 * 5632, 2048, 5632, (long long)(WS_WGU + 2 * SZ_WGU), WGP, 2, 0}, {12, 2LL * 5632 * 2048, 5632, 2048, (long long)(WS_WD + 2 * SZ_WD), AP, 0, 0},
    {10, 3LL * 2048 * 5632, 2048, 5632, (long long)(WS_WGU + 3 * SZ_WGU), WGP, 1, 0}, {11, 3LL * 2048 * 5632, 2048, 5632, (long long)(WS_WGU + 3 * SZ_WGU), WGP, 2, 0}, {12, 3LL * 5632 * 2048, 5632, 2048, (long long)(WS_WD + 3 * SZ_WD), AP, 0, 0},
    {13, 0LL * 2048 * 512, 2048, 512, (long long)(WS_W1 + 0 * SZ_W1), 2048, 0, 0}, {16, 0LL * 2048 * 512, 2048, 512, (long long)(WS_W1 + 0 * SZ_W1), 2048, 0, 512}, {18, 0LL * 2048 * 64, 2048, 64, (long long)(WS_W1 + 0 * SZ_W1), 2048, 0, 1024},
    {15, 0LL * 512 * 3072, 512, 3072, (long long)(WS_WUQ + 0 * SZ_WUQ), 512, 0, 0}, {19, 0LL * 512 * 4096, 512, 4096, (long long)(WS_WUKV + 0 * SZ_WUKV), 512, 0, 0}, {20, 0LL * 2048 * 2048, 2048, 2048, (long long)(WS_WO + 0 * SZ_WO), MP, 0, 0},
    {13, 1LL * 2048 * 512, 2048, 512, (long long)(WS_W1 + 1 * SZ_W1), 2048, 0, 0}, {16, 1LL * 2048 * 512, 2048, 512, (long long)(WS_W1 + 1 * SZ_W1), 2048, 0, 512}, {18, 1LL * 2048 * 64, 2048, 64, (long long)(WS_W1 + 1 * SZ_W1), 2048, 0, 1024},
    {15, 1LL * 512 * 3072, 512, 3072, (long long)(WS_WUQ + 1 * SZ_WUQ), 512, 0, 0}, {19, 1LL * 512 * 4096, 512, 4096, (long long)(WS_WUKV + 1 * SZ_WUKV), 512, 0, 0}, {20, 1LL * 2048 * 2048, 2048, 2048, (long long)(WS_WO + 3 * SZ_WO), MP, 0, 0},
    {21, 0, 2048, 6144, (long long)WS_WIN, 2048, 0, 0}, {34, 0, 2048, 2048, (long long)(WS_WO + 1 * SZ_WO), MP, 0, 0}, {31, 0, 64, 8192, (long long)WS_W3, 256, 0, 0},
    {36, 0, 2048, 2048, (long long)(WS_WO + 2 * SZ_WO), MP, 0, 0},
};
__device__ __forceinline__ void transpose_item(const float* W, int ldw, bf16_t* WT, int ldt, int k0, int n0, int drow0, LAS float* scr, int lane) {
    const int lr = lane >> 3, n4 = (lane & 7) * 4; f32x4 v[8];
#pragma unroll
    for (int i = 0; i < 8; ++i) v[i] = *(const f32x4*)(W + (size_t)(k0 + 8 * i + lr) * ldw + n0 + n4);
#pragma unroll
    for (int i = 0; i < 8; ++i) { LAS float* d = scr + (8 * i + lr) * 33 + n4; d[0] = v[i][0]; d[1] = v[i][1]; d[2] = v[i][2]; d[3] = v[i][3]; }
    LDS_WAIT(); asm volatile("" ::: "memory");
    const int c = lane & 7;
#pragma unroll
    for (int j = 0; j < 4; ++j) { const int n = (lane >> 3) + 8 * j; const LAS float* s = scr + (8 * c) * 33 + n;
        v4u o; o.x = pk2(s[0 * 33], s[1 * 33]); o.y = pk2(s[2 * 33], s[3 * 33]); o.z = pk2(s[4 * 33], s[5 * 33]); o.w = pk2(s[6 * 33], s[7 * 33]);
        *(GAS v4u*)(WT + (size_t)(drow0 + n) * ldt + k0 + 8 * c) = o; }
    LDS_WAIT(); asm volatile("" ::: "memory");
}

__device__ __forceinline__ void wq_strip_item(const float* W, int K, int ldw, signed char* W8, int pitch, float* wscale, int n0, int drow0, LAS unsigned char* lds, int tid) {
    const int lane = tid & 63, wave = tid >> 6, lr = lane >> 3, n4 = (lane & 7) * 4, nkb = K / 64;
    LAS float* red = (LAS float*)(lds + 131072 - 1024); LAS float* scr = (LAS float*)(lds + wave * 16384);
    float m[4] = {0.f, 0.f, 0.f, 0.f};
    for (int kb = wave; kb < nkb; kb += NWAVES) { f32x4 v[8];
#pragma unroll
        for (int i = 0; i < 8; ++i) v[i] = *(const f32x4*)(W + (size_t)(64 * kb + 8 * i + lr) * ldw + n0 + n4);
#pragma unroll
        for (int i = 0; i < 8; ++i)
#pragma unroll
            for (int e = 0; e < 4; ++e) m[e] = fmaxf(m[e], fabsf(v[i][e])); }
#pragma unroll
    for (int e = 0; e < 4; ++e) { m[e] = fmaxf(m[e], __shfl_xor(m[e], 8)); m[e] = fmaxf(m[e], __shfl_xor(m[e], 16)); m[e] = fmaxf(m[e], __shfl_xor(m[e], 32)); }
    __syncthreads();
    if (lr == 0) {
#pragma unroll
        for (int e = 0; e < 4; ++e) red[wave * 32 + n4 + e] = m[e]; }
    __syncthreads();
    float inv[4];
#pragma unroll
    for (int e = 0; e < 4; ++e) { float cm = 0.f;
#pragma unroll
        for (int w = 0; w < NWAVES; ++w) cm = fmaxf(cm, red[w * 32 + n4 + e]);
        inv[e] = cm > 0.f ? 127.0f / cm : 0.f; if (wave == 0 && lr == 0) wscale[drow0 + n4 + e] = cm * (1.0f / 127.0f); }
    const int c = lane & 7;
    for (int kb = wave; kb < nkb; kb += NWAVES) { f32x4 v[8];
#pragma unroll
        for (int i = 0; i < 8; ++i) v[i] = *(const f32x4*)(W + (size_t)(64 * kb + 8 * i + lr) * ldw + n0 + n4);
#pragma unroll
        for (int i = 0; i < 8; ++i) { LAS float* d = scr + (8 * i + lr) * 33 + n4; d[0] = rintf(v[i][0] * inv[0]); d[1] = rintf(v[i][1] * inv[1]); d[2] = rintf(v[i][2] * inv[2]); d[3] = rintf(v[i][3] * inv[3]); }
        LDS_WAIT(); asm volatile("" ::: "memory");
#pragma unroll
        for (int j = 0; j < 4; ++j) { const int n = (lane >> 3) + 8 * j; const LAS float* s = scr + (8 * c) * 33 + n; unsigned w0 = 0u, w1 = 0u;
#pragma unroll
            for (int t = 0; t < 4; ++t) { w0 |= ((unsigned)(int)s[t * 33] & 0xffu) << (8 * t); w1 |= ((unsigned)(int)s[(4 + t) * 33] & 0xffu) << (8 * t); }
            v2u o; o.x = w0; o.y = w1; *(GAS v2u*)(W8 + (size_t)(drow0 + n) * pitch + 64 * kb + 8 * c) = o; }
        LDS_WAIT(); asm volatile("" ::: "memory"); }
}

struct Args { const float* in[38]; float* out; unsigned char* ws; int ph_lo, ph_hi, li, pad; };
enum { I_XP = 0, I_XS, I_C, I_CCKV, I_CKR, I_CCTX, I_ADAW, I_ADAB, I_LNG, I_LNB, I_FG, I_FU, I_FD, I_DQ, I_QN, I_UQ, I_DKV, I_KVN, I_WKR, I_UKV, I_WOM,
       I_HWIN, I_HBIN, I_HCW, I_HCB, I_HW1, I_HB1, I_HFR1, I_HW2, I_HB2, I_HFR2, I_HW3, I_HDEC, I_HSKIP, I_HWOUT, I_HBOUT, I_FNW, I_FNB };
constexpr size_t OUT_CKV = (size_t)NTOK * D, OUT_KR = OUT_CKV + (size_t)16 * 2 * 256 * 512;

__device__ __forceinline__ int group_of_row(int row) { return row < NCTX ? 0 : (row < NCTX + 4096 ? 1 : 2); }
__device__ __forceinline__ int kvrow_of_row(int row) { return row < NCTX ? row : (row < NCTX + 4096 ? row : row + 512); }

__device__ __forceinline__ void make_dml(unsigned char* ws, size_t gt, size_t NGT) {
    for (size_t i = gt; i < (size_t)2 * 2048 * 512; i += NGT) { const int w = (int)(i >> 20), k = (int)(i >> 9) & 2047, c8 = (int)(i & 511) * 8; float v[8];
#pragma unroll
          for (int j = 0; j < 8; ++j) { const int l = c8 + j, r = (k * l) & 4095; const float tr = (float)r * (1.0f / 4096.0f); v[j] = (w == 0 ? __builtin_amdgcn_cosf(tr) : __builtin_amdgcn_sinf(tr)) * (1.0f / 1024.0f); }
          v4u o; o.x = pk2(v[0], v[1]); o.y = pk2(v[2], v[3]); o.z = pk2(v[4], v[5]); o.w = pk2(v[6], v[7]); *(GAS v4u*)(ws + WS_DML + i * 16) = o; }
}
__device__ __forceinline__ void convert_weights(const Args& a, int d0, int d1, int w, int nw, LAS float* scr, int lane) {
    for (int d = d0; d < d1; ++d) {
        const XDesc x = c_xd[d]; const float* W = a.in[x.in_idx] + x.src_off; bf16_t* WT = (bf16_t*)(a.ws + x.dst); const int nnb = x.N / 32, items = (x.K / 64) * nnb;
        for (int it = w; it < items; it += nw) { const int kb = it / nnb, nb = it - kb * nnb, n0 = 32 * nb;
            const int drow0 = x.mode == 0 ? x.row_off + n0 : ((n0 >> 7) * 256 + (n0 & 127) + (x.mode == 2 ? 128 : 0));
            transpose_item(W, x.N, WT, x.ldt, 64 * kb, n0, drow0, scr, lane); }
    }
}
__device__ __forceinline__ void ffn_w8(const Args& a, int l, int w, int nwg, LAS unsigned char* lds, int tid) {
    float* wscale = (float*)(a.ws + WS_WSC) + (size_t)l * 11264; signed char* W8 = (signed char*)(a.ws + WS_WGU + (size_t)l * SZ_WGU);
    for (int it = w; it < 352; it += nwg) { const int d = 3 * l + (it >= 176), nb = it >= 176 ? it - 176 : it, n0 = 32 * nb; const XDesc x = c_xd[d];
        const int drow0 = (n0 >> 7) * 256 + (n0 & 127) + (x.mode == 2 ? 128 : 0);
        wq_strip_item(a.in[x.in_idx] + x.src_off, x.K, x.N, W8, WGP8, wscale, n0, drow0, lds, tid); }
    __syncthreads();
}
__device__ __forceinline__ v2u quant_row512(const float (&x)[8], float& scale) {
    float m = 0.f;
#pragma unroll
    for (int e = 0; e < 8; ++e) m = fmaxf(m, fabsf(x[e]));
#pragma unroll
    for (int o = 1; o < 64; o <<= 1) m = fmaxf(m, __shfl_xor(m, o));
    const float inv = m > 0.f ? 127.0f / m : 0.f; scale = m * (1.0f / 127.0f); unsigned w0 = 0u, w1 = 0u;
#pragma unroll
    for (int t = 0; t < 4; ++t) { w0 |= ((unsigned)(int)rintf(x[t] * inv) & 0xffu) << (8 * t); w1 |= ((unsigned)(int)rintf(x[4 + t] * inv) & 0xffu) << (8 * t); }
    v2u o; o.x = w0; o.y = w1; return o;
}
__device__ __forceinline__ void wq_desc(const Args& a, int d, signed char* W8, int pitch, float* wscale, int w, int nwg, LAS unsigned char* lds, int tid) {
    const XDesc x = c_xd[d];
    for (int it = w; it < x.N / 32; it += nwg) wq_strip_item(a.in[x.in_idx] + x.src_off, x.K, x.N, W8, pitch, wscale, 32 * it, x.row_off + 32 * it, lds, tid);
    __syncthreads();
}
__device__ __forceinline__ void p0_prologue(const Args& a, LAS unsigned char* lds, int tid, int lane, int wave, int vcu, int G) {
    unsigned char* ws = a.ws;
    const int gw = vcu * NWAVES + wave, NGW = G * NWAVES; const size_t gt = (size_t)vcu * NTHREADS + tid, NGT = (size_t)G * NTHREADS;
    { LAS float* scr = (LAS float*)(lds + wave * 16384);
      convert_weights(a, 2, 3, gw, NGW, scr, lane);
      convert_weights(a, 12, 15, gw, NGW, scr, lane); convert_weights(a, 17, 18, gw, NGW, scr, lane);
      convert_weights(a, 24, 27, gw, NGW, scr, lane); }
    { const v4u z = {0u, 0u, 0u, 0u};
      for (size_t i = gt; i < (size_t)2 * 192 * 256; i += NGT) { const int j = (int)(i / (192 * 256)); const size_t r = i % (192 * 256); *(GAS v4u*)(ws + WS_W1 + j * SZ_W1 + (size_t)1088 * 2048 * 2 + r * 16) = z; }
      for (size_t i = gt; i < (size_t)8192 * 24; i += NGT) { const size_t row = i / 24, ch = i % 24; *(GAS v4u*)(ws + WS_W3 + row * 512 + 128 + ch * 16) = z; } }
    { for (size_t i = gt; i < (size_t)512 * 32; i += NGT) { const int row = (int)(i >> 5), c8 = (int)(i & 31) * 8, part = row >> 8, m = row & 255; float v[8];
#pragma unroll
          for (int j = 0; j < 8; ++j) { const int r = (m * (c8 + j)) & 255; float s, c; sincospif((float)r * (1.0f / 128.0f), &s, &c); v[j] = part ? s : c; }
          v4u o; o.x = pk2(v[0], v[1]); o.y = pk2(v[2], v[3]); o.z = pk2(v[4], v[5]); o.w = pk2(v[6], v[7]); *(GAS v4u*)(ws + WS_DFTC + i * 16) = o; }
      for (size_t i = gt; i < (size_t)256 * 64; i += NGT) { const int k = (int)(i >> 6), c8 = (int)(i & 63) * 8; float v[8];
#pragma unroll
          for (int j = 0; j < 8; ++j) { const int col = c8 + j, l = col & 255, r = (k * l) & 255; float s, c; sincospif((float)r * (1.0f / 128.0f), &s, &c); v[j] = (col < 256 ? c : -s) * (1.0f / 256.0f); }
          v4u o; o.x = pk2(v[0], v[1]); o.y = pk2(v[2], v[3]); o.z = pk2(v[4], v[5]); o.w = pk2(v[6], v[7]); *(GAS v4u*)(ws + WS_DMC + i * 16) = o; }
      }
    { f32x2* rope = (f32x2*)(ws + WS_ROPE);
      for (size_t i = gt; i < (size_t)4096 * 32; i += NGT) { const int t = (int)(i >> 5), p = (int)(i & 31); const float inv = exp2f(-(float)(p & 15) * (13.287712379549449f / 16.0f));
          const float ang = (float)(p < 16 ? (t >> 6) : (t & 63)) * inv; float s, c; sincosf(ang, &s, &c); rope[i] = (f32x2){c, s}; } }
    { for (int it = gw; it < 2 * 2 * 512; it += NGW) { const int p = it & 511, lb = (it >> 9) & 1, j = it >> 10; const int kvr = 4096 + lb * 4608 + 4096 + p;
          const float* s = a.in[I_CCKV] + ((size_t)(lb * 2 + j) * 512 + p) * 512 + 8 * lane; const f32x4 x0 = *(const f32x4*)s, x1 = *(const f32x4*)(s + 4);
          const float x[8] = {x0[0], x0[1], x0[2], x0[3], x1[0], x1[1], x1[2], x1[3]}; float sc; const v2u o = quant_row512(x, sc);
          *(GAS v2u*)(ws + WS_CKVN + (size_t)j * NKV * QP8 + (size_t)kvr * QP8 + 8 * lane) = o; if (lane == 0) ((float*)(ws + WS_KSC))[(size_t)j * NKV + kvr] = sc; }
      for (size_t i = gt; i < (size_t)2 * 2 * 512 * 8; i += NGT) { const int r8 = (int)(i & 7) * 8, p = (int)(i >> 3) & 511, lb = (int)(i >> 12) & 1, j = (int)(i >> 13);
          const float* s = a.in[I_CKR] + ((size_t)(lb * 2 + j) * 512 + p) * 64 + r8; const f32x4 x0 = *(const f32x4*)s, x1 = *(const f32x4*)(s + 4);
          v4u o; o.x = pk2(x0[0], x0[1]); o.y = pk2(x0[2], x0[3]); o.z = pk2(x1[0], x1[1]); o.w = pk2(x1[2], x1[3]);
          *(GAS v4u*)(ws + WS_KR + (size_t)j * al256((size_t)NKV * 64 * 2) + ((size_t)(4096 + lb * 4608 + 4096 + p) * 64 + r8) * 2) = o; } }
    { const float* w1 = a.in[I_HW1]; const float* w2 = a.in[I_HW2]; bf16_t* hf2 = (bf16_t*)(ws + WS_HF2);
      const float b1 = a.in[I_HB1][lane], fr1 = a.in[I_HFR1][lane], b2 = a.in[I_HB2][lane], fr2 = a.in[I_HFR2][lane];
      for (int pos = gw; pos < FILT_LD; pos += NGW) { const int L = pos < 4096 ? 4096 : 256, t = pos < 4096 ? pos : pos - 4096;
          float feat = 0.f;
          if (lane == 0) feat = (float)t / (float)(L - 1);
          else if (lane <= 32) { const int b = (lane - 1) & 15; const float band = 1e-4f + (float)b * ((15.0f - 1e-4f) / 15.0f); const float turns = (float)t * band / (float)L; float s, c; sincospif(2.0f * turns, &s, &c); feat = lane <= 16 ? c : -s; }
          float z = b1;
#pragma unroll
          for (int k = 0; k < 33; ++k) z += __shfl(feat, k) * w1[k * 64 + lane];
          const float h1 = sinf(fr1 * z); float z2 = b2;
#pragma unroll 8
          for (int k = 0; k < 64; ++k) z2 += __shfl(h1, k) * w2[k * 64 + lane];
          const float h2 = sinf(fr2 * z2);
          bf16_t* row = hf2 + (size_t)pos * 256; row[lane] = (bf16_t)f2bf(h2); row[64 + lane] = 0; row[128 + lane] = 0; row[192 + lane] = 0; } }
    __syncthreads();
    ffn_w8(a, 0, vcu, G, lds, tid);
    wq_desc(a, 15, (signed char*)(ws + WS_WUQ), QP8, (float*)(ws + WS_WUQSC), vcu, G, lds, tid); wq_desc(a, 16, (signed char*)(ws + WS_WUKV), QP8, (float*)(ws + WS_WUKVSC), vcu, G, lds, tid);
    __syncthreads();
    { LAS float* S = (LAS float*)lds; LAS float* red = (LAS float*)(lds + 24576); float* mod = (float*)(ws + WS_MOD);
      for (int i = tid; i < 3 * 2048; i += NTHREADS) { const int g = i >> 11, k = i & 2047; const float x = g == 0 ? a.in[I_CCTX][k] : a.in[I_C][(g - 1) * 2048 + k]; S[i] = x / (1.0f + __expf(-x)); }
      __syncthreads();
      const int q = tid & 15, kc = tid >> 4;
      for (int it = vcu; it < 768; it += G) { const int l = it / 192, n0 = (it % 192) * 64;
          const float* Wp = a.in[I_ADAW] + (size_t)l * 2048 * 12288 + (size_t)(kc * 64) * 12288 + n0 + 4 * q;
          f32x4 a0 = {0.f, 0.f, 0.f, 0.f}, a1 = a0, a2 = a0;
#pragma unroll 8
          for (int kk = 0; kk < 64; ++kk) { const f32x4 w = *(const f32x4*)(Wp + (size_t)kk * 12288); const int k = kc * 64 + kk; a0 += w * S[k]; a1 += w * S[2048 + k]; a2 += w * S[4096 + k]; }
#pragma unroll
          for (int j = 0; j < 4; ++j) { red[(kc * 3 + 0) * 64 + 4 * q + j] = a0[j]; red[(kc * 3 + 1) * 64 + 4 * q + j] = a1[j]; red[(kc * 3 + 2) * 64 + 4 * q + j] = a2[j]; }
          __syncthreads();
          if (tid < 192) { const int g = tid >> 6, col = tid & 63; float s = a.in[I_ADAB][l * 12288 + n0 + col];
#pragma unroll 8
              for (int k2 = 0; k2 < 32; ++k2) s += red[(k2 * 3 + g) * 64 + col];
              mod[(size_t)(l * 3 + g) * 12288 + n0 + col] = s; }
          __syncthreads(); } }
}

__device__ __forceinline__ void p1_embed(const Args& a, int lane, int wave, int vcu, int G) {
    unsigned char* ws = a.ws; const float* mod = (const float*)(ws + WS_MOD); bf16_t* H = (bf16_t*)(ws + WS_H); bf16_t* U = (bf16_t*)(ws + WS_U);
    for (int row = vcu * NWAVES + wave; row < NTOK; row += G * NWAVES) {
        const float* x = row < NCTX ? a.in[I_XP] + (size_t)row * D : a.in[I_XS] + (size_t)(row - NCTX) * D; const int g = group_of_row(row);
        const float* sh = mod + (size_t)(0 * 3 + g) * 12288 + 0 * 2048; const float* sc = sh + 2048;
#pragma unroll
        for (int j = 0; j < 4; ++j) { const int c = 512 * j + 8 * lane; float v[8], u[8];
#pragma unroll
            for (int h = 0; h < 2; ++h) { const f32x4 xv = *(const f32x4*)(x + c + 4 * h), s1 = *(const f32x4*)(sc + c + 4 * h), s0 = *(const f32x4*)(sh + c + 4 * h);
#pragma unroll
                for (int e = 0; e < 4; ++e) { v[4 * h + e] = xv[e]; u[4 * h + e] = xv[e] * (1.0f + s1[e]) + s0[e]; } }
            v4u o; o.x = pk2(v[0], v[1]); o.y = pk2(v[2], v[3]); o.z = pk2(v[4], v[5]); o.w = pk2(v[6], v[7]); *(GAS v4u*)(H + (size_t)row * D + c) = o;
            o.x = pk2(u[0], u[1]); o.y = pk2(u[2], u[3]); o.z = pk2(u[4], u[5]); o.w = pk2(u[6], u[7]); *(GAS v4u*)(U + (size_t)row * UP + c) = o; }
    }
}

__device__ __forceinline__ void ln_phase(const Args& a, LAS unsigned char* lds, int tid, int lane, int wave, int vcu, int G, int l, int gi, int lni, const float* bias, int ln, int si, bool final) {
    unsigned char* ws = a.ws; const float* mod = (const float*)(ws + WS_MOD); bf16_t* H = (bf16_t*)(ws + WS_H); bf16_t* U = (bf16_t*)(ws + WS_U);
    const bf16_t* P0 = (const bf16_t*)(ws + WS_PART); const bf16_t* P1 = P0 + (size_t)NTOK * D;
    LAS float* V = (LAS float*)lds;
    LAS unsigned char* rb = lds + (wave < 6 ? 49152 + wave * 12288 : LDSCTL_OFF + 2048 + (wave - 6) * 12288);
#define LN_DMA_ROW(r_) do { const size_t ro_ = (size_t)(r_) * D + 8 * lane; _Pragma("unroll") for (int j_ = 0; j_ < 4; ++j_) { \
        __builtin_amdgcn_global_load_lds((const unsigned*)(H + ro_ + 512 * j_), (LAS unsigned*)(rb + j_ * 1024), 16, 0, 0); \
        __builtin_amdgcn_global_load_lds((const unsigned*)(P0 + ro_ + 512 * j_), (LAS unsigned*)(rb + 4096 + j_ * 1024), 16, 0, 0); \
        __builtin_amdgcn_global_load_lds((const unsigned*)(P1 + ro_ + 512 * j_), (LAS unsigned*)(rb + 8192 + j_ * 1024), 16, 0, 0); } } while (0)
    for (int blk = vcu; blk < NTOK / 48; blk += G)
    for (int seg = 0; seg < 2; ++seg) {
        const int r0b = blk * 48, g0 = group_of_row(r0b), g1 = group_of_row(r0b + 47), g = seg == 0 ? g0 : g1;
        const int split = g0 == g1 ? r0b + 48 : (g0 == 0 ? NCTX : NCTX + 4096);
        const int rs = seg == 0 ? r0b : split, re = seg == 0 ? split : r0b + 48;
        if (rs >= re) continue;
        if (rs + wave < re) LN_DMA_ROW(rs + wave);
        __syncthreads();
        { const int c = 4 * tid; const f32x4 z4 = {0.f, 0.f, 0.f, 0.f};
          const f32x4 v0 = *(const f32x4*)(mod + (size_t)(l * 3 + g) * 12288 + gi * 2048 + c), v1 = bias ? *(const f32x4*)(bias + c) : z4;
          const f32x4 v2 = *(const f32x4*)(a.in[I_LNG] + (l * 2 + lni) * 2048 + c), v3 = *(const f32x4*)(a.in[I_LNB] + (l * 2 + lni) * 2048 + c);
          const f32x4 v4 = final ? z4 : *(const f32x4*)(mod + (size_t)(ln * 3 + g) * 12288 + si * 2048 + c), v5 = final ? z4 : *(const f32x4*)(mod + (size_t)(ln * 3 + g) * 12288 + (si + 1) * 2048 + c);
          *(LAS f32x4*)(V + c) = v0; *(LAS f32x4*)(V + 2048 + c) = v1; *(LAS f32x4*)(V + 2 * 2048 + c) = v2; *(LAS f32x4*)(V + 3 * 2048 + c) = v3; *(LAS f32x4*)(V + 4 * 2048 + c) = v4; *(LAS f32x4*)(V + 5 * 2048 + c) = v5; }
        __syncthreads();
#pragma unroll 1
        for (int row = rs + wave; row < re; row += NWAVES) { float x[32]; float s = 0.f;
            v4u hv[4], pa[4], pb[4];
            if (lni == 0) asm volatile("s_waitcnt vmcnt(9)" ::: "memory"); else asm volatile("s_waitcnt vmcnt(8)" ::: "memory");
#pragma unroll
            for (int j = 0; j < 4; ++j) { hv[j] = *(const LAS v4u*)(rb + j * 1024 + lane * 16); pa[j] = *(const LAS v4u*)(rb + 4096 + j * 1024 + lane * 16); pb[j] = *(const LAS v4u*)(rb + 8192 + j * 1024 + lane * 16); }
            LDS_WAIT();
            if (row + NWAVES < re) LN_DMA_ROW(row + NWAVES);
            asm volatile("" ::: "memory");
#pragma unroll
            for (int j = 0; j < 4; ++j) { const int c = 512 * j + 8 * lane; const unsigned hw[4] = {hv[j].x, hv[j].y, hv[j].z, hv[j].w}, aw[4] = {pa[j].x, pa[j].y, pa[j].z, pa[j].w}, bw[4] = {pb[j].x, pb[j].y, pb[j].z, pb[j].w};
#pragma unroll
                for (int h = 0; h < 2; ++h) { const f32x4 gt = *(const LAS f32x4*)(V + c + 4 * h), bs = *(const LAS f32x4*)(V + 2048 + c + 4 * h);
#pragma unroll
                    for (int e = 0; e < 4; ++e) { const int wi = 2 * h + (e >> 1); const float hh = (e & 1) ? bfhi(hw[wi]) : bflo(hw[wi]), p0 = (e & 1) ? bfhi(aw[wi]) : bflo(aw[wi]), p1 = (e & 1) ? bfhi(bw[wi]) : bflo(bw[wi]);
                        const float v = DN_ALPHA * hh + gt[e] * (p0 + p1 + bs[e]); x[8 * j + 4 * h + e] = v; s += v; } }
                asm volatile("" ::: "memory"); }
            const float mean = wave_sum(s) * (1.0f / D); float q = 0.f;
#pragma unroll
            for (int i = 0; i < 32; ++i) { x[i] -= mean; q += x[i] * x[i]; }
            const float rstd = 1.0f / sqrtf(wave_sum(q) * (1.0f / D) + LN_EPS);
            if (lni == 0) {
                float um = 0.f;
#pragma unroll
                for (int j = 0; j < 4; ++j) { const int c = 512 * j + 8 * lane; float hn[8];
#pragma unroll
                    for (int h = 0; h < 2; ++h) { const f32x4 lg = *(const LAS f32x4*)(V + 2 * 2048 + c + 4 * h), lb = *(const LAS f32x4*)(V + 3 * 2048 + c + 4 * h), sh = *(const LAS f32x4*)(V + 4 * 2048 + c + 4 * h), sc = *(const LAS f32x4*)(V + 5 * 2048 + c + 4 * h);
#pragma unroll
                        for (int e = 0; e < 4; ++e) { hn[4 * h + e] = x[8 * j + 4 * h + e] * rstd * lg[e] + lb[e]; const float uu = hn[4 * h + e] * (1.0f + sc[e]) + sh[e]; x[8 * j + 4 * h + e] = uu; um = fmaxf(um, fabsf(uu)); } }
                    v4u o; o.x = pk2(hn[0], hn[1]); o.y = pk2(hn[2], hn[3]); o.z = pk2(hn[4], hn[5]); o.w = pk2(hn[6], hn[7]); *(GAS v4u*)(H + (size_t)row * D + c) = o;
                    asm volatile("" ::: "memory"); }
#pragma unroll
                for (int o = 1; o < 64; o <<= 1) um = fmaxf(um, __shfl_xor(um, o));
                const float qinv = um > 0.f ? 127.0f / um : 0.f; if (lane == 0) ((float*)(ws + WS_USC))[row] = um * (1.0f / 127.0f);
#pragma unroll
                for (int j = 0; j < 4; ++j) { unsigned w0 = 0u, w1 = 0u;
#pragma unroll
                    for (int t = 0; t < 4; ++t) { w0 |= ((unsigned)(int)rintf(x[8 * j + t] * qinv) & 0xffu) << (8 * t); w1 |= ((unsigned)(int)rintf(x[8 * j + 4 + t] * qinv) & 0xffu) << (8 * t); }
                    v2u o; o.x = w0; o.y = w1; *(GAS v2u*)(ws + WS_U8 + (size_t)row * UP8 + 512 * j + 8 * lane) = o; }
            } else
#pragma unroll
            for (int j = 0; j < 4; ++j) { const int c = 512 * j + 8 * lane; float hn[8], u[8];
#pragma unroll
                for (int h = 0; h < 2; ++h) { const f32x4 lg = *(const LAS f32x4*)(V + 2 * 2048 + c + 4 * h), lb = *(const LAS f32x4*)(V + 3 * 2048 + c + 4 * h), sh = *(const LAS f32x4*)(V + 4 * 2048 + c + 4 * h), sc = *(const LAS f32x4*)(V + 5 * 2048 + c + 4 * h);
#pragma unroll
                    for (int e = 0; e < 4; ++e) { hn[4 * h + e] = x[8 * j + 4 * h + e] * rstd * lg[e] + lb[e]; u[4 * h + e] = hn[4 * h + e] * (1.0f + sc[e]) + sh[e]; } }
                if (final) { float* o = a.out + (size_t)row * D + c; *(f32x4*)o = (f32x4){hn[0], hn[1], hn[2], hn[3]}; *(f32x4*)(o + 4) = (f32x4){hn[4], hn[5], hn[6], hn[7]}; }
                else { v4u o; o.x = pk2(hn[0], hn[1]); o.y = pk2(hn[2], hn[3]); o.z = pk2(hn[4], hn[5]); o.w = pk2(hn[6], hn[7]); *(GAS v4u*)(H + (size_t)row * D + c) = o;
                    o.x = pk2(u[0], u[1]); o.y = pk2(u[2], u[3]); o.z = pk2(u[4], u[5]); o.w = pk2(u[6], u[7]); *(GAS v4u*)(U + (size_t)row * UP + c) = o; }
                asm volatile("" ::: "memory"); }
        }
    }
    __syncthreads();
}

struct MlaRowIn { v4u a0, b0; unsigned short krw; f32x2 cs; };
__device__ __forceinline__ void mla_norm_phase(const Args& a, int lane, int wave, int vcu, int G, int j) {
    unsigned char* ws = a.ws; const bf16_t* T1 = (const bf16_t*)(ws + WS_T1); unsigned char* QL = ws + WS_QL;
    unsigned char* CK = ws + WS_CKVN + (size_t)j * NKV * QP8; float* qsc = (float*)(ws + WS_QSC); float* ksc = (float*)(ws + WS_KSC) + (size_t)j * NKV; bf16_t* KR = (bf16_t*)(ws + WS_KR + (size_t)j * al256((size_t)NKV * 64 * 2)); const f32x2* rope = (const f32x2*)(ws + WS_ROPE);
    const float* qn = a.in[I_QN] + j * 512 + 8 * lane; const float* kn = a.in[I_KVN] + j * 512 + 8 * lane;
    float qnv[8], knv[8];
#pragma unroll
    for (int e = 0; e < 8; ++e) { qnv[e] = qn[e]; knv[e] = kn[e]; }
    auto load_row = [&](int row, MlaRowIn& in) { const bf16_t* t = T1 + (size_t)row * 1280; in.a0 = *(const GAS v4u*)(t + 8 * lane); in.b0 = *(const GAS v4u*)(t + 512 + 8 * lane); in.krw = t[1024 + lane];
        in.cs = row >= NCTX ? rope[(size_t)((row - NCTX) & 4095) * 32 + (lane >> 1)] : (f32x2){1.f, 0.f}; };
    auto proc_row = [&](int row, const MlaRowIn& in) {
        const int kvr = kvrow_of_row(row);
        float q[8], k[8]; float sq = 0.f, sk = 0.f;
        { const unsigned aw[4] = {in.a0.x, in.a0.y, in.a0.z, in.a0.w}, bw[4] = {in.b0.x, in.b0.y, in.b0.z, in.b0.w};
#pragma unroll
          for (int e = 0; e < 4; ++e) { q[2 * e] = bflo(aw[e]); q[2 * e + 1] = bfhi(aw[e]); k[2 * e] = bflo(bw[e]); k[2 * e + 1] = bfhi(bw[e]); } }
#pragma unroll
        for (int e = 0; e < 8; ++e) { sq += q[e] * q[e]; sk += k[e] * k[e]; }
        const float rq = 1.0f / sqrtf(wave_sum(sq) * (1.0f / 512.0f) + RMS_EPS), rk = 1.0f / sqrtf(wave_sum(sk) * (1.0f / 512.0f) + RMS_EPS);
#pragma unroll
        for (int e = 0; e < 8; ++e) { q[e] = q[e] * rq * qnv[e]; k[e] = k[e] * rk * knv[e]; }
        { float s0, s1; const v2u oq = quant_row512(q, s0), ok = quant_row512(k, s1);
          *(GAS v2u*)(QL + (size_t)row * QP8 + 8 * lane) = oq; *(GAS v2u*)(CK + (size_t)kvr * QP8 + 8 * lane) = ok; if (lane == 0) { qsc[row] = s0; ksc[kvr] = s1; } }
        float kr = bf2f(in.krw);
        if (row < NCTX) { const int b = row >> 8, tt = row & 255; float* oc = a.out + OUT_CKV + ((size_t)(b * 2 + j) * 256 + tt) * 512 + 8 * lane;
            *(f32x4*)oc = (f32x4){k[0], k[1], k[2], k[3]}; *(f32x4*)(oc + 4) = (f32x4){k[4], k[5], k[6], k[7]};
            a.out[OUT_KR + ((size_t)(b * 2 + j) * 256 + tt) * 64 + lane] = kr; }
        else { const float other = __shfl_xor(kr, 1);
            kr = (lane & 1) ? (other * in.cs[1] + kr * in.cs[0]) : (kr * in.cs[0] - other * in.cs[1]); }
        KR[(size_t)kvr * 64 + lane] = (bf16_t)f2bf(kr); };
    const int gw = vcu * NWAVES + wave, NGW = G * NWAVES;
    for (int row = gw; row < NTOK; row += 3 * NGW) { MlaRowIn r0, r1, r2; const int rb = row + NGW, rc = row + 2 * NGW;
        load_row(row, r0); if (rb < NTOK) load_row(rb, r1); if (rc < NTOK) load_row(rc, r2);
        asm volatile("" ::: "memory");
        proc_row(row, r0); if (rb < NTOK) proc_row(rb, r1); if (rc < NTOK) proc_row(rc, r2); }
}

__device__ __forceinline__ void attn_naive_phase(const Args& a, int lane, int wave, int vcu, int G, int j) {
    unsigned char* ws = a.ws; const bf16_t* Q = (const bf16_t*)(ws + WS_Q); const bf16_t* KV = (const bf16_t*)(ws + WS_KV);
    const bf16_t* KR = (const bf16_t*)(ws + WS_KR + (size_t)j * al256((size_t)NKV * 64 * 2)); bf16_t* O = (bf16_t*)(ws + WS_MIXO);
    for (int pair = vcu * NWAVES + wave; pair < NTOK * 16; pair += G * NWAVES) {
        const int row = pair >> 4, h = pair & 15; int kv0, nk;
        if (row < NCTX) { kv0 = (row >> 8) * 256; nk = 256; } else { const int lb = (row - NCTX) >> 12; kv0 = 4096 + lb * 4608; nk = 4608; }
        const bf16_t* qp = Q + (size_t)row * 3072 + h * 192; const float q0 = bf2f(qp[lane]), q1 = bf2f(qp[64 + lane]), q2 = bf2f(qp[128 + lane]);
        float m = -1e30f, l = 0.f, o0 = 0.f, o1 = 0.f;
        for (int key = 0; key < nk; key += 4) { float s[4], v0[4], v1[4];
#pragma unroll
            for (int u = 0; u < 4; ++u) { const bf16_t* kp = KV + (size_t)(kv0 + key + u) * 4096 + h * 256;
                s[u] = q0 * bf2f(kp[lane]) + q1 * bf2f(kp[64 + lane]) + q2 * bf2f(KR[(size_t)(kv0 + key + u) * 64 + lane]); v0[u] = bf2f(kp[128 + lane]); v1[u] = bf2f(kp[192 + lane]); }
#pragma unroll
            for (int u = 0; u < 4; ++u) s[u] = wave_sum(s[u]);
#pragma unroll
            for (int u = 0; u < 4; ++u) { const float mn = fmaxf(m, s[u]), al = exp2f(m - mn), p = exp2f(s[u] - mn); l = l * al + p; o0 = o0 * al + p * v0[u]; o1 = o1 * al + p * v1[u]; m = mn; }
        }
        const float il = 1.0f / l; O[(size_t)row * MP + h * 128 + lane] = (bf16_t)f2bf(o0 * il); O[(size_t)row * MP + h * 128 + 64 + lane] = (bf16_t)f2bf(o1 * il);
    }
}

__device__ __forceinline__ void fnet_combine_phase(const Args& a, int tid, int lane, int wave, int vcu, int G) {
    unsigned char* ws = a.ws; const bf16_t* PQ = (const bf16_t*)(ws + WS_PQ); bf16_t* F = (bf16_t*)(ws + WS_MIXO); const bf16_t* ATL = (const bf16_t*)(ws + WS_ATL);
    const size_t gt = (size_t)vcu * NTHREADS + tid, NGT = (size_t)G * NTHREADS;
    for (size_t i = gt; i < (size_t)2 * 2048 * 256; i += NGT) { const int c8 = (int)(i & 255) * 8, k = (int)(i >> 8) & 2047, lb = (int)(i >> 19);
        const v4u pv = *(const GAS v4u*)(PQ + ((size_t)(0 * 2 + lb) * 2048 + k) * 2048 + c8), qv = *(const GAS v4u*)(PQ + ((size_t)(1 * 2 + lb) * 2048 + k) * 2048 + c8);
        const unsigned pw[4] = {pv.x, pv.y, pv.z, pv.w}, qw[4] = {qv.x, qv.y, qv.z, qv.w}; v4u lo, hi; unsigned lw[4], hw[4];
#pragma unroll
        for (int e = 0; e < 4; ++e) { const float p0 = bflo(pw[e]), p1 = bfhi(pw[e]), q0 = bflo(qw[e]), q1 = bfhi(qw[e]); lw[e] = pk2(p0 - q0, p1 - q1); hw[e] = pk2(p0 + q0, p1 + q1); }
        lo.x = lw[0]; lo.y = lw[1]; lo.z = lw[2]; lo.w = lw[3]; hi.x = hw[0]; hi.y = hw[1]; hi.z = hw[2]; hi.w = hw[3];
        bf16_t* base = F + (size_t)(NCTX + lb * 4096) * MP + c8;
        *(GAS v4u*)(base + (size_t)k * MP) = lo; if (k > 0) *(GAS v4u*)(base + (size_t)(4096 - k) * MP) = hi; }
    for (int it = vcu * NWAVES + wave; it < 2 * 2048; it += G * NWAVES) { const int lb = it >> 11, ch = it & 2047; const bf16_t* row = ATL + ((size_t)lb * 2048 + ch) * 8192; float s = 0.f;
#pragma unroll
        for (int j = 0; j < 8; ++j) { const v4u x = *(const GAS v4u*)(row + (j * 64 + lane) * 8); s += (bflo(x.x) - bfhi(x.x)) + (bflo(x.y) - bfhi(x.y)) + (bflo(x.z) - bfhi(x.z)) + (bflo(x.w) - bfhi(x.w)); }
        s = wave_sum(s); if (lane == 0) F[(size_t)(NCTX + lb * 4096 + 2048) * MP + ch] = (bf16_t)f2bf(s * (1.0f / 1024.0f)); }
}

__device__ __forceinline__ void transpose_zt_phase(const Args& a, LAS unsigned char* lds, int lane, int wave, int vcu, int G) {
    const bf16_t* ZT = (const bf16_t*)(a.ws + WS_ZT); bf16_t* Z = (bf16_t*)(a.ws + WS_MIXO); LAS bf16_t* scr = (LAS bf16_t*)(lds + wave * 16384);
    const int ch8 = lane & 7, r8 = lane >> 3;
    for (int tile = vcu * NWAVES + wave; tile < 32 * 192; tile += G * NWAVES) { const int c0 = (tile / 192) * 64, t0 = (tile % 192) * 64;
        v4u x[8];
#pragma unroll
        for (int i = 0; i < 8; ++i) x[i] = *(const GAS v4u*)(ZT + (size_t)(c0 + r8 + 8 * i) * NTOK + t0 + 8 * ch8);
#pragma unroll
        for (int i = 0; i < 8; ++i) { LAS unsigned* d = (LAS unsigned*)(scr + (r8 + 8 * i) * 66 + 8 * ch8); d[0] = x[i].x; d[1] = x[i].y; d[2] = x[i].z; d[3] = x[i].w; }
        LDS_WAIT(); asm volatile("" ::: "memory");
#pragma unroll
        for (int j = 0; j < 8; ++j) { const int t = r8 + 8 * j; const LAS bf16_t* s = scr + (8 * ch8) * 66 + t;
            v4u o; o.x = (unsigned)s[0] | ((unsigned)s[66] << 16); o.y = (unsigned)s[2 * 66] | ((unsigned)s[3 * 66] << 16); o.z = (unsigned)s[4 * 66] | ((unsigned)s[5 * 66] << 16); o.w = (unsigned)s[6 * 66] | ((unsigned)s[7 * 66] << 16);
            *(GAS v4u*)(Z + (size_t)(t0 + t) * MP + c0 + 8 * ch8) = o; }
        LDS_WAIT(); asm volatile("" ::: "memory"); }
}

namespace att {
using bf16x8 = __attribute__((ext_vector_type(8))) short;
using s16x4  = __attribute__((ext_vector_type(4))) short;
using f32x16 = __attribute__((ext_vector_type(16))) float;
using u32x4  = __attribute__((ext_vector_type(4))) unsigned;
constexpr int NW = 8, QBLK = 32, KVBLK = 64;
constexpr int LDQ = 3072, LDKV = 4096, LDKR = 64, LDO = MP;
constexpr int SHM_V = KVBLK * 128 * 2, SHM_KN = KVBLK * 128 * 2, SHM_KR = KVBLK * 64 * 2, SHM_QR = NW * 32 * 64 * 2;
constexpr int OFF_KN = 2 * SHM_V, OFF_KR = OFF_KN + 2 * SHM_KN, OFF_QR = OFF_KR + 2 * SHM_KR, OFF_WS = OFF_QR + SHM_QR, SHM_ATTN = OFF_WS + NW * 64 * 4;
constexpr float THR2 = 11.5f;
#define AT_KSWZ(row, colB) ((row) * 256 + ((colB) ^ (((row) & 7) << 4)))
#define AT_RSWZ(row, chunk) ((row) * 128 + ((((chunk) ^ (((row) >> 1) & 7))) << 4))
#define AT_SBAR() __builtin_amdgcn_sched_barrier(0)
__device__ __forceinline__ int crow(int r, int hi) { return (r & 3) + 8 * (r >> 2) + 4 * hi; }
__device__ __forceinline__ unsigned cvtpk(float lo, float hi) { unsigned r; asm volatile("v_cvt_pk_bf16_f32 %0, %1, %2" : "=v"(r) : "v"(lo), "v"(hi)); return r; }

__device__ __forceinline__ void partialSM(f32x16& p0, f32x16& p1, float& m_reg, float& mn, float& alpha) {
  float pmax = p0[0];
#pragma unroll
  for (int r = 1; r < 16; ++r) pmax = fmaxf(pmax, p0[r]);
#pragma unroll
  for (int r = 0; r < 16; ++r) pmax = fmaxf(pmax, p1[r]);
  { auto rr = __builtin_amdgcn_permlane32_swap(__float_as_uint(pmax), __float_as_uint(pmax), false, false);
    pmax = fmaxf(__uint_as_float(rr[0]), __uint_as_float(rr[1])); }
  if (__builtin_expect(__all(pmax - m_reg <= THR2), 1)) { mn = m_reg; alpha = 1.f; }
  else { mn = fmaxf(m_reg, pmax); alpha = __builtin_amdgcn_exp2f(m_reg - mn); m_reg = mn; }
#pragma unroll
  for (int r = 0; r < 16; ++r) p0[r] = p0[r] - mn;
#pragma unroll
  for (int r = 0; r < 16; ++r) p1[r] = p1[r] - mn;
#pragma unroll
  for (int r = 0; r < 16; ++r) p0[r] = __builtin_amdgcn_exp2f(p0[r]);
}
__device__ __forceinline__ void finishSM(f32x16& p0, f32x16& p1, float alpha, float& l_reg, bf16x8& pa0, bf16x8& pa1, bf16x8& pa2, bf16x8& pa3) {
#pragma unroll
  for (int r = 0; r < 16; ++r) p1[r] = __builtin_amdgcn_exp2f(p1[r]);
  float ps = 0;
#pragma unroll
  for (int r = 0; r < 16; ++r) ps += p0[r];
#pragma unroll
  for (int r = 0; r < 16; ++r) ps += p1[r];
  { auto rr = __builtin_amdgcn_permlane32_swap(__float_as_uint(ps), __float_as_uint(ps), false, false);
    ps = __uint_as_float(rr[0]) + __uint_as_float(rr[1]); }
  l_reg = l_reg * alpha + ps;
#define AT_PK4(P, BASE, OUT) do { unsigned a0 = cvtpk(P[BASE + 0], P[BASE + 1]), a1 = cvtpk(P[BASE + 2], P[BASE + 3]);   \
    unsigned b0 = cvtpk(P[BASE + 4], P[BASE + 5]), b1 = cvtpk(P[BASE + 6], P[BASE + 7]);                              \
    auto r0 = __builtin_amdgcn_permlane32_swap(a0, b0, false, false); auto r1 = __builtin_amdgcn_permlane32_swap(a1, b1, false, false); \
    u32x4 w = {r0[0], r1[0], r0[1], r1[1]}; OUT = *reinterpret_cast<bf16x8*>(&w); } while (0)
  AT_PK4(p0, 0, pa0); AT_PK4(p0, 8, pa1); AT_PK4(p1, 0, pa2); AT_PK4(p1, 8, pa3);
#undef AT_PK4
}
__device__ __forceinline__ void qkt(f32x16& p0, f32x16& p1, const LAS char* Kn, const LAS char* Kr, const bf16x8* qr, const LAS char* Qr, int r32, int hi) {
  asm volatile("" : "+v"(r32), "+v"(hi));
  p0 = f32x16{}; p1 = f32x16{};
#pragma unroll
  for (int d0 = 0; d0 < 8; ++d0) { const int cb = (d0 * 16 + hi * 8) * 2;
    const bf16x8 b0 = *reinterpret_cast<const LAS bf16x8*>(Kn + AT_KSWZ(r32, cb));
    const bf16x8 b1 = *reinterpret_cast<const LAS bf16x8*>(Kn + AT_KSWZ(32 + r32, cb));
    p0 = __builtin_amdgcn_mfma_f32_32x32x16_bf16(b0, qr[d0], p0, 0, 0, 0);
    p1 = __builtin_amdgcn_mfma_f32_32x32x16_bf16(b1, qr[d0], p1, 0, 0, 0); }
#pragma unroll
  for (int d0 = 0; d0 < 4; ++d0) { const int ch = 2 * d0 + hi;
    const bf16x8 b0 = *reinterpret_cast<const LAS bf16x8*>(Kr + AT_RSWZ(r32, ch));
    const bf16x8 b1 = *reinterpret_cast<const LAS bf16x8*>(Kr + AT_RSWZ(32 + r32, ch));
    const bf16x8 q = *reinterpret_cast<const LAS bf16x8*>(Qr + AT_RSWZ(r32, ch));
    p0 = __builtin_amdgcn_mfma_f32_32x32x16_bf16(b0, q, p0, 0, 0, 0);
    p1 = __builtin_amdgcn_mfma_f32_32x32x16_bf16(b1, q, p1, 0, 0, 0); }
}
__device__ __forceinline__ int v_st(int k, int c) { const int kk = (k & ~0xC) | ((k & 4) << 1) | ((k & 8) >> 1); return ((kk >> 3) * 4 + (c >> 5)) * 512 + ((kk & 7) * 32 + (c & 31)) * 2; }
__device__ __forceinline__ int v_rd_base(int lane) { return ((lane & 3) << 3) | (((lane >> 2) & 3) << 6) | (((lane >> 4) & 1) << 5) | (((lane >> 5) & 1) << 8); }
constexpr int v_rd_off(int d0, int ks, int half) { return d0 * 512 + ks * 4096 + half * 2048; }
template <int OFF> __device__ __forceinline__ s16x4 tr_read(int vb) {
  s16x4 r; asm volatile("ds_read_b64_tr_b16 %0, %1 offset:%2" : "=&v"(r) : "v"(vb), "i"(OFF) : "memory"); return r;
}
template <int D0> __device__ __forceinline__ void pv_one(f32x16& od, int vb, bf16x8 pa0, bf16x8 pa1, bf16x8 pa2, bf16x8 pa3) {
  const s16x4 l0 = tr_read<v_rd_off(D0, 0, 0)>(vb), h0 = tr_read<v_rd_off(D0, 0, 1)>(vb), l1 = tr_read<v_rd_off(D0, 1, 0)>(vb), h1 = tr_read<v_rd_off(D0, 1, 1)>(vb);
  const s16x4 l2 = tr_read<v_rd_off(D0, 2, 0)>(vb), h2 = tr_read<v_rd_off(D0, 2, 1)>(vb), l3 = tr_read<v_rd_off(D0, 3, 0)>(vb), h3 = tr_read<v_rd_off(D0, 3, 1)>(vb);
  asm volatile("s_waitcnt lgkmcnt(0)" ::: "memory"); AT_SBAR();
#define AT_PK(L, H) (bf16x8){L[0], L[1], L[2], L[3], H[0], H[1], H[2], H[3]}
  od = __builtin_amdgcn_mfma_f32_32x32x16_bf16(pa0, AT_PK(l0, h0), od, 0, 0, 0);
  od = __builtin_amdgcn_mfma_f32_32x32x16_bf16(pa1, AT_PK(l1, h1), od, 0, 0, 0);
  od = __builtin_amdgcn_mfma_f32_32x32x16_bf16(pa2, AT_PK(l2, h2), od, 0, 0, 0);
  od = __builtin_amdgcn_mfma_f32_32x32x16_bf16(pa3, AT_PK(l3, h3), od, 0, 0, 0);
#undef AT_PK
}
__device__ __forceinline__ void pv_d0(f32x16* o, int vb, bf16x8 pa0, bf16x8 pa1, bf16x8 pa2, bf16x8 pa3) {
  pv_one<0>(o[0], vb, pa0, pa1, pa2, pa3); pv_one<1>(o[1], vb, pa0, pa1, pa2, pa3); pv_one<2>(o[2], vb, pa0, pa1, pa2, pa3); pv_one<3>(o[3], vb, pa0, pa1, pa2, pa3);
}

__device__ __forceinline__ void attn_unit(const bf16_t* __restrict__ Qb, const bf16_t* __restrict__ KVh, const bf16_t* __restrict__ KRb, bf16_t* __restrict__ Ob, int seq, LAS char* lds) {
  const int tid = threadIdx.x, wid = __builtin_amdgcn_readfirstlane(tid >> 6), lane = tid & 63, r32 = lane & 31, hi = lane >> 5;
  LAS char* V_lds = lds; LAS char* Kn_lds = lds + OFF_KN; LAS char* Kr_lds = lds + OFF_KR; LAS char* Qr = lds + OFF_QR + wid * 4096;
  LAS float* ws = (LAS float*)(lds + OFF_WS) + wid * 64; LAS float* li_l = ws; LAS float* al_l = ws + 32;
  float m_reg = -1e30f, l_reg = 0; f32x16 o[4] = {}; bf16x8 qr[8];
  const bf16_t* Qw = Qb + (long)(wid * QBLK + r32) * LDQ + hi * 8;
#pragma unroll
  for (int d0 = 0; d0 < 8; ++d0) qr[d0] = *reinterpret_cast<const bf16x8*>(Qw + d0 * 16);
#pragma unroll
  for (int d0 = 0; d0 < 4; ++d0) *reinterpret_cast<LAS bf16x8*>(Qr + AT_RSWZ(r32, 2 * d0 + hi)) = *reinterpret_cast<const bf16x8*>(Qw + 128 + d0 * 16);
  const int sr = tid >> 4, sc = (tid & 15) * 8, vst0 = v_st(sr, sc), vst1 = v_st(32 + sr, sc);
  const int vb0 = (int)(uintptr_t)V_lds + v_rd_base(lane);
  const bf16_t* Vg = KVh + 128 + (long)sr * LDKV + sc;
  const int kn_row = wid * 4 + (lane >> 4), kn_ch = (lane & 15) ^ (kn_row & 7);
  const int kr_row = wid * 8 + (lane >> 3), kr_ch = (lane & 7) ^ ((kr_row >> 1) & 7);
  const bf16_t* Kg = KVh + (long)kn_row * LDKV + kn_ch * 8; const bf16_t* Rg = KRb + (long)kr_row * LDKR + kr_ch * 8;
  bf16x8 vs0, vs1;
#define AT_KDMA(b, k0) do { \
    __builtin_amdgcn_global_load_lds((const unsigned*)(Kg + (long)(k0) * LDKV), (LAS unsigned*)(Kn_lds + (b) * SHM_KN + wid * 1024), 16, 0, 0); \
    __builtin_amdgcn_global_load_lds((const unsigned*)(Kg + (long)((k0) + 32) * LDKV), (LAS unsigned*)(Kn_lds + (b) * SHM_KN + 8192 + wid * 1024), 16, 0, 0); \
    __builtin_amdgcn_global_load_lds((const unsigned*)(Rg + (long)(k0) * LDKR), (LAS unsigned*)(Kr_lds + (b) * SHM_KR + wid * 1024), 16, 0, 0); } while (0)
#define AT_VLOAD(k0) do { vs0 = *reinterpret_cast<const bf16x8*>(Vg + (long)(k0) * LDKV); vs1 = *reinterpret_cast<const bf16x8*>(Vg + (long)((k0) + 32) * LDKV); } while (0)
#define AT_SLOAD(b, k0) do { AT_KDMA(b, k0); AT_VLOAD(k0); } while (0)
#define AT_SWRITE(b) do { *(LAS bf16x8*)(V_lds + (b) * SHM_V + vst0) = vs0; *(LAS bf16x8*)(V_lds + (b) * SHM_V + vst1) = vs1; } while (0)
#define AT_SWAIT() asm volatile("s_waitcnt vmcnt(0)" ::: "memory")
#define AT_RESC(a) do { if (__any((a) < 1.f)) { if (hi == 0) al_l[r32] = (a); asm volatile("s_waitcnt lgkmcnt(0)" ::: "memory"); \
    _Pragma("unroll") for (int d = 0; d < 4; ++d) _Pragma("unroll") for (int r = 0; r < 16; ++r) o[d][r] *= al_l[crow(r, hi)]; } } while (0)
  f32x16 pA0, pA1, pB0, pB1; float mnA, mnB, alA, alB; bf16x8 pa0, pa1, pa2, pa3; const int NT = seq / KVBLK;
  AT_SLOAD(0, 0); AT_SWAIT(); AT_SWRITE(0); __syncthreads();
  qkt(pA0, pA1, Kn_lds, Kr_lds, qr, Qr, r32, hi); partialSM(pA0, pA1, m_reg, mnA, alA);
  AT_SLOAD(1, KVBLK);
  AT_SWAIT(); AT_SWRITE(1); __syncthreads();
  for (int j = 1; j + 1 < NT; j += 2) {
    AT_SBAR(); qkt(pB0, pB1, Kn_lds + SHM_KN, Kr_lds + SHM_KR, qr, Qr, r32, hi);
    finishSM(pA0, pA1, alA, l_reg, pa0, pa1, pa2, pa3); AT_SBAR();
    AT_SLOAD(0, (j + 1) * KVBLK); AT_SBAR();
    pv_d0(o, vb0, pa0, pa1, pa2, pa3); partialSM(pB0, pB1, m_reg, mnB, alB);
    AT_SWAIT(); __syncthreads(); AT_SWRITE(0);
    AT_RESC(alB); __syncthreads();
    AT_SBAR(); qkt(pA0, pA1, Kn_lds, Kr_lds, qr, Qr, r32, hi);
    finishSM(pB0, pB1, alB, l_reg, pa0, pa1, pa2, pa3); AT_SBAR();
    AT_SLOAD(1, (j + 2) * KVBLK); AT_SBAR();
    pv_d0(o, vb0 + SHM_V, pa0, pa1, pa2, pa3); partialSM(pA0, pA1, m_reg, mnA, alA);
    AT_SWAIT(); __syncthreads(); AT_SWRITE(1);
    AT_RESC(alA); __syncthreads();
  }
  AT_SBAR(); qkt(pB0, pB1, Kn_lds + SHM_KN, Kr_lds + SHM_KR, qr, Qr, r32, hi);
  finishSM(pA0, pA1, alA, l_reg, pa0, pa1, pa2, pa3); AT_SBAR();
  pv_d0(o, vb0, pa0, pa1, pa2, pa3); partialSM(pB0, pB1, m_reg, mnB, alB);
  __syncthreads(); AT_RESC(alB);
  finishSM(pB0, pB1, alB, l_reg, pa0, pa1, pa2, pa3); AT_SBAR();
  pv_d0(o, vb0 + SHM_V, pa0, pa1, pa2, pa3);
  if (hi == 0) li_l[r32] = l_reg; asm volatile("s_waitcnt lgkmcnt(0)" ::: "memory");
  float rli[16];
#pragma unroll
  for (int r = 0; r < 16; ++r) rli[r] = __builtin_amdgcn_rcpf(li_l[crow(r, hi)]);
  bf16_t* Ow = Ob + (long)(wid * QBLK) * LDO;
  const int odd = lane & 1;
#pragma unroll
  for (int r = 0; r < 16; r += 2) {
#pragma unroll
    for (int d0 = 0; d0 < 4; ++d0) { const float a = o[d0][r] * rli[r], b = o[d0][r + 1] * rli[r + 1];
      const float recv = __shfl_xor(odd ? a : b, 1);
      const unsigned w = odd ? cvtpk(recv, b) : cvtpk(a, recv); const int orow = crow(odd ? r + 1 : r, hi);
      *(unsigned*)(Ow + (long)orow * LDO + d0 * 32 + (r32 & ~1)) = w; } }
#undef AT_SLOAD
#undef AT_VLOAD
#undef AT_KDMA
#undef AT_SWRITE
#undef AT_SWAIT
#undef AT_RESC
}
}

__device__ __forceinline__ void attn_phase(const Args& a, LAS unsigned char* lds, int vcu, int G, int j) {
    unsigned char* ws = a.ws; const bf16_t* Q = (const bf16_t*)(ws + WS_Q); const bf16_t* KV = (const bf16_t*)(ws + WS_KV);
    const bf16_t* KR = (const bf16_t*)(ws + WS_KR + (size_t)j * al256((size_t)NKV * 64 * 2)); bf16_t* O = (bf16_t*)(ws + WS_MIXO);
    for (int u = vcu; u < 768; u += G) {
        int qrow0, kv0, seq, h;
        if (u < 512) { const int lb = u >> 8, qb = u & 15; h = (u >> 4) & 15; qrow0 = NCTX + lb * 4096 + qb * 256; kv0 = 4096 + lb * 4608; seq = 4608; }
        else { const int c = u - 512, b = c >> 4; h = c & 15; qrow0 = b * 256; kv0 = b * 256; seq = 256; }
        __syncthreads();
        att::attn_unit(Q + (size_t)qrow0 * 3072 + h * 192, KV + (size_t)kv0 * 4096 + h * 256, KR + (size_t)kv0 * 64, O + (size_t)qrow0 * MP + h * 128, seq, (LAS char*)lds);
    }
    __syncthreads();
}

struct SchedGrid {
    const char* A; const char* B; char* O;
    size_t a_pm, b_pn, a_s, b_s, o_pm, o_pn, o_s;
    int ldc, nM, nN, nS, G, c;
    __device__ __forceinline__ bool next(int i, pg8::Unit& u) const {
        const int L = i * G + c, per = nM * nN; if (L >= per * nS) return false;
        const int s = L / per; int pm, pn; pg8::tile_of(L - s * per, nM, nN, pm, pn);
        u.A = A + pm * a_pm + s * a_s; u.B = B + pn * b_pn + s * b_s; u.O = O + pm * o_pm + pn * o_pn + s * o_s; u.ldc = ldc; u.pm = pm; u.pn = pn; u.aux = s; return true;
    }
};
struct SchedPair {
    SchedGrid g0, g1; int G, c;
    __device__ __forceinline__ bool next(int i, pg8::Unit& u) const {
        const int L = i * G + c, n0 = g0.nM * g0.nN;
        if (L < n0) { int pm, pn; pg8::tile_of(L, g0.nM, g0.nN, pm, pn); u.A = g0.A + pm * g0.a_pm; u.B = g0.B + pn * g0.b_pn; u.O = g0.O + pm * g0.o_pm + pn * g0.o_pn; u.ldc = g0.ldc; u.pm = pm; u.pn = pn; u.aux = 0; return true; }
        const int L1 = L - n0; if (L1 >= g1.nM * g1.nN) return false;
        int pm, pn; pg8::tile_of(L1, g1.nM, g1.nN, pm, pn); u.A = g1.A + pm * g1.a_pm; u.B = g1.B + pn * g1.b_pn; u.O = g1.O + pm * g1.o_pm + pn * g1.o_pn; u.ldc = g1.ldc; u.pm = pm; u.pn = pn; u.aux = 1; return true;
    }
};
struct SchedF1 {
    const char* dftc; const char* U; char* atc; char* atl; int G, c;
    __device__ __forceinline__ bool next(int i, pg8::Unit& u) const {
        const int L = i * G + c; if (L >= 768) return false;
        const int part = L & 1, g = (L >> 1) & 7, tt = L >> 4;
        u.A = dftc + (size_t)part * 256 * 256 * 2; u.B = U + ((size_t)tt * 256 * UP + g * 256) * 2;
        if (tt < 16) { u.O = atc + ((size_t)tt * 2048 * 512 + (size_t)(g * 256) * 512 + part * 256) * 2; u.ldc = 512; }
        else { const int lb = (tt - 16) >> 4, l0 = ((tt - 16) & 15) * 256; u.O = atl + ((size_t)lb * 2048 * 8192 + (size_t)(g * 256) * 8192 + part * 4096 + l0) * 2; u.ldc = 8192; }
        u.pm = part; u.pn = tt; u.aux = g; return true;
    }
};

struct SchedF2 {
    const char* tab; const char* atl; char* pq; int G, c;
    __device__ __forceinline__ bool next(int i, pg8::Unit& u) const {
        const int L = i * G + c; if (L >= 256) return false;
        const int s = L >> 6, w = s >> 1, lb = s & 1; int pm, pn; pg8::tile_of(L & 63, 8, 8, pm, pn);
        u.A = tab + ((size_t)w * 2048 + pm * 256) * 4096 * 2; u.B = atl + (((size_t)lb * 2048 + pn * 256) * 8192 + (size_t)w * 4096) * 2;
        u.O = pq + ((((size_t)w * 2 + lb) * 2048 + pm * 256) * 2048 + pn * 256) * 2; u.ldc = 2048; u.pm = pm; u.pn = pn; u.aux = s; return true;
    }
};

#define DEVFN __device__ __forceinline__
#define C2_TYPEDEF typedef float c2 __attribute__((ext_vector_type(2)));
#define LDSP LAS
#define OPAQUE(x) asm volatile("" : "+v"(x))
#define U32X4 v4u
#define U32X2 v2u
#define LOAD16(p) (*(const v4u*)(p))
#define LOAD8(p) (*(const v2u*)(p))
#define STORE16(p, v) (*(v4u*)(p) = (v))
#define STORE8(p, v) (*(v2u*)(p) = (v))
#define BFLO(w) bflo(w)
#define BFHI(w) bfhi(w)
#define PK2(a, b) pk2(a, b)
#define BF16X8 pg8::bf16x8
#define F32X4 f32x4
#define F32X4_ZERO ((f32x4){0.f, 0.f, 0.f, 0.f})
#define F32X4_GET(a, r) ((a)[r])
#define LSTORE16(p, v) (*(LAS v4u*)(p) = (v))
#define LSTORE8(p, v) (*(LAS v2u*)(p) = (v))
#define LLOAD8(p) (*(const LAS v2u*)(p))
#define LLOAD_BF8(p) (*(const LAS pg8::bf16x8*)(p))
#define MFMA16(a, b, c) __builtin_amdgcn_mfma_f32_16x16x32_bf16(a, b, c, 0, 0, 0)
typedef float f32x16_t __attribute__((ext_vector_type(16)));
#define F32X16 f32x16_t
#define F32X16_ZERO ((f32x16_t){0.f, 0.f, 0.f, 0.f, 0.f, 0.f, 0.f, 0.f, 0.f, 0.f, 0.f, 0.f, 0.f, 0.f, 0.f, 0.f})
#define F32X16_GET(a, r) ((a)[r])
#define F32X16_SET(a, r, x) ((a)[r] = (x))
#define U32X4_ZERO ((v4u){0u, 0u, 0u, 0u})
#define LLOAD16(p) (*(const LAS v4u*)(p))
__device__ __forceinline__ pg8::bf16x8 make_bf8(const float* v) { v4u w; w.x = pk2(v[0], v[1]); w.y = pk2(v[2], v[3]); w.z = pk2(v[4], v[5]); w.w = pk2(v[6], v[7]); return __builtin_bit_cast(pg8::bf16x8, w); }
#define MAKE_BF8(v) make_bf8(v)
#define BF8_FROM_U32X4(w) __builtin_bit_cast(BF16X8, (w))
#define OPAQUE_BF8(x) asm volatile("" : "+v"(x))
#define SCHED_FENCE() __builtin_amdgcn_sched_barrier(0)
#define MFMA32(a, b, c) __builtin_amdgcn_mfma_f32_32x32x16_bf16(a, b, c, 0, 0, 0)
#define LANE_XOR1(x) __builtin_bit_cast(float, __builtin_amdgcn_mov_dpp(__builtin_bit_cast(int, (x)), 0xB1, 0xF, 0xF, true))
#define BF2F(x) bf2f(x)
#define F2BF(x) ((bf16_t)pk2((x), 0.f))
#define COS_TURNS(x) __builtin_amdgcn_cosf(x)
#define SIN_TURNS(x) __builtin_amdgcn_sinf(x)
#define EXPF(x) __expf(x)
#define RSQRTF(x) (1.0f / sqrtf(x))
#define WAVE_SUM(v) wave_sum(v)
#define BLOCK_SYNC() __syncthreads()
#define WAVE_SYNC() asm volatile("s_waitcnt lgkmcnt(0)" ::: "memory")
C2_TYPEDEF
DEVFN c2 cmul(c2 a, c2 b) { c2 r; r.x = a.x * b.x - a.y * b.y; r.y = a.x * b.y + a.y * b.x; return r; }
DEVFN c2 cmulc(c2 a, c2 b) { c2 r; r.x = a.x * b.x + a.y * b.y; r.y = a.y * b.x - a.x * b.y; return r; }
#define SWZ(i) ((i) ^ ((((i) >> 5) & 1) * 5) ^ ((((i) >> 6) & 1) * 10) ^ ((((i) >> 7) & 1) << 4))
DEVFN constexpr float cos16(int i) { return i == 0 ? 1.f : i == 1 ? 0.9238795325f : i == 2 ? 0.7071067812f : i == 3 ? 0.3826834324f : i == 4 ? 0.f : i == 5 ? -0.3826834324f : i == 6 ? -0.7071067812f : -0.9238795325f; }
DEVFN constexpr float sin16(int i) { return i == 0 ? 0.f : i == 1 ? 0.3826834324f : i == 2 ? 0.7071067812f : i == 3 ? 0.9238795325f : i == 4 ? 1.f : i == 5 ? 0.9238795325f : i == 6 ? 0.7071067812f : 0.3826834324f; }
template <int LOGN, int S, int G, bool INV, int NT>
DEVFN void fft_pass(LDSP c2* x, int total, int tid) {
    OPAQUE(tid);
    constexpr int N = 1 << LOGN, R = 1 << G, H3 = N >> (S + G);
    const int ngroups = total / R;
#pragma unroll 1
    for (int j = tid; j < ngroups; j += NT) {
        const int tr = j / (N / R), jj = j % (N / R), blk = jj / H3, pos = jj % H3;
        const int i0 = tr * N + blk * (R * H3) + pos;
        c2 v[R];
        const int b0 = SWZ(i0);
#pragma unroll
        for (int q = 0; q < R; ++q) v[q] = x[b0 ^ SWZ(q * H3)];
        c2 wg[G];
        { const float fr = (float)pos * (1.0f / (float)(R * H3)); wg[0].x = COS_TURNS(fr); wg[0].y = -SIN_TURNS(fr);
#pragma unroll
          for (int g = 1; g < G; ++g) { wg[g].x = wg[g - 1].x * wg[g - 1].x - wg[g - 1].y * wg[g - 1].y; wg[g].y = 2.0f * wg[g - 1].x * wg[g - 1].y; } }
#pragma unroll
        for (int gg = 0; gg < G; ++gg) {
            const int g = INV ? (G - 1 - gg) : gg;
            const int hq = R >> (g + 1);
#pragma unroll
            for (int q = 0; q < R; ++q) {
                if ((q & hq) == 0) {
                    const int m = q & (hq - 1), ci = m * (8 / hq);
                    c2 w = wg[g];
                    if (m != 0) { c2 cc; cc.x = cos16(ci); cc.y = -sin16(ci); w = cmul(w, cc); }
                    const c2 a = v[q], b = v[q + hq];
                    if (!INV) { c2 d; d.x = a.x - b.x; d.y = a.y - b.y; v[q].x = a.x + b.x; v[q].y = a.y + b.y; v[q + hq] = cmul(d, w); }
                    else { const c2 bw = cmulc(b, w); v[q].x = a.x + bw.x; v[q].y = a.y + bw.y; v[q + hq].x = a.x - bw.x; v[q + hq].y = a.y - bw.y; }
                }
            }
        }
#pragma unroll
        for (int q = 0; q < R; ++q) x[b0 ^ SWZ(q * H3)] = v[q];
    }
}
template <int LOGW, bool INV> DEVFN void fft_wave(LDSP c2* x, int lane) {
    constexpr int NW = 1 << LOGW;
    if constexpr (LOGW == 9) {
        if (!INV) { fft_pass<9, 0, 3, false, 64>(x, NW, lane); WAVE_SYNC(); fft_pass<9, 3, 3, false, 64>(x, NW, lane); WAVE_SYNC(); fft_pass<9, 6, 3, false, 64>(x, NW, lane); WAVE_SYNC(); }
        else { fft_pass<9, 6, 3, true, 64>(x, NW, lane); WAVE_SYNC(); fft_pass<9, 3, 3, true, 64>(x, NW, lane); WAVE_SYNC(); fft_pass<9, 0, 3, true, 64>(x, NW, lane); WAVE_SYNC(); }
    } else {
        static_assert(LOGW == 9 || LOGW == 10, "wave-local sizes");
        if (!INV) { fft_pass<10, 0, 3, false, 64>(x, NW, lane); WAVE_SYNC(); fft_pass<10, 3, 3, false, 64>(x, NW, lane); WAVE_SYNC(); fft_pass<10, 6, 2, false, 64>(x, NW, lane); WAVE_SYNC(); fft_pass<10, 8, 2, false, 64>(x, NW, lane); WAVE_SYNC(); }
        else { fft_pass<10, 8, 2, true, 64>(x, NW, lane); WAVE_SYNC(); fft_pass<10, 6, 2, true, 64>(x, NW, lane); WAVE_SYNC(); fft_pass<10, 3, 3, true, 64>(x, NW, lane); WAVE_SYNC(); fft_pass<10, 0, 3, true, 64>(x, NW, lane); WAVE_SYNC(); }
    }
}
struct HyParams {
    float dec[2][2];
    float skip[2];
    float cw[3][3];
    float cb[3];
};
template <int NV> struct ShortRaw { U32X4 v; unsigned short xl, xr; };
template <int NV>
DEVFN void hy_short_load(ShortRaw<NV>& r, const bf16_t* Pcol, unsigned o, int t0, int L) {
    if constexpr (NV == 8) r.v = LOAD16(Pcol + o); else { const U32X2 t = LOAD8(Pcol + o); r.v.x = t.x; r.v.y = t.y; r.v.z = 0u; r.v.w = 0u; }
    r.xl = Pcol[t0 > 0 ? o - 1u : o]; r.xr = Pcol[t0 + NV < L ? o + (unsigned)NV : o];
}
template <int NV>
DEVFN void hy_short_calc(const ShortRaw<NV>& r, int t0, int L, float w0, float w1, float w2, float cb, float (&out)[NV]) {
    float x[NV + 2]; const unsigned w[4] = {r.v.x, r.v.y, r.v.z, r.v.w};
#pragma unroll
    for (int e = 0; e < NV / 2; ++e) { x[1 + 2 * e] = BFLO(w[e]); x[2 + 2 * e] = BFHI(w[e]); }
    x[0] = t0 > 0 ? BF2F(r.xl) : 0.f; x[NV + 1] = t0 + NV < L ? BF2F(r.xr) : 0.f;
#pragma unroll
    for (int e = 0; e < NV; ++e) out[e] = w0 * x[e] + w1 * x[e + 1] + w2 * x[e + 2] + cb;
}
template <int LOGN, int NB, int O>
DEVFN void hy_conv_order(LDSP c2* XB, LDSP c2* KB, LDSP float* red, int c, int region_base, int fpos, const bf16_t* PT, const bf16_t* FILT, const HyParams& hp, bf16_t* ZT, int tid,
                         float (&za)[(NB << (LOGN - 1)) / NTHREADS], float (&zb)[(NB << (LOGN - 1)) / NTHREADS]) {
    constexpr int N = 1 << LOGN, L = N / 2, NV = NB * L / NTHREADS;
    static_assert((NB == 1 && LOGN == 13 && NV == 8) || (NB == 8 && LOGN == 9 && NV == 4), "supported shapes");
    const int lane = tid & 63, wv = tid >> 6;
    const bf16_t* Pv = PT + (size_t)c * NTOK; const bf16_t* Pg = PT + (size_t)((1 + O) * 2048 + c) * NTOK;
    const int v0 = NV * tid, pair = v0 / L, t0 = v0 % L, sb = region_base + (2 * pair) * L;
    const bf16_t* Ff = FILT + (size_t)(0 * 4096 + O * 2048 + c) * FILT_LD + fpos; const bf16_t* Fb = FILT + (size_t)(1 * 4096 + O * 2048 + c) * FILT_LD + fpos;
    LDSP c2* KBw = NB == 1 ? KB : KB + wv * N;
    const int ft0 = NB == 1 ? 8 * tid : 4 * lane; U32X4 rf, rb;
    if constexpr (NB == 1) { rf = LOAD16(Ff + ft0); rb = LOAD16(Fb + ft0); } else { const U32X2 a2 = LOAD8(Ff + ft0), b2 = LOAD8(Fb + ft0); rf.x = a2.x; rf.y = a2.y; rf.z = 0u; rf.w = 0u; rb.x = b2.x; rb.y = b2.y; rb.z = 0u; rb.w = 0u; }
    ShortRaw<NV> rva, rvb;
    if (O == 0) { hy_short_load<NV>(rva, Pv, (unsigned)(sb + t0), t0, L); hy_short_load<NV>(rvb, Pv, (unsigned)(sb + L + t0), t0, L); }
    float ss = 0.f; const float tsc = 1.0f / (float)(L - 1); const float d0 = hp.dec[0][O], d1 = hp.dec[1][O];
    { const unsigned wf[4] = {rf.x, rf.y, rf.z, rf.w}, wb[4] = {rb.x, rb.y, rb.z, rb.w};
#pragma unroll
      for (int e = 0; e < NV; ++e) { const int t = ft0 + e; const float tn = (float)t * tsc;
          const float f = ((e & 1) ? BFHI(wf[e >> 1]) : BFLO(wf[e >> 1])) * (EXPF(-tn * d0) + 0.05f), b = ((e & 1) ? BFHI(wb[e >> 1]) : BFLO(wb[e >> 1])) * (EXPF(-tn * d1) + 0.05f);
          ss += f * f + b * b; c2 k; k.x = f; k.y = 0.f; KBw[SWZ(t)] = k; c2 kb; kb.x = t > 0 ? b : 0.f; kb.y = 0.f; KBw[SWZ(t > 0 ? N - t : L)] = kb; } }
    ss = WAVE_SUM(ss);
    float tot;
    if constexpr (NB == 1) { BLOCK_SYNC(); if (lane == 0) red[wv] = ss; }
    if (O == 0) { hy_short_calc<NV>(rva, t0, L, hp.cw[0][0], hp.cw[0][1], hp.cw[0][2], hp.cb[0], za); hy_short_calc<NV>(rvb, t0, L, hp.cw[0][0], hp.cw[0][1], hp.cw[0][2], hp.cb[0], zb); }
#pragma unroll
    for (int e = 0; e < NV; ++e) { c2 z; z.x = za[e]; z.y = zb[e]; XB[SWZ(pair * N + t0 + e)] = z; c2 zz; zz.x = 0.f; zz.y = 0.f; XB[SWZ(pair * N + L + t0 + e)] = zz; }
    ShortRaw<NV> rga, rgb;
    hy_short_load<NV>(rga, Pg, (unsigned)(sb + t0), t0, L); hy_short_load<NV>(rgb, Pg, (unsigned)(sb + L + t0), t0, L);
    if constexpr (NB == 1) {
        BLOCK_SYNC();
        tot = 0.f;
#pragma unroll
        for (int w = 0; w < NTHREADS / 64; ++w) tot += red[w];
        const float sc = RSQRTF(tot + 1e-12f) * (1.0f / (float)N);
        fft_pass<13, 0, 3, false, NTHREADS>(KB, N, tid); fft_pass<13, 0, 3, false, NTHREADS>(XB, N, tid);
        BLOCK_SYNC();
        { LDSP c2* kw = KB + wv * 1024; LDSP c2* xw = XB + wv * 1024;
          fft_wave<10, false>(kw, lane); fft_wave<10, false>(xw, lane);
#pragma unroll 4
          for (int i = 0; i < 16; ++i) { const int p = wv * 1024 + lane + 64 * i; c2 k = KB[SWZ(p)]; k.x *= sc; k.y *= sc; const c2 xv = XB[SWZ(p)]; XB[SWZ(p)] = cmul(xv, k); }
          WAVE_SYNC();
          fft_wave<10, true>(xw, lane); }
        BLOCK_SYNC();
        fft_pass<13, 0, 3, true, NTHREADS>(XB, N, tid);
        BLOCK_SYNC();
    } else {
        WAVE_SYNC();
        const float sc = RSQRTF(ss + 1e-12f) * (1.0f / (float)N);
        LDSP c2* xw = XB + wv * N;
        fft_wave<9, false>(KBw, lane); fft_wave<9, false>(xw, lane);
#pragma unroll 4
        for (int i = 0; i < 8; ++i) { const int p = lane + 64 * i; c2 k = KBw[SWZ(p)]; k.x *= sc; k.y *= sc; const c2 xv = xw[SWZ(p)]; xw[SWZ(p)] = cmul(xv, k); }
        WAVE_SYNC();
        fft_wave<9, true>(xw, lane);
    }
    { const float sk = hp.skip[O]; float ga[NV], gb[NV];
      hy_short_calc<NV>(rga, t0, L, hp.cw[1 + O][0], hp.cw[1 + O][1], hp.cw[1 + O][2], hp.cb[1 + O], ga); hy_short_calc<NV>(rgb, t0, L, hp.cw[1 + O][0], hp.cw[1 + O][1], hp.cw[1 + O][2], hp.cb[1 + O], gb);
#pragma unroll
      for (int e = 0; e < NV; ++e) { const c2 y = XB[SWZ(pair * N + t0 + e)]; za[e] = ga[e] * (y.x + sk * za[e]); zb[e] = gb[e] * (y.y + sk * zb[e]); }
      if (O == 1) { bf16_t* Zc = ZT + (size_t)c * NTOK;
          if constexpr (NV == 8) { U32X4 wa, wb; wa.x = PK2(za[0], za[1]); wa.y = PK2(za[2], za[3]); wa.z = PK2(za[4], za[5]); wa.w = PK2(za[6], za[7]); wb.x = PK2(zb[0], zb[1]); wb.y = PK2(zb[2], zb[3]); wb.z = PK2(zb[4], zb[5]); wb.w = PK2(zb[6], zb[7]);
              STORE16(Zc + (unsigned)(sb + t0), wa); STORE16(Zc + (unsigned)(sb + L + t0), wb); }
          else { U32X2 wa, wb; wa.x = PK2(za[0], za[1]); wa.y = PK2(za[2], za[3]); wb.x = PK2(zb[0], zb[1]); wb.y = PK2(zb[2], zb[3]); STORE8(Zc + (unsigned)(sb + t0), wa); STORE8(Zc + (unsigned)(sb + L + t0), wb); } } }
    if constexpr (NB == 8) WAVE_SYNC();
}
template <int LOGN, int NB>
DEVFN void hy_conv_unit(LDSP c2* XB, LDSP c2* KB, LDSP float* red, int c, int region_base, int fpos, const bf16_t* PT, const bf16_t* FILT, const HyParams& hp, bf16_t* ZT, int tid) {
    constexpr int NV = (NB << (LOGN - 1)) / NTHREADS;
    float za[NV], zb[NV];
#pragma unroll
    for (int i = 0; i < NV; ++i) { za[i] = 0.f; zb[i] = 0.f; }
    BLOCK_SYNC();
    hy_conv_order<LOGN, NB, 0>(XB, KB, red, c, region_base, fpos, PT, FILT, hp, ZT, tid, za, zb);
    hy_conv_order<LOGN, NB, 1>(XB, KB, red, c, region_base, fpos, PT, FILT, hp, ZT, tid, za, zb);
}
constexpr int CT_PITCH = 264, CT_ZS = 16 * CT_PITCH * 2, CT_KCOPY = 528 * 2, CT_KC = 8 * CT_KCOPY;
constexpr int CT_OFF_ZS0 = 0, CT_OFF_ZS1 = CT_ZS, CT_OFF_G1 = 2 * CT_ZS, CT_OFF_G2 = 3 * CT_ZS, CT_OFF_KC = 4 * CT_ZS, CT_BYTES = 4 * CT_ZS + 2 * CT_KC;
DEVFN void hy_ctx_mfma_unit(LDSP unsigned char* lb, int c, const bf16_t* PT, const bf16_t* FILT, const HyParams& hp, bf16_t* ZT, int tid) {
    constexpr int L = 256;
    const int lane = tid & 63, wv = tid >> 6;
    BLOCK_SYNC();
    { const int b = tid >> 5, t8 = (tid & 31) * 8; const unsigned o = (unsigned)(b * L + t8);
      ShortRaw<8> r0, r1, r2; hy_short_load<8>(r0, PT + (size_t)c * NTOK, o, t8, L); hy_short_load<8>(r1, PT + (size_t)(2048 + c) * NTOK, o, t8, L); hy_short_load<8>(r2, PT + (size_t)(4096 + c) * NTOK, o, t8, L);
      float v[8]; U32X4 w;
      hy_short_calc<8>(r0, t8, L, hp.cw[0][0], hp.cw[0][1], hp.cw[0][2], hp.cb[0], v); w.x = PK2(v[0], v[1]); w.y = PK2(v[2], v[3]); w.z = PK2(v[4], v[5]); w.w = PK2(v[6], v[7]); LSTORE16(lb + CT_OFF_ZS0 + (b * CT_PITCH + t8) * 2, w);
      hy_short_calc<8>(r1, t8, L, hp.cw[1][0], hp.cw[1][1], hp.cw[1][2], hp.cb[1], v); w.x = PK2(v[0], v[1]); w.y = PK2(v[2], v[3]); w.z = PK2(v[4], v[5]); w.w = PK2(v[6], v[7]); LSTORE16(lb + CT_OFF_G1 + (b * CT_PITCH + t8) * 2, w);
      hy_short_calc<8>(r2, t8, L, hp.cw[2][0], hp.cw[2][1], hp.cw[2][2], hp.cb[2], v); w.x = PK2(v[0], v[1]); w.y = PK2(v[2], v[3]); w.z = PK2(v[4], v[5]); w.w = PK2(v[6], v[7]); LSTORE16(lb + CT_OFF_G2 + (b * CT_PITCH + t8) * 2, w); }
#pragma unroll
    for (int O = 0; O < 2; ++O) {
        const bf16_t* Ff = FILT + (size_t)(0 * 4096 + O * 2048 + c) * FILT_LD + 4096; const bf16_t* Fb = FILT + (size_t)(1 * 4096 + O * 2048 + c) * FILT_LD + 4096;
        const U32X2 rf = LOAD8(Ff + 4 * lane), rb = LOAD8(Fb + 4 * lane); const unsigned wf[2] = {rf.x, rf.y}, wb[2] = {rb.x, rb.y};
        float f[4], bk[4], ss = 0.f; const float tsc = 1.0f / (float)(L - 1);
#pragma unroll
        for (int e = 0; e < 4; ++e) { const float tn = (float)(4 * lane + e) * tsc;
            f[e] = ((e & 1) ? BFHI(wf[e >> 1]) : BFLO(wf[e >> 1])) * (EXPF(-tn * hp.dec[0][O]) + 0.05f); bk[e] = ((e & 1) ? BFHI(wb[e >> 1]) : BFLO(wb[e >> 1])) * (EXPF(-tn * hp.dec[1][O]) + 0.05f); ss += f[e] * f[e] + bk[e] * bk[e]; }
        ss = WAVE_SUM(ss); const float nr = RSQRTF(ss + 1e-12f);
        LDSP bf16_t* kc = (LDSP bf16_t*)(lb + CT_OFF_KC + O * CT_KC + wv * CT_KCOPY);
#pragma unroll
        for (int e = 0; e < 4; ++e) { const int t = 4 * lane + e; const int mf = 255 - t - wv, mb = 255 + t - wv;
            if (mf >= 0) kc[mf] = F2BF(f[e] * nr); if (t > 0) kc[mb] = F2BF(bk[e] * nr); }
    }
    BLOCK_SYNC();
    const int bcol = lane & 15, g = lane >> 4; float z1[2][4];
#pragma unroll
    for (int O = 0; O < 2; ++O) {
        LDSP unsigned char* zin = lb + (O == 0 ? CT_OFF_ZS0 : CT_OFF_ZS1); LDSP unsigned char* gat = lb + (O == 0 ? CT_OFF_G1 : CT_OFF_G2); LDSP unsigned char* kc = lb + CT_OFF_KC + O * CT_KC;
        const float sk = hp.skip[O];
#pragma unroll
        for (int tt = 0; tt < 2; ++tt) { const int t0 = 32 * wv + 16 * tt; F32X4 acc = F32X4_ZERO;
#pragma unroll
            for (int ks = 0; ks < 8; ++ks) { const int s0 = 32 * ks; const int i0 = 255 - (t0 + bcol - s0 - 8 * g);
                const BF16X8 a = LLOAD_BF8(kc + (i0 & 7) * CT_KCOPY + (i0 & ~7) * 2), bq = LLOAD_BF8(zin + (bcol * CT_PITCH + s0 + 8 * g) * 2);
                acc = MFMA16(a, bq, acc); }
            const int tb = t0 + 4 * g; const U32X2 zr = LLOAD8(zin + (bcol * CT_PITCH + tb) * 2), gr = LLOAD8(gat + (bcol * CT_PITCH + tb) * 2);
            const float zv[4] = {BFLO(zr.x), BFHI(zr.x), BFLO(zr.y), BFHI(zr.y)}, gv[4] = {BFLO(gr.x), BFHI(gr.x), BFLO(gr.y), BFHI(gr.y)}; float o[4];
#pragma unroll
            for (int r = 0; r < 4; ++r) { const float zprev = O == 0 ? zv[r] : z1[tt][r]; o[r] = gv[r] * (F32X4_GET(acc, r) + sk * zprev); z1[tt][r] = o[r]; }
            U32X2 w; w.x = PK2(o[0], o[1]); w.y = PK2(o[2], o[3]);
            if (O == 0) LSTORE8(lb + CT_OFF_ZS1 + (bcol * CT_PITCH + tb) * 2, w); else STORE8(ZT + (size_t)c * NTOK + (unsigned)(bcol * L + tb), w); }
        if (O == 0) BLOCK_SYNC();
    }
}
constexpr int LT_INP = 72, LT_MIDP = 136;
constexpr int LT_IN = 0, LT_IN_BYTES = 2 * 128 * LT_INP * 2, LT_MID = LT_IN + LT_IN_BYTES, LT_MID_BYTES = 2 * 64 * LT_MIDP * 2, LT_ZS = LT_MID + LT_MID_BYTES, LT_GS = LT_ZS + 2 * 4096 * 2, LT_BYTES = LT_GS + 2 * 2 * 4096 * 2;
struct LatFrags { BF16X8 af[8]; BF16X8 gb[16]; };
DEVFN float lat_af_val(int k1, int pp, int kk) { const int p = kk >> 6, n1 = kk & 63; const float tr = (float)((k1 * n1) & 63) * (1.0f / 64.0f); return p == pp ? COS_TURNS(tr) : (pp == 0 ? SIN_TURNS(tr) : -SIN_TURNS(tr)); }
DEVFN float lat_gb_val(int k2, int pp, int kk) { const int p = kk >> 7, n2 = kk & 127; const float tr = (float)((n2 * k2) & 127) * (1.0f / 128.0f); return p == pp ? COS_TURNS(tr) : (p == 0 ? -SIN_TURNS(tr) : SIN_TURNS(tr)); }
DEVFN void lat_make_frags(LatFrags& fr, int tid) {
    const int lane = tid & 63, wv = tid >> 6, hh = lane >> 5, m = lane & 31, rb = wv >> 1;
    { const int a = m >> 3, h = (m >> 2) & 1, b = m & 3, k1 = 16 * rb + 4 * a + 2 * h + (b >> 1), pp = b & 1;
#pragma unroll
      for (int ks = 0; ks < 8; ++ks) { int k1o = k1; OPAQUE(k1o); const int k0 = 16 * ks + 8 * hh; U32X4 w;
          w.x = PK2(lat_af_val(k1o, pp, k0 + 0), lat_af_val(k1o, pp, k0 + 1)); w.y = PK2(lat_af_val(k1o, pp, k0 + 2), lat_af_val(k1o, pp, k0 + 3));
          w.z = PK2(lat_af_val(k1o, pp, k0 + 4), lat_af_val(k1o, pp, k0 + 5)); w.w = PK2(lat_af_val(k1o, pp, k0 + 6), lat_af_val(k1o, pp, k0 + 7));
          fr.af[ks] = BF8_FROM_U32X4(w); OPAQUE_BF8(fr.af[ks]); SCHED_FENCE(); } }
    { const int c = lane & 31, k2 = 16 * wv + (c >> 1), pp = c & 1;
#pragma unroll
      for (int ks = 0; ks < 16; ++ks) { int k2o = k2; OPAQUE(k2o); const int k0 = 16 * ks + 8 * hh; U32X4 w;
          w.x = PK2(lat_gb_val(k2o, pp, k0 + 0), lat_gb_val(k2o, pp, k0 + 1)); w.y = PK2(lat_gb_val(k2o, pp, k0 + 2), lat_gb_val(k2o, pp, k0 + 3));
          w.z = PK2(lat_gb_val(k2o, pp, k0 + 4), lat_gb_val(k2o, pp, k0 + 5)); w.w = PK2(lat_gb_val(k2o, pp, k0 + 6), lat_gb_val(k2o, pp, k0 + 7));
          fr.gb[ks] = BF8_FROM_U32X4(w); OPAQUE_BF8(fr.gb[ks]); SCHED_FENCE(); } }
}
DEVFN int lat_crow(int r, int hh) { return (r & 3) + 8 * (r >> 2) + 4 * hh; }
DEVFN void lat_fft(LDSP unsigned char* lb, const LatFrags& fr, F32X16 (&out)[2], int tid) {
    OPAQUE(tid);
    const int lane = tid & 63, wv = tid >> 6, hh = lane >> 5, col = lane & 31, rb = wv >> 1, ch = wv & 1;
#pragma unroll
    for (int cb = 0; cb < 2; ++cb) { const int n2 = 64 * ch + 32 * cb + col; F32X16 acc = F32X16_ZERO;
#pragma unroll
        for (int ks = 0; ks < 8; ++ks) { const int kk = 16 * ks + 8 * hh, p = kk >> 6, n1 = kk & 63;
            const BF16X8 b = LLOAD_BF8(lb + LT_IN + ((p * 128 + n2) * LT_INP + n1) * 2); acc = MFMA32(fr.af[ks], b, acc); }
#pragma unroll
        for (int a = 0; a < 4; ++a)
#pragma unroll
            for (int j = 0; j < 2; ++j) { const int k1 = 16 * rb + 4 * a + 2 * hh + j; const float re = F32X16_GET(acc, 4 * a + 2 * j), im = F32X16_GET(acc, 4 * a + 2 * j + 1);
                const float tr = (float)(k1 * n2) * (1.0f / 8192.0f), cs = COS_TURNS(tr), sn = SIN_TURNS(tr);
                *(LDSP bf16_t*)(lb + LT_MID + ((0 * 64 + k1) * LT_MIDP + n2) * 2) = F2BF(re * cs + im * sn); *(LDSP bf16_t*)(lb + LT_MID + ((1 * 64 + k1) * LT_MIDP + n2) * 2) = F2BF(im * cs - re * sn); } }
    BLOCK_SYNC();
    int col3 = col, hh3 = hh; OPAQUE(col3); OPAQUE(hh3);
#pragma unroll
    for (int mb = 0; mb < 2; ++mb) { F32X16 acc = F32X16_ZERO; const int k1 = 32 * mb + col3;
#pragma unroll
        for (int ks = 0; ks < 16; ++ks) { const int kk = 16 * ks + 8 * hh3, p = kk >> 7, n2 = kk & 127;
            const BF16X8 a = LLOAD_BF8(lb + LT_MID + ((p * 64 + k1) * LT_MIDP + n2) * 2); acc = MFMA32(a, fr.gb[ks], acc); }
        out[mb] = acc; }
}
DEVFN void lat_scatter_conj(LDSP unsigned char* lb, const F32X16 (&y)[2], int tid) {
    OPAQUE(tid);
    const int lane = tid & 63, wv = tid >> 6, hh = lane >> 5, c = lane & 31, k2 = 16 * wv + (c >> 1), pp = c & 1; const float sg = pp ? -1.0f : 1.0f;
#pragma unroll
    for (int mb = 0; mb < 2; ++mb)
#pragma unroll
        for (int r = 0; r < 16; ++r) { const int k1 = 32 * mb + lat_crow(r, hh);
            *(LDSP bf16_t*)(lb + LT_IN + ((pp * 128 + k1 + 64 * (k2 & 1)) * LT_INP + (k2 >> 1)) * 2) = F2BF(sg * F32X16_GET(y[mb], r)); }
}
DEVFN void hy_lat_mfma_unit(LDSP unsigned char* lb, LDSP float* red, const LatFrags& fr, int c, const bf16_t* PT, const bf16_t* FILT, const HyParams& hp, bf16_t* ZT, int tid) {
    constexpr int L = 4096, N = 8192, RB = 4096;
    const int lane = tid & 63, wv = tid >> 6, pp = lane & 1;
    BLOCK_SYNC();
    { int tq = tid; OPAQUE(tq); const int t8 = 8 * tq;
#pragma unroll
    for (int b = 0; b < 2; ++b) { const unsigned o = (unsigned)(RB + b * L + t8); ShortRaw<8> r0, r1, r2;
        hy_short_load<8>(r0, PT + (size_t)c * NTOK, o, t8, L); hy_short_load<8>(r1, PT + (size_t)(2048 + c) * NTOK, o, t8, L); hy_short_load<8>(r2, PT + (size_t)(4096 + c) * NTOK, o, t8, L);
        float v[8]; U32X4 w;
        hy_short_calc<8>(r0, t8, L, hp.cw[0][0], hp.cw[0][1], hp.cw[0][2], hp.cb[0], v); w.x = PK2(v[0], v[1]); w.y = PK2(v[2], v[3]); w.z = PK2(v[4], v[5]); w.w = PK2(v[6], v[7]); LSTORE16(lb + LT_ZS + (b * L + t8) * 2, w);
        hy_short_calc<8>(r1, t8, L, hp.cw[1][0], hp.cw[1][1], hp.cw[1][2], hp.cb[1], v); w.x = PK2(v[0], v[1]); w.y = PK2(v[2], v[3]); w.z = PK2(v[4], v[5]); w.w = PK2(v[6], v[7]); LSTORE16(lb + LT_GS + ((0 * 2 + b) * L + t8) * 2, w);
        hy_short_calc<8>(r2, t8, L, hp.cw[2][0], hp.cw[2][1], hp.cw[2][2], hp.cb[2], v); w.x = PK2(v[0], v[1]); w.y = PK2(v[2], v[3]); w.z = PK2(v[4], v[5]); w.w = PK2(v[6], v[7]); LSTORE16(lb + LT_GS + ((1 * 2 + b) * L + t8) * 2, w); } }
#pragma unroll 1
    for (int O = 0; O < 2; ++O) {
        int tq = tid; OPAQUE(tq); const int t8 = 8 * tq;
        const bf16_t* Ff = FILT + (size_t)(0 * 4096 + O * 2048 + c) * FILT_LD; const bf16_t* Fb = FILT + (size_t)(1 * 4096 + O * 2048 + c) * FILT_LD;
        const float d0 = O == 0 ? hp.dec[0][0] : hp.dec[0][1], d1 = O == 0 ? hp.dec[1][0] : hp.dec[1][1], sk = O == 0 ? hp.skip[0] : hp.skip[1];
        float ss = 0.f;
        { const U32X4 rf = LOAD16(Ff + t8), rbk = LOAD16(Fb + t8); const unsigned wf[4] = {rf.x, rf.y, rf.z, rf.w}, wb[4] = {rbk.x, rbk.y, rbk.z, rbk.w}; const float tsc = 1.0f / (float)(L - 1);
          { const U32X4 z4 = U32X4_ZERO; const int row = tq >> 2, q = tq & 3; LSTORE16(lb + LT_IN + ((128 + row) * LT_INP + 16 * q) * 2, z4); LSTORE16(lb + LT_IN + ((128 + row) * LT_INP + 16 * q + 8) * 2, z4); }
#pragma unroll
          for (int e = 0; e < 8; ++e) { const int t = t8 + e; const float tn = (float)t * tsc;
              const float f = ((e & 1) ? BFHI(wf[e >> 1]) : BFLO(wf[e >> 1])) * (EXPF(-tn * d0) + 0.05f), b = ((e & 1) ? BFHI(wb[e >> 1]) : BFLO(wb[e >> 1])) * (EXPF(-tn * d1) + 0.05f);
              ss += f * f + b * b;
              *(LDSP bf16_t*)(lb + LT_IN + ((t & 127) * LT_INP + (t >> 7)) * 2) = F2BF(f);
              const int nb = t > 0 ? N - t : L; *(LDSP bf16_t*)(lb + LT_IN + ((nb & 127) * LT_INP + (nb >> 7)) * 2) = F2BF(t > 0 ? b : 0.f); } }
        ss = WAVE_SUM(ss);
        if (lane == 0) red[wv] = ss;
        BLOCK_SYNC();
        float tot = 0.f;
#pragma unroll
        for (int w = 0; w < NTHREADS / 64; ++w) tot += red[w];
        const float sc = RSQRTF(tot + 1e-12f) * (1.0f / (float)N);
        F32X16 ksp[2]; lat_fft(lb, fr, ksp, tid);
        int tr_ = tid; OPAQUE(tr_); const int t8b = 8 * tr_;
        { const U32X4 z4 = U32X4_ZERO; const int row = tr_ >> 1, q = tr_ & 1; LSTORE16(lb + LT_IN + (row * LT_INP + 32 + 16 * q) * 2, z4); LSTORE16(lb + LT_IN + (row * LT_INP + 32 + 16 * q + 8) * 2, z4); }
#pragma unroll
        for (int b = 0; b < 2; ++b) { const U32X4 zr = LLOAD16(lb + LT_ZS + (b * L + t8b) * 2); const unsigned zw[4] = {zr.x, zr.y, zr.z, zr.w};
#pragma unroll
            for (int e = 0; e < 8; ++e) { const int t = t8b + e; *(LDSP bf16_t*)(lb + LT_IN + ((b * 128 + (t & 127)) * LT_INP + (t >> 7)) * 2) = (bf16_t)((e & 1) ? (zw[e >> 1] >> 16) : (zw[e >> 1] & 0xffffu)); } }
        BLOCK_SYNC();
        F32X16 xs[2]; lat_fft(lb, fr, xs, tid);
#pragma unroll
        for (int mb = 0; mb < 2; ++mb)
#pragma unroll
            for (int r = 0; r < 16; ++r) { const float x = F32X16_GET(xs[mb], r), k = F32X16_GET(ksp[mb], r) * sc, xo = LANE_XOR1(x), ko = LANE_XOR1(k);
                F32X16_SET(xs[mb], r, pp ? (xo * k + x * ko) : (x * k - xo * ko)); }
        lat_scatter_conj(lb, xs, tid);
        BLOCK_SYNC();
        F32X16 ys[2]; lat_fft(lb, fr, ys, tid);
        if (wv < 4) { int lg = lane; OPAQUE(lg); const int hh_ = lg >> 5, pp_ = lg & 1, k2g = 16 * wv + ((lg & 31) >> 1); const float sg = pp_ ? -1.0f : 1.0f;
#pragma unroll
            for (int mb = 0; mb < 2; ++mb)
#pragma unroll
                for (int a = 0; a < 4; ++a) { const int t = 64 * k2g + 32 * mb + 8 * a + 4 * hh_;
                    const U32X2 zr = LLOAD8(lb + LT_ZS + (pp_ * L + t) * 2), gr = LLOAD8(lb + LT_GS + ((O * 2 + pp_) * L + t) * 2);
                    const float zv[4] = {BFLO(zr.x), BFHI(zr.x), BFLO(zr.y), BFHI(zr.y)}, gv[4] = {BFLO(gr.x), BFHI(gr.x), BFLO(gr.y), BFHI(gr.y)}; float o[4];
#pragma unroll
                    for (int e = 0; e < 4; ++e) o[e] = gv[e] * (sg * F32X16_GET(ys[mb], 4 * a + e) + sk * zv[e]);
                    U32X2 w; w.x = PK2(o[0], o[1]); w.y = PK2(o[2], o[3]);
                    if (O == 0) LSTORE8(lb + LT_ZS + (pp_ * L + t) * 2, w); else STORE8(ZT + (size_t)c * NTOK + (unsigned)(RB + pp_ * L + t), w); } }
        BLOCK_SYNC();
    }
}
__device__ __forceinline__ void hy_load_params(const Args& a, int c, HyParams& hp) {
#pragma unroll
    for (int d = 0; d < 2; ++d)
#pragma unroll
        for (int o = 0; o < 2; ++o) hp.dec[d][o] = __expf(a.in[I_HDEC][(d * 2 + o) * 2048 + c]);
    hp.skip[0] = a.in[I_HSKIP][c]; hp.skip[1] = a.in[I_HSKIP][2048 + c];
#pragma unroll
    for (int w = 0; w < 3; ++w) { hp.cb[w] = a.in[I_HCB][w * 2048 + c];
#pragma unroll
        for (int k = 0; k < 3; ++k) hp.cw[w][k] = a.in[I_HCW][k * 6144 + w * 2048 + c]; }
}
__device__ __forceinline__ void hy_conv_phase(const Args& a, LAS unsigned char* lds, int tid, int vcu, int G) {
    unsigned char* ws = a.ws; const bf16_t* PT = (const bf16_t*)(ws + WS_PT); const bf16_t* FILT = (const bf16_t*)(ws + WS_FILT); bf16_t* ZT = (bf16_t*)(ws + WS_ZT);
    LAS float* red = (LAS float*)(lds + LDSCTL_OFF);
    { LatFrags fr; lat_make_frags(fr, tid);
      for (int c = vcu; c < 2048; c += G) { HyParams hp; hy_load_params(a, c, hp); hy_lat_mfma_unit(lds, red, fr, c, PT, FILT, hp, ZT, tid); } }
    for (int c = vcu; c < 2048; c += G) { HyParams hp; hy_load_params(a, c, hp); hy_ctx_mfma_unit(lds, c, PT, FILT, hp, ZT, tid); }
    __syncthreads();
}

constexpr int N_PHASES = 36;
#ifndef MK_PER_PHASE
#define MK_PER_PHASE 0
#endif
#ifndef ATTN_NAIVE
#define ATTN_NAIVE 0
#endif

__global__ void __launch_bounds__(NTHREADS, 2) trunk_fwd(Args args) {
    extern __shared__ __attribute__((aligned(16))) unsigned char lds_raw[];
    LAS unsigned char* lds = (LAS unsigned char*)lds_raw;
    volatile LAS unsigned* MISC = (volatile LAS unsigned*)(lds + MISC_OFF);
    const int tid = threadIdx.x, lane = tid & 63, wave = __builtin_amdgcn_readfirstlane(tid >> 6);
    const int G = gridDim.x, bx = blockIdx.x, vcu = (G % 8 == 0) ? (bx % 8) * (G / 8) + bx / 8 : bx;
    unsigned char* ws = args.ws;
    for (int u = tid; u < (LDS_BYTES - LDSCTL_OFF) / 4; u += NTHREADS) ((LAS unsigned*)(lds + LDSCTL_OFF))[u] = 0u;
    __syncthreads();
    XcdBarrier bar; bar.bar = (unsigned*)(ws + WS_CTL) + 4096; bar.x = 0; bar.st = nullptr;
    if (!MK_PER_PHASE) bar = xcd_barrier_post((unsigned*)(ws + WS_CTL) + 4096, MISC + 8);
    const int lo = args.ph_lo, hi = args.ph_hi;
#ifndef PH_ONLY_LO
#define PH_ONLY_LO 0
#define PH_ONLY_HI 1000
#endif
#define IN(k) ((k) >= PH_ONLY_LO && (k) < PH_ONLY_HI && lo <= (k) && (k) < hi)
#ifdef PROBE_MULT
    unsigned long long pr_prev = __builtin_amdgcn_s_memrealtime(), pr_acc = 0ull;
#define PROBE_STAMP(k) do { const unsigned long long now_ = __builtin_amdgcn_s_memrealtime(); if ((PROBE_MASK >> (k)) & 1ull) pr_acc += now_ - pr_prev; pr_prev = now_; } while (0)
#else
#define PROBE_STAMP(k) do { } while (0)
#endif
#define SEAM(k) do { if (IN(k) && IN((k) + 1)) xcd_barrier(bar); PROBE_STAMP(k); } while (0)
#ifndef DUP_N
#define DUP_N 1
#define DUP_A -1
#define DUP_B -1
#define DUP_C -1
#define DUP_D -1
#endif
#define NREP(k) (((k) == DUP_A || (k) == DUP_B || (k) == DUP_C || (k) == DUP_D) ? DUP_N : 1)
#define REPEAT(k) for (int rep_ = 0; rep_ < NREP(k); ++rep_)
    const char* U = (const char*)(ws + WS_U); const char* MIXO = (const char*)(ws + WS_MIXO); char* PART = (char*)(ws + WS_PART);

#define OUTPROJ(Aptr, Wptr, KTOT) OUTPROJ_P(Aptr, Wptr, KTOT, KTOT)
#define OUTPROJ_P(Aptr, Wptr, KTOT, PITCH) do { SchedGrid S{(const char*)(Aptr), (const char*)(Wptr), PART, (size_t)256 * (PITCH) * 2, (size_t)256 * (PITCH) * 2, (size_t)((KTOT) / 2) * 2, (size_t)((KTOT) / 2) * 2, \
        (size_t)256 * D * 2, (size_t)256 * 2, (size_t)NTOK * D * 2, D, 48, 8, 2, G, bx}; pg8::EpiBf16<0> E{nullptr}; pg8::gemm_phase<pg8::EpiBf16<0>, SchedGrid, true, true>(lds, (KTOT) / 2, (PITCH), (PITCH), S, E); } while (0)
#define FFN_BLOCK(l, p, lnext, final) do { \
    if (IN(p)) REPEAT(p) { SchedGrid S{(const char*)(ws + WS_U8), (const char*)(ws + WS_WGU + (size_t)(l) * SZ_WGU), (char*)(ws + WS_ACT), (size_t)256 * UP8, (size_t)256 * WGP8, 0, 0, (size_t)256 * AP * 2, (size_t)128 * 2, 0, AP, 48, 44, 1, G, bx}; \
        pg8::EpiSwigluI8 E{(const float*)(ws + WS_USC), (const float*)(ws + WS_WSC) + (size_t)(l) * 11264}; pg8::gemm_phase<pg8::EpiSwigluI8, SchedGrid, true, true, true>(lds, D / 2, UP8 / 2, WGP8 / 2, S, E);     \
        if ((l) < 3 && G == 256 && bx >= 64) { convert_weights(args, 3 * ((l) + 1) + 2, 3 * ((l) + 1) + 3, (bx - 64) * NWAVES + wave, 192 * NWAVES, (LAS float*)(lds + wave * 16384), lane); __syncthreads(); ffn_w8(args, (l) + 1, bx - 64, 192, lds, tid); }     \
        else if ((l) < 3 && G != 256) { convert_weights(args, 3 * ((l) + 1) + 2, 3 * ((l) + 1) + 3, vcu * NWAVES + wave, G * NWAVES, (LAS float*)(lds + wave * 16384), lane); __syncthreads(); ffn_w8(args, (l) + 1, vcu, G, lds, tid); } } SEAM(p); \
    if (IN((p) + 1)) REPEAT((p) + 1) { OUTPROJ_P(ws + WS_ACT, ws + WS_WD + (size_t)(l) * SZ_WD, DFF, AP); } SEAM((p) + 1); \
    if (IN((p) + 2)) { \
        ln_phase(args, lds, tid, lane, wave, vcu, G, (l), 5, 1, nullptr, (lnext), 0, (final)); } if (!(final)) SEAM((p) + 2); } while (0)
#define MLA_BLOCK(j, l, p) do { \
    if (IN(p)) REPEAT(p) { SchedGrid S{U, (const char*)(ws + WS_W1 + (size_t)(j) * SZ_W1), (char*)(ws + WS_T1), (size_t)256 * UP * 2, (size_t)256 * D * 2, 0, 0, (size_t)256 * 1280 * 2, (size_t)256 * 2, 0, 1280, 48, 5, 1, G, bx}; \
        pg8::EpiBf16<0> E{nullptr}; pg8::gemm_phase<pg8::EpiBf16<0>, SchedGrid, true, true>(lds, D, UP, D, S, E); } SEAM(p); \
    if (IN((p) + 1)) { mla_norm_phase(args, lane, wave, vcu, G, (j)); } SEAM((p) + 1); \
    if (IN((p) + 2)) REPEAT((p) + 2) { SchedPair S; \
        S.g0 = SchedGrid{(const char*)(ws + WS_QL), (const char*)(ws + WS_WUQ + (size_t)(j) * SZ_WUQ), (char*)(ws + WS_Q), (size_t)256 * QP8, (size_t)256 * QP8, 0, 0, (size_t)256 * 3072 * 2, (size_t)256 * 2, 0, 3072, 48, 12, 1, G, bx}; \
        S.g1 = SchedGrid{(const char*)(ws + WS_CKVN + (size_t)(j) * NKV * QP8), (const char*)(ws + WS_WUKV + (size_t)(j) * SZ_WUKV), (char*)(ws + WS_KV), (size_t)256 * QP8, (size_t)256 * QP8, 0, 0, (size_t)256 * 4096 * 2, (size_t)256 * 2, 0, 4096, 52, 16, 1, G, bx}; \
        S.G = G; S.c = bx; pg8::EpiQKV E{(const pg8::f32x2*)(ws + WS_ROPE), QSCALE, (const float*)(ws + WS_QSC), (const float*)(ws + WS_WUQSC) + (j) * 3072, (const float*)(ws + WS_KSC) + (size_t)(j) * NKV, (const float*)(ws + WS_WUKVSC) + (j) * 4096}; \
        int k512 = 256; asm volatile("" : "+s"(k512)); pg8::gemm_phase<pg8::EpiQKV, SchedPair, false, true, true>(lds, k512, QP8 / 2, QP8 / 2, S, E); } SEAM((p) + 2);     \
    if (IN((p) + 3)) REPEAT((p) + 3) { if (ATTN_NAIVE) attn_naive_phase(args, lane, wave, vcu, G, (j)); else attn_phase(args, lds, vcu, G, (j)); } SEAM((p) + 3); \
    if (IN((p) + 4)) REPEAT((p) + 4) { OUTPROJ_P(MIXO, ws + WS_WO + (size_t)(l) * SZ_WO, D, MP); } SEAM((p) + 4); \
    if (IN((p) + 5)) { ln_phase(args, lds, tid, lane, wave, vcu, G, (l), 2, 0, nullptr, (l), 3, false); } SEAM((p) + 5); } while (0)

    if (IN(0)) REPEAT(0) { p0_prologue(args, lds, tid, lane, wave, vcu, G); } SEAM(0);
    if (IN(1)) { p1_embed(args, lane, wave, vcu, G);
        { SchedGrid S{(const char*)(ws + WS_W3), (const char*)(ws + WS_HF2), (char*)(ws + WS_FILT), (size_t)256 * 256 * 2, (size_t)256 * 256 * 2, 0, 0, (size_t)256 * FILT_LD * 2, (size_t)256 * 2, 0, FILT_LD, 32, 17, 1, G, bx};
          pg8::EpiBf16<0> E{nullptr}; int k256 = 256; asm volatile("" : "+s"(k256));
          pg8::gemm_phase<pg8::EpiBf16<0>, SchedGrid, true, true>(lds, k256, 256, 256, S, E); }
    } SEAM(1);
    MLA_BLOCK(0, 0, 2);
    FFN_BLOCK(0, 8, 1, false);
    if (IN(11)) REPEAT(11) {
        { SchedGrid S{(const char*)(ws + WS_WIN), U, (char*)(ws + WS_PT), (size_t)256 * D * 2, (size_t)256 * UP * 2, 0, 0, (size_t)256 * NTOK * 2, (size_t)256 * 2, 0, NTOK, 24, 48, 1, G, bx};
          pg8::EpiBf16<1> E{args.in[I_HBIN]}; pg8::gemm_phase<pg8::EpiBf16<1>, SchedGrid, true, true>(lds, D, D, UP, S, E); }
        { const bool part = (G == 256); if (!part || bx >= 128) { const int w0 = part ? bx - 128 : vcu, nwg = part ? 128 : G;
            convert_weights(args, 18, 21, w0 * NWAVES + wave, nwg * NWAVES, (LAS float*)(lds + wave * 16384), lane); convert_weights(args, 23, 24, w0 * NWAVES + wave, nwg * NWAVES, (LAS float*)(lds + wave * 16384), lane); convert_weights(args, 27, 28, w0 * NWAVES + wave, nwg * NWAVES, (LAS float*)(lds + wave * 16384), lane);
            make_dml(ws, (size_t)w0 * NTHREADS + tid, (size_t)nwg * NTHREADS); __syncthreads();
            wq_desc(args, 21, (signed char*)(ws + WS_WUQ + SZ_WUQ), QP8, (float*)(ws + WS_WUQSC) + 3072, w0, nwg, lds, tid); wq_desc(args, 22, (signed char*)(ws + WS_WUKV + SZ_WUKV), QP8, (float*)(ws + WS_WUKVSC) + 4096, w0, nwg, lds, tid); } }
    } SEAM(11);
    if (IN(12)) REPEAT(12) { hy_conv_phase(args, lds, tid, vcu, G); } SEAM(12);
    if (IN(13)) { transpose_zt_phase(args, lds, lane, wave, vcu, G); } SEAM(13);
    if (IN(14)) { OUTPROJ_P(MIXO, ws + WS_WO + (size_t)1 * SZ_WO, D, MP); } SEAM(14);
    if (IN(15)) { ln_phase(args, lds, tid, lane, wave, vcu, G, 1, 2, 0, args.in[I_HBOUT], 1, 3, false); } SEAM(15);
    FFN_BLOCK(1, 16, 2, false);
    if (IN(19)) REPEAT(19) { SchedF1 S{(const char*)(ws + WS_DFTC), U, (char*)(ws + WS_ATC), (char*)(ws + WS_ATL), G, bx}; pg8::EpiBf16<0> E{nullptr}; int k256 = 256; asm volatile("" : "+s"(k256)); pg8::gemm_phase<pg8::EpiBf16<0>, SchedF1, true, true>(lds, k256, 256, UP, S, E); } SEAM(19);
    if (IN(20)) REPEAT(20) {
        { SchedF2 S{(const char*)(ws + WS_DML), (const char*)(ws + WS_ATL), (char*)(ws + WS_PQ), G, bx};
          pg8::EpiBf16<0> E{nullptr}; pg8::gemm_phase<pg8::EpiBf16<0>, SchedF2, true, true>(lds, 4096, 4096, 8192, S, E); }
        { SchedGrid S{(const char*)(ws + WS_DMC), (const char*)(ws + WS_ATC), (char*)(ws + WS_MIXO), 0, (size_t)256 * 512 * 2, 0, (size_t)2048 * 512 * 2, 0, (size_t)256 * 2, (size_t)256 * MP * 2, MP, 1, 8, 16, G, bx};
          pg8::EpiBf16<0> E{nullptr}; pg8::gemm_phase<pg8::EpiBf16<0>, SchedGrid, true, true>(lds, 512, 512, 512, S, E); }
    } SEAM(20);
    if (IN(35)) { fnet_combine_phase(args, tid, lane, wave, vcu, G); } if (IN(35) && IN(21)) xcd_barrier(bar); PROBE_STAMP(35);
    if (IN(21)) { OUTPROJ_P(MIXO, ws + WS_WO + (size_t)2 * SZ_WO, D, MP); } SEAM(21);
    if (IN(22)) { ln_phase(args, lds, tid, lane, wave, vcu, G, 2, 2, 0, args.in[I_FNB], 2, 3, false); } SEAM(22);
    FFN_BLOCK(2, 23, 3, false);
    MLA_BLOCK(1, 3, 26);
    FFN_BLOCK(3, 32, 3, true);
#ifdef PROBE_MULT
    { __syncthreads(); PROBE_STAMP(34); if (bx == 0 && tid == 0) { pr_acc += *(LAS unsigned long long*)(lds + LDSCTL_OFF + 1024); const unsigned long long t0_ = __builtin_amdgcn_s_memrealtime(), want_ = pr_acc * PROBE_MULT; while (__builtin_amdgcn_s_memrealtime() - t0_ < want_) __builtin_amdgcn_s_sleep(8); } }
#endif
#undef IN
#undef SEAM
}

extern "C" void kernel_launch(void* const* d_in, const int* in_sizes, int n_in, void* d_out, int out_size, void* d_ws, size_t ws_size, hipStream_t stream) {
    static int grid = 0;
    if (grid == 0) {
        if (n_in != 38 || ws_size < WS_END) { fprintf(stderr, "kernel_launch: expected 38 inputs and >= %zu bytes of workspace; got %d, %zu\n", (size_t)WS_END, n_in, ws_size); grid = -1; return; }
        int dev = 0, cus = 0, per_cu = 0;
        if (hipGetDevice(&dev) != hipSuccess || hipDeviceGetAttribute(&cus, hipDeviceAttributeMultiprocessorCount, dev) != hipSuccess) { grid = -1; return; }
        if (hipFuncSetAttribute((const void*)trunk_fwd, hipFuncAttributeMaxDynamicSharedMemorySize, LDS_BYTES) != hipSuccess) { fprintf(stderr, "kernel_launch: hipFuncSetAttribute failed\n"); grid = -1; return; }
        if (hipOccupancyMaxActiveBlocksPerMultiprocessor(&per_cu, (const void*)trunk_fwd, NTHREADS, LDS_BYTES) != hipSuccess || per_cu < 1) { fprintf(stderr, "kernel_launch: occupancy query reports %d workgroups per CU\n", per_cu); }
        (void)hipGetLastError();
        grid = cus;
    }
    if (grid < 0) return;
    if (hipMemsetAsync((char*)d_ws + WS_CTL, 0, CTL_ZERO_BYTES, stream) != hipSuccess) return;
    Args a{};
    for (int i = 0; i < 38; ++i) a.in[i] = (const float*)d_in[i];
    a.out = (float*)d_out; a.ws = (unsigned char*)d_ws; a.li = 0; a.pad = 0;
#if MK_PER_PHASE
    for (int p = 0; p < N_PHASES; ++p) { a.ph_lo = p; a.ph_hi = p + 1; hipLaunchKernelGGL(trunk_fwd, dim3(grid), dim3(NTHREADS), LDS_BYTES, stream, a); }
#else
    a.ph_lo = 0; a.ph_hi = N_PHASES; hipLaunchKernelGGL(trunk_fwd, dim3(grid), dim3(NTHREADS), LDS_BYTES, stream, a);
#endif
    const hipError_t le = hipPeekAtLastError();
    if (le != hipSuccess) fprintf(stderr, "kernel_launch: launch failed: %s\n", hipGetErrorName(le));
}
```

```cpp
#include <hip/hip_runtime.h>
#include <cstdio>
#include <cstdint>
#define GAS __attribute__((address_space(1)))
#define LAS __attribute__((address_space(3)))
typedef unsigned short bf16_t;
typedef unsigned v4u __attribute__((ext_vector_type(4)));
typedef unsigned v2u __attribute__((ext_vector_type(2)));
typedef float f32x4 __attribute__((ext_vector_type(4)));
typedef float f32x2 __attribute__((ext_vector_type(2)));

constexpr int D = 2048, NCTX = 4096, NLAT = 8192, NTOK = 12288, DFF = 5632, NKV = 13312;
constexpr int NTHREADS = 512, NWAVES = 8;
constexpr int UP8 = 2048 + 128, WGP8 = 2048 + 128;
constexpr int QP8 = 512 + 64;
constexpr int MP = 2048 + 64;
constexpr int UP = 2048 + 64, WGP = 2048 + 64, AP = 5632 + 64;
constexpr float DN_ALPHA = 1.681792830507429f;
constexpr float LN_EPS = 1e-5f, RMS_EPS = 1e-6f;
constexpr float QSCALE = 0.07216878364870322f * 1.4426950408889634f;
constexpr int FILT_LD = 4352;

constexpr size_t al256(size_t x) { return (x + 255) & ~(size_t)255; }
constexpr size_t SZ_WGU = (size_t)11264 * WGP8,          SZ_WD = (size_t)2048 * AP * 2;
constexpr size_t SZ_W1 = (size_t)1280 * 2048 * 2, SZ_WUQ = (size_t)3072 * QP8  , SZ_WUKV = (size_t)4096 * QP8  , SZ_WO = (size_t)2048 * MP * 2;
constexpr size_t SZ_WIN = (size_t)6144 * 2048 * 2, SZ_W3 = (size_t)8192 * 256 * 2;
constexpr size_t SZ_DFTC = (size_t)512 * 256 * 2, SZ_DML = (size_t)4096 * 8192 * 2, SZ_DMC = (size_t)256 * 512 * 2;
constexpr size_t SZ_ROWS = (size_t)NTOK * D * 2;
constexpr size_t WS_CTL = 0, CTL_ZERO_BYTES = 1u << 20;
constexpr size_t WS_COLMAX = 65536;
constexpr size_t WS_MOD = WS_CTL + CTL_ZERO_BYTES;
constexpr size_t WS_ROPE = WS_MOD + al256((size_t)4 * 3 * 12288 * 4);
constexpr size_t WS_HF2 = WS_ROPE + al256((size_t)4096 * 32 * 8);
constexpr size_t WS_WGU = WS_HF2 + al256((size_t)FILT_LD * 256 * 2);
constexpr size_t WS_WD = WS_WGU + 4 * SZ_WGU;
constexpr size_t WS_W1 = WS_WD + 4 * SZ_WD;
constexpr size_t WS_WUQ = WS_W1 + 2 * SZ_W1;
constexpr size_t WS_WUKV = WS_WUQ + 2 * SZ_WUQ;
constexpr size_t WS_WO = WS_WUKV + 2 * SZ_WUKV;
constexpr size_t WS_WIN = WS_WO + 4 * SZ_WO;
constexpr size_t WS_W3 = WS_WIN + SZ_WIN;
constexpr size_t WS_DFTC = WS_W3 + SZ_W3;
constexpr size_t WS_DML = WS_DFTC + SZ_DFTC;
constexpr size_t WS_DMC = WS_DML + SZ_DML;
constexpr size_t WS_WSC = WS_DMC + al256(SZ_DMC);
constexpr size_t WS_WUQSC = WS_WSC + al256((size_t)4 * 11264 * 4);
constexpr size_t WS_WUKVSC = WS_WUQSC + al256((size_t)2 * 3072 * 4);
constexpr size_t WS_QSC = WS_WUKVSC + al256((size_t)2 * 4096 * 4);
constexpr size_t WS_KSC = WS_QSC + al256((size_t)NTOK * 4);
constexpr size_t WS_U8 = WS_KSC + al256((size_t)2 * NKV * 4);
constexpr size_t WS_USC = WS_U8 + (size_t)NTOK * UP8;
constexpr size_t WS_H = WS_USC + al256((size_t)NTOK * 4);
constexpr size_t WS_U = WS_H + SZ_ROWS;
constexpr size_t WS_PART = WS_U + (size_t)NTOK * UP * 2;
constexpr size_t WS_ACT = WS_PART + (size_t)2 * NTOK * D * 4;
constexpr size_t WS_CKVN = WS_ACT + (size_t)NTOK * AP * 2;
constexpr size_t WS_KR = WS_CKVN + 2 * (size_t)NKV * QP8;
constexpr size_t WS_MIXO = WS_KR + 2 * al256((size_t)NKV * 64 * 2);
constexpr size_t WS_FILT = WS_MIXO + (size_t)NTOK * MP * 2;
constexpr size_t WS_X = WS_FILT + (size_t)8192 * FILT_LD * 2;
constexpr size_t WS_T1 = WS_X;
constexpr size_t WS_QL = WS_T1 + (size_t)NTOK * 1280 * 4;
constexpr size_t WS_Q = WS_QL + (size_t)NTOK * QP8;
constexpr size_t WS_KV = WS_Q + (size_t)NTOK * 3072 * 2;
constexpr size_t WS_XEND_MLA = WS_KV + (size_t)NKV * 4096 * 2;
constexpr size_t WS_PT = WS_X;
constexpr size_t WS_ZT = WS_PT + (size_t)6144 * NTOK * 2;
constexpr size_t WS_XEND_HY = WS_ZT + (size_t)2048 * NTOK * 2;
constexpr size_t WS_ATC = WS_X;
constexpr size_t WS_ATL = WS_ATC + (size_t)16 * 2048 * 512 * 2;
constexpr size_t WS_PQ = WS_ATL + (size_t)2 * 2048 * 8192 * 2;
constexpr size_t WS_XEND_FN = WS_PQ + (size_t)2 * 2 * 2048 * 2048 * 2;
constexpr size_t cmax(size_t a, size_t b) { return a > b ? a : b; }
constexpr size_t WS_END = cmax(WS_XEND_MLA, cmax(WS_XEND_HY, WS_XEND_FN));
static_assert(WS_END <= (size_t)1610612736, "d_ws map exceeds 4 x largest tensor");

constexpr int RING_OFF = 0, RING_BYTES = 131072;
constexpr int LDSCTL_OFF = RING_BYTES, MISC_OFF = LDSCTL_OFF + 320;
constexpr int LDS_BYTES = 163840;
static_assert(MISC_OFF + 128 <= LDS_BYTES, "LDS map");

__device__ __forceinline__ unsigned pk2(float lo, float hi) { unsigned r; asm("v_cvt_pk_bf16_f32 %0, %1, %2" : "=v"(r) : "v"(lo), "v"(hi)); return r; }
__device__ __forceinline__ unsigned f2bf(float f) { return pk2(f, 0.f) & 0xffffu; }
__device__ __forceinline__ float bf2f(unsigned short b) { return __builtin_bit_cast(float, ((unsigned)b) << 16); }
__device__ __forceinline__ float bflo(unsigned w) { return __builtin_bit_cast(float, w << 16); }
__device__ __forceinline__ float bfhi(unsigned w) { return __builtin_bit_cast(float, w & 0xffff0000u); }
#define LDS_WAIT() asm volatile("s_waitcnt lgkmcnt(0)" ::: "memory")
#define VM_WAIT() asm volatile("s_waitcnt vmcnt(0)" ::: "memory")
__device__ __forceinline__ float wave_sum(float v) {
#pragma unroll
    for (int o = 1; o < 64; o <<= 1) v += __shfl_xor(v, o);
    return v;
}

namespace pg8 {
typedef short bf16x8 __attribute__((ext_vector_type(8)));
typedef float f32x4 __attribute__((ext_vector_type(4)));
typedef float f32x2 __attribute__((ext_vector_type(2)));
typedef unsigned u32x4 __attribute__((ext_vector_type(4)));
typedef int i32x4 __attribute__((ext_vector_type(4)));
constexpr int BM = 256, BK = 64, HALF = 128, HTB = HALF * BK * 2  , STAGE_BYTES = 8 * HTB, NXCD = 8, WGM = 8;

__host__ __device__ __forceinline__ int lds_byte(int r, int c) { const int st = (r >> 4) * 2 + (c >> 5), rr = r & 15, cc = c & 31, ob = rr * 64 + cc * 2; return st * 1024 + (ob ^ (((ob >> 9) & 1) << 5)); }
__host__ __device__ __forceinline__ void stage_rc(int b, int& R, int& C) { const int st = b / 1024, sb = b % 1024, swz = sb ^ (((sb >> 9) & 1) << 5); R = (st >> 1) * 16 + swz / 64; C = (st & 1) * 32 + (swz % 64) / 2; }
__host__ __device__ __forceinline__ int perm32(int rho) { const int n = rho >> 4, i = rho & 15; return 8 * (i >> 2) + 4 * n + (i & 3); }

struct Unit { const char* A; const char* B; char* O; int ldc; int pm, pn, aux; };

__device__ __forceinline__ void tile_of(int L, int nM, int nN, int& pm, int& pn) {
    const int nwg = nM * nN; int wgid = L; { const int q = nwg / NXCD, r = nwg % NXCD, xcd = wgid % NXCD, off = wgid / NXCD; wgid = (xcd < r ? xcd * (q + 1) : r * (q + 1) + (xcd - r) * q) + off; }
    const int nig = WGM * nN, gid = wgid / nig, fm = gid * WGM, gsz = (nM - fm) < WGM ? (nM - fm) : WGM;
    pm = fm + ((wgid % nig) % gsz); pn = (wgid % nig) / gsz;
}

__device__ __forceinline__ unsigned cvt_pk_bf16(float lo, float hi) { unsigned r; asm volatile("v_cvt_pk_bf16_f32 %0, %1, %2" : "=v"(r) : "v"(lo), "v"(hi)); return r; }

struct EpiF32 {
    static constexpr bool PERM = false;
    __device__ __forceinline__ void operator()(const f32x4 (&acc)[2][2][4][2], const Unit& u, int wr, int wc, int fr_, int fq_) const {
        int ln_ = threadIdx.x & 63; asm volatile("" : "+v"(ln_)); const int fr = ln_ & 15, fq = ln_ >> 4;
        const int row0 = wr * 64 + fr, col0 = wc * 32 + 4 * fq; float* O = (float*)u.O;
#pragma unroll
        for (int ai = 0; ai < 2; ++ai)
#pragma unroll
            for (int m = 0; m < 4; ++m) { float* rowp = O + (size_t)(row0 + ai * HALF + m * 16) * u.ldc + col0;
#pragma unroll
                for (int bj = 0; bj < 2; ++bj)
#pragma unroll
                    for (int n = 0; n < 2; ++n) *(f32x4*)(rowp + bj * HALF + n * 16) = acc[ai][bj][m][n]; }
    }
};
template <int BIAS  > struct EpiBf16 {
    static constexpr bool PERM = true;
    const float* bias;
    __device__ __forceinline__ void operator()(const f32x4 (&acc)[2][2][4][2], const Unit& u, int wr, int wc, int fr_, int fq_) const {
        int ln_ = threadIdx.x & 63; asm volatile("" : "+v"(ln_)); const int fr = ln_ & 15, fq = ln_ >> 4;
        const int row0 = wr * 64 + fr, col0 = wc * 32 + 8 * fq; bf16_t* O = (bf16_t*)u.O;
        float bv[2][4];
#pragma unroll
        for (int ai = 0; ai < 2; ++ai)
#pragma unroll
            for (int m = 0; m < 4; ++m) { bv[ai][m] = 0.f; if constexpr (BIAS == 1) bv[ai][m] = bias[u.pm * BM + row0 + ai * HALF + m * 16]; }
#pragma unroll
        for (int ai = 0; ai < 2; ++ai)
#pragma unroll
            for (int m = 0; m < 4; ++m) { const int r = row0 + ai * HALF + m * 16; bf16_t* rowp = O + (size_t)r * u.ldc + col0; const float b = bv[ai][m];
#pragma unroll
                for (int bj = 0; bj < 2; ++bj) { f32x4 v0 = acc[ai][bj][m][0], v1 = acc[ai][bj][m][1]; if constexpr (BIAS == 1) { v0 = v0 + b; v1 = v1 + b; }
                    u32x4 w; w.x = cvt_pk_bf16(v0[0], v0[1]); w.y = cvt_pk_bf16(v0[2], v0[3]); w.z = cvt_pk_bf16(v1[0], v1[1]); w.w = cvt_pk_bf16(v1[2], v1[3]);
                    *(u32x4*)(rowp + bj * HALF) = w; } }
    }
};
struct EpiSwiglu {
    static constexpr bool PERM = true;
    __device__ __forceinline__ void operator()(const f32x4 (&acc)[2][2][4][2], const Unit& u, int wr, int wc, int fr_, int fq_) const {
        int ln_ = threadIdx.x & 63; asm volatile("" : "+v"(ln_)); const int fr = ln_ & 15, fq = ln_ >> 4;
        const int row0 = wr * 64 + fr, col0 = wc * 32 + 8 * fq; bf16_t* O = (bf16_t*)u.O;
#pragma unroll
        for (int ai = 0; ai < 2; ++ai)
#pragma unroll
            for (int m = 0; m < 4; ++m) { bf16_t* rowp = O + (size_t)(row0 + ai * HALF + m * 16) * u.ldc + col0; float v[8];
#pragma unroll
                for (int n = 0; n < 2; ++n)
#pragma unroll
                    for (int j = 0; j < 4; ++j) { const float g = acc[ai][0][m][n][j], up = acc[ai][1][m][n][j]; v[n * 4 + j] = g * __builtin_amdgcn_rcpf(1.0f + __expf(-g)) * up; }
                u32x4 w; w.x = cvt_pk_bf16(v[0], v[1]); w.y = cvt_pk_bf16(v[2], v[3]); w.z = cvt_pk_bf16(v[4], v[5]); w.w = cvt_pk_bf16(v[6], v[7]);
                *(u32x4*)rowp = w; }
    }
};
struct EpiSwigluI8 {
    static constexpr bool PERM = true;
    const float* sa; const float* sb;
    __device__ __forceinline__ void operator()(const i32x4 (&acc)[2][2][4][2], const Unit& u, int wr, int wc, int fr_, int fq_) const {
        int ln_ = threadIdx.x & 63; asm volatile("" : "+v"(ln_)); const int fr = ln_ & 15, fq = ln_ >> 4;
        const int row0 = wr * 64 + fr, col0 = wc * 32 + 8 * fq; bf16_t* O = (bf16_t*)u.O;
        float sg[8], su[8];
        { const f32x4 g0 = *(const f32x4*)(sb + u.pn * BM + col0), g1 = *(const f32x4*)(sb + u.pn * BM + col0 + 4), u0 = *(const f32x4*)(sb + u.pn * BM + HALF + col0), u1 = *(const f32x4*)(sb + u.pn * BM + HALF + col0 + 4);
#pragma unroll
          for (int j = 0; j < 4; ++j) { sg[j] = g0[j]; sg[4 + j] = g1[j]; su[j] = u0[j]; su[4 + j] = u1[j]; } }
        float rav[2][4];
#pragma unroll
        for (int ai = 0; ai < 2; ++ai)
#pragma unroll
            for (int m = 0; m < 4; ++m) rav[ai][m] = sa[u.pm * BM + row0 + ai * HALF + m * 16];
#pragma unroll
        for (int ai = 0; ai < 2; ++ai)
#pragma unroll
            for (int m = 0; m < 4; ++m) { const int r = row0 + ai * HALF + m * 16; bf16_t* rowp = O + (size_t)r * u.ldc + col0; const float ra = rav[ai][m]; float v[8];
#pragma unroll
                for (int n = 0; n < 2; ++n)
#pragma unroll
                    for (int j = 0; j < 4; ++j) { const float gt = (float)acc[ai][0][m][n][j] * (ra * sg[n * 4 + j]), up = (float)acc[ai][1][m][n][j] * (ra * su[n * 4 + j]); v[n * 4 + j] = gt * __builtin_amdgcn_rcpf(1.0f + __expf(-gt)) * up; }
                u32x4 w; w.x = cvt_pk_bf16(v[0], v[1]); w.y = cvt_pk_bf16(v[2], v[3]); w.z = cvt_pk_bf16(v[4], v[5]); w.w = cvt_pk_bf16(v[6], v[7]);
                *(u32x4*)rowp = w; }
    }
};
struct EpiQKV {
    static constexpr bool PERM = true;
    const f32x2* rope; float qscale; const float* sa0; const float* sb0; const float* sa1; const float* sb1;
    __device__ __forceinline__ void operator()(const i32x4 (&acc)[2][2][4][2], const Unit& u, int wr, int wc, int fr_, int fq_) const {
        int ln_ = threadIdx.x & 63; asm volatile("" : "+v"(ln_)); const int fr = ln_ & 15, fq = ln_ >> 4;
        const int row0 = wr * 64 + fr, col0 = wc * 32 + 8 * fq; bf16_t* O = (bf16_t*)u.O;
        const bool isq = (u.aux == 0); const float sc = isq ? qscale : 1.0f; const bool lat = isq && (u.pm >= 16);
        const float* sa = isq ? sa0 : sa1; const float* sb = isq ? sb0 : sb1;
        int pr[2]; bool rp[2]; float cs_[2][8];
#pragma unroll
        for (int bj = 0; bj < 2; ++bj) { const int c8 = u.pn * BM + bj * HALF + col0, d = c8 % 192; rp[bj] = lat && d >= 128; pr[bj] = (d - 128) >> 1;
            const f32x4 c0 = *(const f32x4*)(sb + c8), c1 = *(const f32x4*)(sb + c8 + 4);
#pragma unroll
            for (int j = 0; j < 4; ++j) { cs_[bj][j] = c0[j] * sc; cs_[bj][4 + j] = c1[j] * sc; } }
        float rav[2][4];
#pragma unroll
        for (int ai = 0; ai < 2; ++ai)
#pragma unroll
            for (int m = 0; m < 4; ++m) rav[ai][m] = sa[u.pm * BM + row0 + ai * HALF + m * 16];
        const bool rpl = rp[0] || rp[1]; const int prl = rp[0] ? pr[0] : pr[1];
#pragma unroll
        for (int ai = 0; ai < 2; ++ai) {
            f32x4 rc[4][2];
            if (rpl) {
#pragma unroll
                for (int m = 0; m < 4; ++m) { const int t = (u.pm * BM + row0 + ai * HALF + m * 16) & 4095; const f32x4* cs = (const f32x4*)(rope + (size_t)t * 32 + prl); rc[m][0] = cs[0]; rc[m][1] = cs[1]; } }
            asm volatile("" ::: "memory");
#pragma unroll
            for (int m = 0; m < 4; ++m) { const int r = row0 + ai * HALF + m * 16; bf16_t* rowp = O + (size_t)r * u.ldc + col0; const float ra = rav[ai][m];
#pragma unroll
                for (int bj = 0; bj < 2; ++bj) { f32x4 v0, v1;
#pragma unroll
                    for (int j = 0; j < 4; ++j) { v0[j] = (float)acc[ai][bj][m][0][j] * (ra * cs_[bj][j]); v1[j] = (float)acc[ai][bj][m][1][j] * (ra * cs_[bj][4 + j]); }
                    if (rp[bj]) { const f32x4 c01 = rc[m][0], c23 = rc[m][1];
                        f32x4 a, b; a[0] = v0[0] * c01[0] - v0[1] * c01[1]; a[1] = v0[0] * c01[1] + v0[1] * c01[0]; a[2] = v0[2] * c01[2] - v0[3] * c01[3]; a[3] = v0[2] * c01[3] + v0[3] * c01[2];
                        b[0] = v1[0] * c23[0] - v1[1] * c23[1]; b[1] = v1[0] * c23[1] + v1[1] * c23[0]; b[2] = v1[2] * c23[2] - v1[3] * c23[3]; b[3] = v1[2] * c23[3] + v1[3] * c23[2]; v0 = a; v1 = b; }
                    u32x4 w; w.x = cvt_pk_bf16(v0[0], v0[1]); w.y = cvt_pk_bf16(v0[2], v0[3]); w.z = cvt_pk_bf16(v1[0], v1[1]); w.w = cvt_pk_bf16(v1[2], v1[3]);
                    *(u32x4*)(rowp + bj * HALF) = w; } } }
    }
};

template <bool I8> struct acc_sel { typedef f32x4 type; }; template <> struct acc_sel<true> { typedef i32x4 type; };
template <class Epi, class Sched, bool ALIGN_EPI = false, bool SP2 = false, bool I8 = false>
__device__ __forceinline__ void gemm_phase(LAS unsigned char* lds, const int K, const int lda, const int ldb, const Sched& S, const Epi& E) {
    const int tid = threadIdx.x, wid = __builtin_amdgcn_readfirstlane(tid >> 6), lane = tid & 63, wr = wid >> 2, wc = wid & 3, fr = lane & 15, fq = lane >> 4;
    const int nt = K / BK;
    unsigned voffA[2], voffB[2];
#pragma unroll
    for (int i = 0; i < 2; ++i) { int R, C; stage_rc(tid * 16 + i * 8192, R, C); const int Rb = Epi::PERM ? ((R & ~31) + perm32(R & 31)) : R;
        voffA[i] = (unsigned)(R * lda + C) * 2u; voffB[i] = (unsigned)(Rb * ldb + C) * 2u; }
    const size_t kstep = (size_t)(BK * 2);
    const size_t hstepA = (size_t)HALF * lda * 2, hstepB = (size_t)HALF * ldb * 2;
    const unsigned ldsw = (unsigned)wid * 1024u;
    const int aoff = lds_byte(wr * 64 + fr, fq * 8), boff = lds_byte(wc * 32 + fr, fq * 8);
#define PG8_SA(b, h) (((b) * 2 + (h)) * HTB)
#define PG8_SB(b, h) ((4 + (b) * 2 + (h)) * HTB)
#define PG8_STAGE(bufoff, gbase, voff) do { _Pragma("unroll") for (int _i = 0; _i < 2; ++_i) \
        __builtin_amdgcn_global_load_lds((const unsigned*)((const char*)(gbase) + (voff)[_i]), (LAS unsigned*)(lds + (bufoff) + ldsw + _i * 8192), 16, 0, 0); } while (0)
#define PG8_LDA(dst, b, h) do { _Pragma("unroll") for (int m = 0; m < 4; ++m) _Pragma("unroll") for (int k = 0; k < 2; ++k) dst[m][k] = *(const LAS bf16x8*)(lds + PG8_SA(b, h) + aoff + m * 2048 + k * 1024); } while (0)
#define PG8_LDB(dst, b, h) do { _Pragma("unroll") for (int n = 0; n < 2; ++n) _Pragma("unroll") for (int k = 0; k < 2; ++k) dst[n][k] = *(const LAS bf16x8*)(lds + PG8_SB(b, h) + boff + n * 2048 + k * 1024); } while (0)
#define PG8_MMA(ai, bj, At, Bt) do { __builtin_amdgcn_s_setprio(1); _Pragma("unroll") for (int m = 0; m < 4; ++m) _Pragma("unroll") for (int n = 0; n < 2; ++n) _Pragma("unroll") for (int k = 0; k < 2; ++k) { \
        if constexpr (I8) acc[ai][bj][m][n] = __builtin_bit_cast(acc_t, __builtin_amdgcn_mfma_i32_16x16x64_i8(__builtin_bit_cast(i32x4, Bt[n][k]), __builtin_bit_cast(i32x4, At[m][k]), __builtin_bit_cast(i32x4, acc[ai][bj][m][n]), 0, 0, 0)); \
        else acc[ai][bj][m][n] = __builtin_bit_cast(acc_t, __builtin_amdgcn_mfma_f32_16x16x32_bf16(Bt[n][k], At[m][k], __builtin_bit_cast(f32x4, acc[ai][bj][m][n]), 0, 0, 0)); } __builtin_amdgcn_s_setprio(0); } while (0)
#define PG8_WAIT_V(n) asm volatile("s_waitcnt vmcnt(" #n ")" ::: "memory")
#define PG8_WAIT_L(n) asm volatile("s_waitcnt lgkmcnt(" #n ")" ::: "memory")
#define PG8_BAR __builtin_amdgcn_s_barrier()
#define PG8_SCHED __builtin_amdgcn_sched_barrier(0)
    Unit cur, nxt; int ui = 0;
    if (!S.next(0, cur)) return;
    typedef typename acc_sel<I8>::type acc_t; acc_t acc[2][2][4][2];
#pragma unroll
    for (int a = 0; a < 2; ++a)
#pragma unroll
        for (int b = 0; b < 2; ++b)
#pragma unroll
            for (int m = 0; m < 4; ++m)
#pragma unroll
                for (int n = 0; n < 2; ++n) acc[a][b][m][n] = acc_t{};
    bf16x8 At[4][2], B0[2][2], B1[2][2];
    const char* cA = cur.A; const char* cB = cur.B;
    if constexpr (SP2) {
        PG8_STAGE(PG8_SB(0, 0), cB, voffB); PG8_STAGE(PG8_SB(0, 1), cB + hstepB, voffB); PG8_STAGE(PG8_SA(0, 0), cA, voffA); PG8_STAGE(PG8_SA(0, 1), cA + hstepA, voffA);
        if (wr == 1) PG8_BAR;
        PG8_WAIT_V(2); PG8_BAR;
        PG8_STAGE(PG8_SB(1, 0), cB + kstep, voffB); PG8_STAGE(PG8_SA(1, 0), cA + kstep, voffA); PG8_STAGE(PG8_SB(1, 1), cB + hstepB + kstep, voffB);
        PG8_WAIT_V(6); PG8_BAR;
    } else {
        PG8_STAGE(PG8_SB(0, 0), cB, voffB); PG8_STAGE(PG8_SA(0, 0), cA, voffA); PG8_STAGE(PG8_SB(0, 1), cB + hstepB, voffB); PG8_STAGE(PG8_SA(0, 1), cA + hstepA, voffA);
        if (wr == 1) PG8_BAR;
        PG8_WAIT_V(4); PG8_BAR;
        PG8_STAGE(PG8_SB(1, 0), cB + kstep, voffB); PG8_STAGE(PG8_SA(1, 0), cA + kstep, voffA); PG8_STAGE(PG8_SB(1, 1), cB + hstepB + kstep, voffB);
        PG8_WAIT_V(6); PG8_BAR;
    }
    for (;;) {
        const bool has_next = S.next(ui + 1, nxt);
        const char* nA = has_next ? nxt.A : cA; const char* nB = has_next ? nxt.B : cB;
        for (int t = 0; t < nt; t += 2) {
            const bool last = (t == nt - 2);
            const char* a1 = cA + (size_t)(t + 1) * kstep;
            const char* a2 = last ? nA : cA + (size_t)(t + 2) * kstep; const char* b2 = last ? nB : cB + (size_t)(t + 2) * kstep;
            const char* a3 = a2 + kstep; const char* b3 = b2 + kstep;
            if constexpr (SP2) {
            PG8_LDB(B0, 0, 0); PG8_LDB(B1, 0, 1); PG8_SCHED; PG8_LDA(At, 0, 0); PG8_STAGE(PG8_SA(1, 1), a1 + hstepA, voffA);
            PG8_WAIT_V(8); PG8_WAIT_L(0); PG8_BAR; PG8_MMA(0, 0, At, B0); PG8_MMA(0, 1, At, B1); PG8_BAR; PG8_SCHED;
            PG8_LDA(At, 0, 1); PG8_STAGE(PG8_SB(0, 0), b2, voffB); PG8_STAGE(PG8_SB(0, 1), b2 + hstepB, voffB); PG8_STAGE(PG8_SA(0, 0), a2, voffA);
            PG8_WAIT_V(8); PG8_WAIT_L(0); PG8_BAR; PG8_MMA(1, 0, At, B0); PG8_MMA(1, 1, At, B1); PG8_BAR; PG8_SCHED;
            PG8_LDB(B0, 1, 0); PG8_LDB(B1, 1, 1); PG8_SCHED; PG8_LDA(At, 1, 0); PG8_STAGE(PG8_SA(0, 1), a2 + hstepA, voffA);
            PG8_WAIT_V(8); PG8_WAIT_L(0); PG8_BAR; PG8_MMA(0, 0, At, B0); PG8_MMA(0, 1, At, B1); PG8_BAR; PG8_SCHED;
            PG8_LDA(At, 1, 1); PG8_STAGE(PG8_SB(1, 0), b3, voffB); PG8_STAGE(PG8_SB(1, 1), b3 + hstepB, voffB); PG8_STAGE(PG8_SA(1, 0), a3, voffA);
            PG8_WAIT_V(8); PG8_WAIT_L(0); PG8_BAR; PG8_MMA(1, 0, At, B0); PG8_MMA(1, 1, At, B1); PG8_BAR; PG8_SCHED;
            } else {
            PG8_LDB(B0, 0, 0); PG8_SCHED; PG8_LDA(At, 0, 0); PG8_STAGE(PG8_SA(1, 1), a1 + hstepA, voffA);
            PG8_WAIT_L(8); PG8_BAR; PG8_WAIT_L(0); PG8_MMA(0, 0, At, B0); PG8_BAR; PG8_SCHED;
            PG8_LDB(B1, 0, 1); PG8_STAGE(PG8_SB(0, 0), b2, voffB);
            PG8_BAR; PG8_WAIT_L(0); PG8_MMA(0, 1, At, B1); PG8_BAR;
            PG8_LDA(At, 0, 1); PG8_STAGE(PG8_SA(0, 0), a2, voffA);
            PG8_BAR; PG8_WAIT_L(0); PG8_MMA(1, 0, At, B0); PG8_BAR; PG8_SCHED;
            PG8_STAGE(PG8_SB(0, 1), b2 + hstepB, voffB);
            PG8_WAIT_V(6); PG8_BAR; PG8_MMA(1, 1, At, B1); PG8_BAR;
            PG8_LDB(B0, 1, 0); PG8_SCHED; PG8_LDA(At, 1, 0); PG8_STAGE(PG8_SA(0, 1), a2 + hstepA, voffA);
            PG8_WAIT_L(8); PG8_BAR; PG8_WAIT_L(0); PG8_MMA(0, 0, At, B0); PG8_BAR; PG8_SCHED;
            PG8_LDB(B1, 1, 1); PG8_STAGE(PG8_SB(1, 0), b3, voffB);
            PG8_BAR; PG8_WAIT_L(0); PG8_MMA(0, 1, At, B1); PG8_BAR;
            PG8_LDA(At, 1, 1); PG8_STAGE(PG8_SA(1, 0), a3, voffA);
            PG8_BAR; PG8_WAIT_L(0); PG8_MMA(1, 0, At, B0); PG8_BAR; PG8_SCHED;
            PG8_STAGE(PG8_SB(1, 1), b3 + hstepB, voffB);
            PG8_WAIT_V(6); PG8_BAR; PG8_MMA(1, 1, At, B1); PG8_BAR;
            }
        }
        if constexpr (ALIGN_EPI) { if (wr == 0) PG8_BAR; }
        E(acc, cur, wr, wc, fr, fq);
        if (!has_next) break;
#pragma unroll
        for (int a = 0; a < 2; ++a)
#pragma unroll
            for (int b = 0; b < 2; ++b)
#pragma unroll
                for (int m = 0; m < 4; ++m)
#pragma unroll
                    for (int n = 0; n < 2; ++n) acc[a][b][m][n] = acc_t{};
        cur = nxt; cA = nA; cB = nB; ++ui;
        if constexpr (ALIGN_EPI) { if (wr == 1) PG8_BAR; }
    }
    PG8_WAIT_V(0);
    if constexpr (!ALIGN_EPI) { if (wr == 0) PG8_BAR; }
    PG8_BAR;
#undef PG8_SA
#undef PG8_SB
#undef PG8_STAGE
#undef PG8_LDA
#undef PG8_LDB
#undef PG8_MMA
#undef PG8_WAIT_V
#undef PG8_WAIT_L
#undef PG8_BAR
#undef PG8_SCHED
}
}

#define XB_TMO      128
#define XB_XCNT(j)  (256  + 64 * (j))
#define XB_XSUB(j)  (1280 + 64 * (j))
#define XB_XGEN(j)  (2304 + 64 * (j))
#define XB_TOP      3328
#define XB_TOPGEN   3392
#define XCD_BAR_WORDS 3456
#define XB_SPIN_CAP (1u << 24)

__device__ __forceinline__ unsigned xb_ld(unsigned* p)              { return __hip_atomic_load(p, __ATOMIC_RELAXED, __HIP_MEMORY_SCOPE_AGENT); }
__device__ __forceinline__ unsigned xb_add(unsigned* p, unsigned v) { return __hip_atomic_fetch_add(p, v, __ATOMIC_RELAXED, __HIP_MEMORY_SCOPE_AGENT); }
__device__ __forceinline__ unsigned xb_xcc_id() { return (unsigned)__builtin_amdgcn_s_getreg((3 << 11) | 20) & 0xFu; }
#define XB_SPIN(cond, bar) do { unsigned _sp = 0; while (cond) { __builtin_amdgcn_s_sleep(1); \
    if ((++_sp & 255u) == 0u) { if (xb_ld(&(bar)[XB_TMO])) break; if (_sp > XB_SPIN_CAP) { atomicAdd(&(bar)[XB_TMO], 1u); break; } } } } while (0)

struct XcdBarrier {
    unsigned* bar; unsigned x;
    volatile LAS unsigned* st;
};
__device__ __forceinline__ XcdBarrier xcd_barrier_post(unsigned* bar, volatile LAS unsigned* st) {
    XcdBarrier b; b.bar = bar; b.x = xb_xcc_id(); b.st = st;
    if (threadIdx.x == 0) (void)xb_add(&bar[XB_XCNT(b.x)], 1u);
    return b;
}
__device__ __forceinline__ void xcd_barrier_complete(unsigned* bar, unsigned x, unsigned& nloc, unsigned& nx) {
    const unsigned G = gridDim.x * gridDim.y * gridDim.z;
    unsigned sum, cnt, mine, sp = 0u;
    for (;;) {
        sum = 0u; cnt = 0u; mine = 0u;
#pragma unroll
        for (unsigned j = 0; j < 16; ++j) { const unsigned c = xb_ld(&bar[XB_XCNT(j)]); sum += c; cnt += (c > 0u) ? 1u : 0u; mine = (j == x) ? c : mine; }
        if (sum == G) break;
        __builtin_amdgcn_s_sleep(1);
        if ((++sp & 255u) == 0u) { if (xb_ld(&bar[XB_TMO])) break; if (sp > XB_SPIN_CAP) { atomicAdd(&bar[XB_TMO], 1u); break; } }
    }
    nloc = mine > 0u ? mine : 1u; nx = cnt > 0u ? cnt : 1u;
}
__device__ __forceinline__ void xcd_barrier(const XcdBarrier& b) {
    asm volatile("s_waitcnt vmcnt(0)" ::: "memory");
    __syncthreads();
    if (threadIdx.x == 0) {
        unsigned* bar = b.bar;
        __builtin_amdgcn_s_waitcnt(0);
        unsigned nloc = b.st[0], nx = b.st[1];
        if (nloc == 0u) { xcd_barrier_complete(bar, b.x, nloc, nx); b.st[0] = nloc; b.st[1] = nx; }
        const unsigned old = xb_add(&bar[XB_XSUB(b.x)], 1u);
        const unsigned gen = old / nloc;
        if (old + 1u == (gen + 1u) * nloc) {
            __builtin_amdgcn_fence(__ATOMIC_RELEASE, "agent");
            asm volatile("s_waitcnt vmcnt(0)" ::: "memory");
            const unsigned og = xb_add(&bar[XB_TOP], 1u);
            const unsigned tg = og / nx;
            if (og + 1u == (tg + 1u) * nx) xb_add(&bar[XB_TOPGEN], 1u);
            else XB_SPIN(xb_ld(&bar[XB_TOPGEN]) == tg, bar);
            __builtin_amdgcn_fence(__ATOMIC_ACQUIRE, "agent");
            xb_add(&bar[XB_XGEN(b.x)], 1u);
            asm volatile("s_waitcnt vmcnt(0)" ::: "memory");
        } else {
            XB_SPIN(xb_ld(&bar[XB_XGEN(b.x)]) == gen, bar);
            __builtin_amdgcn_fence(__ATOMIC_ACQUIRE, "agent");
            asm volatile("s_waitcnt vmcnt(0)" ::: "memory");
        }
    }
    __syncthreads();
}

struct XDesc { int in_idx; long long src_off; int K, N; long long dst; int ldt; int mode; int row_off; };
constexpr int NXD = 28;
__constant__ XDesc c_xd[NXD] = {
    {10, 0LL * 2048 * 5632, 2048, 5632, (long long)(WS_WGU + 0 * SZ_WGU), WGP, 1, 0}, {11, 0LL * 2048 * 5632, 2048, 5632, (long long)(WS_WGU + 0 * SZ_WGU), WGP, 2, 0}, {12, 0LL * 5632 * 2048, 5632, 2048, (long long)(WS_WD + 0 * SZ_WD), AP, 0, 0},
    {10, 1LL * 2048 * 5632, 2048, 5632, (long long)(WS_WGU + 1 * SZ_WGU), WGP, 1, 0}, {11, 1LL * 2048 * 5632, 2048, 5632, (long long)(WS_WGU + 1 * SZ_WGU), WGP, 2, 0}, {12, 1LL * 5632 * 2048, 5632, 2048, (long long)(WS_WD + 1 * SZ_WD), AP, 0, 0},
    {10, 2LL * 2048 * 5632, 2048, 5632, (long long)(WS_WGU + 2 * SZ_WGU), WGP, 1, 0}, {11, 2LL * 2048 * 5632, 2048, 5632, (long long)(WS_WGU + 2 * SZ_WGU), WGP, 2, 0}, {12, 2LL * 5632 * 2048, 5632, 2048, (long long)(WS_WD + 2 * SZ_WD), AP, 0, 0},
    {10, 3LL * 2048 * 5632, 2048, 5632, (long long)(WS_WGU + 3 * SZ_WGU), WGP, 1, 0}, {11, 3LL * 2048 * 5632, 2048, 5632, (long long)(WS_WGU + 3 * SZ_WGU), WGP, 2, 0}, {12, 3LL * 5632 * 2048, 5632, 2048, (long long)(WS_WD + 3 * SZ_WD), AP, 0, 0},
    {13, 0LL * 2048 * 512, 2048, 512, (long long)(WS_W1 + 0 * SZ_W1), 2048, 0, 0}, {16, 0LL * 2048 * 512, 2048, 512, (long long)(WS_W1 + 0 * SZ_W1), 2048, 0, 512}, {18, 0LL * 2048 * 64, 2048, 64, (long long)(WS_W1 + 0 * SZ_W1), 2048, 0, 1024},
    {15, 0LL * 512 * 3072, 512, 3072, (long long)(WS_WUQ + 0 * SZ_WUQ), 512, 0, 0}, {19, 0LL * 512 * 4096, 512, 4096, (long long)(WS_WUKV + 0 * SZ_WUKV), 512, 0, 0}, {20, 0LL * 2048 * 2048, 2048, 2048, (long long)(WS_WO + 0 * SZ_WO), MP, 0, 0},
    {13, 1LL * 2048 * 512, 2048, 512, (long long)(WS_W1 + 1 * SZ_W1), 2048, 0, 0}, {16, 1LL * 2048 * 512, 2048, 512, (long long)(WS_W1 + 1 * SZ_W1), 2048, 0, 512}, {18, 1LL * 2048 * 64, 2048, 64, (long long)(WS_W1 + 1 * SZ_W1), 2048, 0, 1024},
    {15, 1LL * 512 * 3072, 512, 3072, (long long)(WS_WUQ + 1 * SZ_WUQ), 512, 0, 0}, {19, 1LL * 512 * 4096, 512, 4096, (long long)(WS_WUKV + 1 * SZ_WUKV), 512, 0, 0}, {20, 1LL * 2048 * 2048, 2048, 2048, (long long)(WS_WO + 3 * SZ_WO), MP, 0, 0},
    {21, 0, 2048, 6144, (long long)WS_WIN, 2048, 0, 0}, {34, 0, 2048, 2048, (long long)(WS_WO + 1 * SZ_WO), MP, 0, 0}, {31, 0, 64, 8192, (long long)WS_W3, 256, 0, 0},
    {36, 0, 2048, 2048, (long long)(WS_WO + 2 * SZ_WO), MP, 0, 0},
};
__device__ __forceinline__ void transpose_item(const float* W, int ldw, bf16_t* WT, int ldt, int k0, int n0, int drow0, LAS float* scr, int lane) {
    const int lr = lane >> 3, n4 = (lane & 7) * 4; f32x4 v[8];
#pragma unroll
    for (int i = 0; i < 8; ++i) v[i] = __builtin_nontemporal_load((const f32x4*)(W + (size_t)(k0 + 8 * i + lr) * ldw + n0 + n4));
#pragma unroll
    for (int i = 0; i < 8; ++i) { LAS float* d = scr + (8 * i + lr) * 33 + n4; d[0] = v[i][0]; d[1] = v[i][1]; d[2] = v[i][2]; d[3] = v[i][3]; }
    LDS_WAIT(); asm volatile("" ::: "memory");
    const int c = lane & 7;
#pragma unroll
    for (int j = 0; j < 4; ++j) { const int n = (lane >> 3) + 8 * j; const LAS float* s = scr + (8 * c) * 33 + n;
        v4u o; o.x = pk2(s[0 * 33], s[1 * 33]); o.y = pk2(s[2 * 33], s[3 * 33]); o.z = pk2(s[4 * 33], s[5 * 33]); o.w = pk2(s[6 * 33], s[7 * 33]);
        *(GAS v4u*)(WT + (size_t)(drow0 + n) * ldt + k0 + 8 * c) = o; }
    LDS_WAIT(); asm volatile("" ::: "memory");
}

__device__ __forceinline__ void wq_strip_item(const float* W, int K, int ldw, signed char* W8, int pitch, float* wscale, int n0, int drow0, LAS unsigned char* lds, int tid) {
    const int lane = tid & 63, wave = tid >> 6, lr = lane >> 3, n4 = (lane & 7) * 4, nkb = K / 64;
    LAS float* red = (LAS float*)(lds + 131072 - 1024); LAS float* scr = (LAS float*)(lds + wave * 16384);
    float m[4] = {0.f, 0.f, 0.f, 0.f};
    for (int kb = wave; kb < nkb; kb += NWAVES) { f32x4 v[8];
#pragma unroll
        for (int i = 0; i < 8; ++i) v[i] = *(const f32x4*)(W + (size_t)(64 * kb + 8 * i + lr) * ldw + n0 + n4);
#pragma unroll
        for (int i = 0; i < 8; ++i)
#pragma unroll
            for (int e = 0; e < 4; ++e) m[e] = fmaxf(m[e], fabsf(v[i][e])); }
#pragma unroll
    for (int e = 0; e < 4; ++e) { m[e] = fmaxf(m[e], __shfl_xor(m[e], 8)); m[e] = fmaxf(m[e], __shfl_xor(m[e], 16)); m[e] = fmaxf(m[e], __shfl_xor(m[e], 32)); }
    __syncthreads();
    if (lr == 0) {
#pragma unroll
        for (int e = 0; e < 4; ++e) red[wave * 32 + n4 + e] = m[e]; }
    __syncthreads();
    float inv[4];
#pragma unroll
    for (int e = 0; e < 4; ++e) { float cm = 0.f;
#pragma unroll
        for (int w = 0; w < NWAVES; ++w) cm = fmaxf(cm, red[w * 32 + n4 + e]);
        inv[e] = cm > 0.f ? 127.0f / cm : 0.f; if (wave == 0 && lr == 0) wscale[drow0 + n4 + e] = cm * (1.0f / 127.0f); }
    const int c = lane & 7;
    for (int kb = wave; kb < nkb; kb += NWAVES) { f32x4 v[8];
#pragma unroll
        for (int i = 0; i < 8; ++i) v[i] = *(const f32x4*)(W + (size_t)(64 * kb + 8 * i + lr) * ldw + n0 + n4);
#pragma unroll
        for (int i = 0; i < 8; ++i) { LAS float* d = scr + (8 * i + lr) * 33 + n4; d[0] = rintf(v[i][0] * inv[0]); d[1] = rintf(v[i][1] * inv[1]); d[2] = rintf(v[i][2] * inv[2]); d[3] = rintf(v[i][3] * inv[3]); }
        LDS_WAIT(); asm volatile("" ::: "memory");
#pragma unroll
        for (int j = 0; j < 4; ++j) { const int n = (lane >> 3) + 8 * j; const LAS float* s = scr + (8 * c) * 33 + n; unsigned w0 = 0u, w1 = 0u;
#pragma unroll
            for (int t = 0; t < 4; ++t) { w0 |= ((unsigned)(int)s[t * 33] & 0xffu) << (8 * t); w1 |= ((unsigned)(int)s[(4 + t) * 33] & 0xffu) << (8 * t); }
            v2u o; o.x = w0; o.y = w1; *(GAS v2u*)(W8 + (size_t)(drow0 + n) * pitch + 64 * kb + 8 * c) = o; }
        LDS_WAIT(); asm volatile("" ::: "memory"); }
}

struct Args { const float* in[38]; float* out; unsigned char* ws; int ph_lo, ph_hi, li, pad; };
enum { I_XP = 0, I_XS, I_C, I_CCKV, I_CKR, I_CCTX, I_ADAW, I_ADAB, I_LNG, I_LNB, I_FG, I_FU, I_FD, I_DQ, I_QN, I_UQ, I_DKV, I_KVN, I_WKR, I_UKV, I_WOM,
       I_HWIN, I_HBIN, I_HCW, I_HCB, I_HW1, I_HB1, I_HFR1, I_HW2, I_HB2, I_HFR2, I_HW3, I_HDEC, I_HSKIP, I_HWOUT, I_HBOUT, I_FNW, I_FNB };
constexpr size_t OUT_CKV = (size_t)NTOK * D, OUT_KR = OUT_CKV + (size_t)16 * 2 * 256 * 512;

__device__ __forceinline__ int group_of_row(int row) { return row < NCTX ? 0 : (row < NCTX + 4096 ? 1 : 2); }
__device__ __forceinline__ int kvrow_of_row(int row) { return row < NCTX ? row : (row < NCTX + 4096 ? row : row + 512); }

__device__ __forceinline__ void make_dml(unsigned char* ws, size_t gt, size_t NGT) {
    for (size_t i = gt; i < (size_t)2 * 2048 * 512; i += NGT) { const int w = (int)(i >> 20), k = (int)(i >> 9) & 2047, c8 = (int)(i & 511) * 8; float v[8];
#pragma unroll
          for (int j = 0; j < 8; ++j) { const int l = c8 + j, r = (k * l) & 4095; const float tr = (float)r * (1.0f / 4096.0f); v[j] = (w == 0 ? __builtin_amdgcn_cosf(tr) : __builtin_amdgcn_sinf(tr)) * (1.0f / 1024.0f); }
          v4u o; o.x = pk2(v[0], v[1]); o.y = pk2(v[2], v[3]); o.z = pk2(v[4], v[5]); o.w = pk2(v[6], v[7]); *(GAS v4u*)(ws + WS_DML + i * 16) = o; }
}
__device__ __forceinline__ void convert_weights(const Args& a, int d0, int d1, int w, int nw, LAS float* scr, int lane) {
    for (int d = d0; d < d1; ++d) {
        const XDesc x = c_xd[d]; const float* W = a.in[x.in_idx] + x.src_off; bf16_t* WT = (bf16_t*)(a.ws + x.dst); const int nnb = x.N / 32, items = (x.K / 64) * nnb;
        for (int it = w; it < items; it += nw) { const int kb = it / nnb, nb = it - kb * nnb, n0 = 32 * nb;
            const int drow0 = x.mode == 0 ? x.row_off + n0 : ((n0 >> 7) * 256 + (n0 & 127) + (x.mode == 2 ? 128 : 0));
            transpose_item(W, x.N, WT, x.ldt, 64 * kb, n0, drow0, scr, lane); }
    }
}
__device__ __forceinline__ void ffn_w8(const Args& a, int l, int w, int nwg, LAS unsigned char* lds, int tid) {
    float* wscale = (float*)(a.ws + WS_WSC) + (size_t)l * 11264; signed char* W8 = (signed char*)(a.ws + WS_WGU + (size_t)l * SZ_WGU);
    for (int it = w; it < 352; it += nwg) { const int d = 3 * l + (it >= 176), nb = it >= 176 ? it - 176 : it, n0 = 32 * nb; const XDesc x = c_xd[d];
        const int drow0 = (n0 >> 7) * 256 + (n0 & 127) + (x.mode == 2 ? 128 : 0);
        wq_strip_item(a.in[x.in_idx] + x.src_off, x.K, x.N, W8, WGP8, wscale, n0, drow0, lds, tid); }
    __syncthreads();
}
__device__ __forceinline__ v2u quant_row512(const float (&x)[8], float& scale) {
    float m = 0.f;
#pragma unroll
    for (int e = 0; e < 8; ++e) m = fmaxf(m, fabsf(x[e]));
#pragma unroll
    for (int o = 1; o < 64; o <<= 1) m = fmaxf(m, __shfl_xor(m, o));
    const float inv = m > 0.f ? 127.0f / m : 0.f; scale = m * (1.0f / 127.0f); unsigned w0 = 0u, w1 = 0u;
#pragma unroll
    for (int t = 0; t < 4; ++t) { w0 |= ((unsigned)(int)rintf(x[t] * inv) & 0xffu) << (8 * t); w1 |= ((unsigned)(int)rintf(x[4 + t] * inv) & 0xffu) << (8 * t); }
    v2u o; o.x = w0; o.y = w1; return o;
}
__device__ __forceinline__ void wq_desc(const Args& a, int d, signed char* W8, int pitch, float* wscale, int w, int nwg, LAS unsigned char* lds, int tid) {
    const XDesc x = c_xd[d];
    for (int it = w; it < x.N / 32; it += nwg) wq_strip_item(a.in[x.in_idx] + x.src_off, x.K, x.N, W8, pitch, wscale, 32 * it, x.row_off + 32 * it, lds, tid);
    __syncthreads();
}
__device__ __forceinline__ void p0_prologue(const Args& a, LAS unsigned char* lds, int tid, int lane, int wave, int vcu, int G) {
    unsigned char* ws = a.ws;
    const int gw = vcu * NWAVES + wave, NGW = G * NWAVES; const size_t gt = (size_t)vcu * NTHREADS + tid, NGT = (size_t)G * NTHREADS;
    { LAS float* scr = (LAS float*)(lds + wave * 16384);
      convert_weights(a, 2, 3, gw, NGW, scr, lane);
      convert_weights(a, 12, 15, gw, NGW, scr, lane); convert_weights(a, 17, 18, gw, NGW, scr, lane);
      convert_weights(a, 24, 27, gw, NGW, scr, lane); }
    { const v4u z = {0u, 0u, 0u, 0u};
      for (size_t i = gt; i < (size_t)2 * 192 * 256; i += NGT) { const int j = (int)(i / (192 * 256)); const size_t r = i % (192 * 256); *(GAS v4u*)(ws + WS_W1 + j * SZ_W1 + (size_t)1088 * 2048 * 2 + r * 16) = z; }
      for (size_t i = gt; i < (size_t)8192 * 24; i += NGT) { const size_t row = i / 24, ch = i % 24; *(GAS v4u*)(ws + WS_W3 + row * 512 + 128 + ch * 16) = z; } }
    { for (size_t i = gt; i < (size_t)512 * 32; i += NGT) { const int row = (int)(i >> 5), c8 = (int)(i & 31) * 8, part = row >> 8, m = row & 255; float v[8];
#pragma unroll
          for (int j = 0; j < 8; ++j) { const int r = (m * (c8 + j)) & 255; float s, c; sincospif((float)r * (1.0f / 128.0f), &s, &c); v[j] = part ? s : c; }
          v4u o; o.x = pk2(v[0], v[1]); o.y = pk2(v[2], v[3]); o.z = pk2(v[4], v[5]); o.w = pk2(v[6], v[7]); *(GAS v4u*)(ws + WS_DFTC + i * 16) = o; }
      for (size_t i = gt; i < (size_t)256 * 64; i += NGT) { const int k = (int)(i >> 6), c8 = (int)(i & 63) * 8; float v[8];
#pragma unroll
          for (int j = 0; j < 8; ++j) { const int col = c8 + j, l = col & 255, r = (k * l) & 255; float s, c; sincospif((float)r * (1.0f / 128.0f), &s, &c); v[j] = (col < 256 ? c : -s) * (1.0f / 256.0f); }
          v4u o; o.x = pk2(v[0], v[1]); o.y = pk2(v[2], v[3]); o.z = pk2(v[4], v[5]); o.w = pk2(v[6], v[7]); *(GAS v4u*)(ws + WS_DMC + i * 16) = o; }
      }
    { f32x2* rope = (f32x2*)(ws + WS_ROPE);
      for (size_t i = gt; i < (size_t)4096 * 32; i += NGT) { const int t = (int)(i >> 5), p = (int)(i & 31); const float inv = exp2f(-(float)(p & 15) * (13.287712379549449f / 16.0f));
          const float ang = (float)(p < 16 ? (t >> 6) : (t & 63)) * inv; float s, c; sincosf(ang, &s, &c); rope[i] = (f32x2){c, s}; } }
    { for (int it = gw; it < 2 * 2 * 512; it += NGW) { const int p = it & 511, lb = (it >> 9) & 1, j = it >> 10; const int kvr = 4096 + lb * 4608 + 4096 + p;
          const float* s = a.in[I_CCKV] + ((size_t)(lb * 2 + j) * 512 + p) * 512 + 8 * lane; const f32x4 x0 = *(const f32x4*)s, x1 = *(const f32x4*)(s + 4);
          const float x[8] = {x0[0], x0[1], x0[2], x0[3], x1[0], x1[1], x1[2], x1[3]}; float sc; const v2u o = quant_row512(x, sc);
          *(GAS v2u*)(ws + WS_CKVN + (size_t)j * NKV * QP8 + (size_t)kvr * QP8 + 8 * lane) = o; if (lane == 0) ((float*)(ws + WS_KSC))[(size_t)j * NKV + kvr] = sc; }
      for (size_t i = gt; i < (size_t)2 * 2 * 512 * 8; i += NGT) { const int r8 = (int)(i & 7) * 8, p = (int)(i >> 3) & 511, lb = (int)(i >> 12) & 1, j = (int)(i >> 13);
          const float* s = a.in[I_CKR] + ((size_t)(lb * 2 + j) * 512 + p) * 64 + r8; const f32x4 x0 = *(const f32x4*)s, x1 = *(const f32x4*)(s + 4);
          v4u o; o.x = pk2(x0[0], x0[1]); o.y = pk2(x0[2], x0[3]); o.z = pk2(x1[0], x1[1]); o.w = pk2(x1[2], x1[3]);
          *(GAS v4u*)(ws + WS_KR + (size_t)j * al256((size_t)NKV * 64 * 2) + ((size_t)(4096 + lb * 4608 + 4096 + p) * 64 + r8) * 2) = o; } }
    { const float* w1 = a.in[I_HW1]; const float* w2 = a.in[I_HW2]; bf16_t* hf2 = (bf16_t*)(ws + WS_HF2);
      const float b1 = a.in[I_HB1][lane], fr1 = a.in[I_HFR1][lane], b2 = a.in[I_HB2][lane], fr2 = a.in[I_HFR2][lane];
      for (int pos = gw; pos < FILT_LD; pos += NGW) { const int L = pos < 4096 ? 4096 : 256, t = pos < 4096 ? pos : pos - 4096;
          float feat = 0.f;
          if (lane == 0) feat = (float)t / (float)(L - 1);
          else if (lane <= 32) { const int b = (lane - 1) & 15; const float band = 1e-4f + (float)b * ((15.0f - 1e-4f) / 15.0f); const float turns = (float)t * band / (float)L; float s, c; sincospif(2.0f * turns, &s, &c); feat = lane <= 16 ? c : -s; }
          float z = b1;
#pragma unroll
          for (int k = 0; k < 33; ++k) z += __shfl(feat, k) * w1[k * 64 + lane];
          const float h1 = sinf(fr1 * z); float z2 = b2;
#pragma unroll 8
          for (int k = 0; k < 64; ++k) z2 += __shfl(h1, k) * w2[k * 64 + lane];
          const float h2 = sinf(fr2 * z2);
          bf16_t* row = hf2 + (size_t)pos * 256; row[lane] = (bf16_t)f2bf(h2); row[64 + lane] = 0; row[128 + lane] = 0; row[192 + lane] = 0; } }
    __syncthreads();
    ffn_w8(a, 0, vcu, G, lds, tid);
    wq_desc(a, 15, (signed char*)(ws + WS_WUQ), QP8, (float*)(ws + WS_WUQSC), vcu, G, lds, tid); wq_desc(a, 16, (signed char*)(ws + WS_WUKV), QP8, (float*)(ws + WS_WUKVSC), vcu, G, lds, tid);
    __syncthreads();
    { LAS float* S = (LAS float*)lds; LAS float* red = (LAS float*)(lds + 24576); float* mod = (float*)(ws + WS_MOD);
      for (int i = tid; i < 3 * 2048; i += NTHREADS) { const int g = i >> 11, k = i & 2047; const float x = g == 0 ? a.in[I_CCTX][k] : a.in[I_C][(g - 1) * 2048 + k]; S[i] = x / (1.0f + __expf(-x)); }
      __syncthreads();
      const int q = tid & 15, kc = tid >> 4;
      for (int it = vcu; it < 768; it += G) { const int l = it / 192, n0 = (it % 192) * 64;
          const float* Wp = a.in[I_ADAW] + (size_t)l * 2048 * 12288 + (size_t)(kc * 64) * 12288 + n0 + 4 * q;
          f32x4 a0 = {0.f, 0.f, 0.f, 0.f}, a1 = a0, a2 = a0;
#pragma unroll 8
          for (int kk = 0; kk < 64; ++kk) { const f32x4 w = __builtin_nontemporal_load((const f32x4*)(Wp + (size_t)kk * 12288));     const int k = kc * 64 + kk; a0 += w * S[k]; a1 += w * S[2048 + k]; a2 += w * S[4096 + k]; }
#pragma unroll
          for (int j = 0; j < 4; ++j) { red[(kc * 3 + 0) * 64 + 4 * q + j] = a0[j]; red[(kc * 3 + 1) * 64 + 4 * q + j] = a1[j]; red[(kc * 3 + 2) * 64 + 4 * q + j] = a2[j]; }
          __syncthreads();
          if (tid < 192) { const int g = tid >> 6, col = tid & 63; float s = a.in[I_ADAB][l * 12288 + n0 + col];
#pragma unroll 8
              for (int k2 = 0; k2 < 32; ++k2) s += red[(k2 * 3 + g) * 64 + col];
              mod[(size_t)(l * 3 + g) * 12288 + n0 + col] = s; }
          __syncthreads(); } }
}

__device__ __forceinline__ void p1_embed(const Args& a, int lane, int wave, int vcu, int G) {
    unsigned char* ws = a.ws; const float* mod = (const float*)(ws + WS_MOD); bf16_t* H = (bf16_t*)(ws + WS_H); bf16_t* U = (bf16_t*)(ws + WS_U);
    for (int row = vcu * NWAVES + wave; row < NTOK; row += G * NWAVES) {
        const float* x = row < NCTX ? a.in[I_XP] + (size_t)row * D : a.in[I_XS] + (size_t)(row - NCTX) * D; const int g = group_of_row(row);
        const float* sh = mod + (size_t)(0 * 3 + g) * 12288 + 0 * 2048; const float* sc = sh + 2048;
#pragma unroll
        for (int j = 0; j < 4; ++j) { const int c = 512 * j + 8 * lane; float v[8], u[8];
#pragma unroll
            for (int h = 0; h < 2; ++h) { const f32x4 xv = *(const f32x4*)(x + c + 4 * h), s1 = *(const f32x4*)(sc + c + 4 * h), s0 = *(const f32x4*)(sh + c + 4 * h);
#pragma unroll
                for (int e = 0; e < 4; ++e) { v[4 * h + e] = xv[e]; u[4 * h + e] = xv[e] * (1.0f + s1[e]) + s0[e]; } }
            v4u o; o.x = pk2(v[0], v[1]); o.y = pk2(v[2], v[3]); o.z = pk2(v[4], v[5]); o.w = pk2(v[6], v[7]); *(GAS v4u*)(H + (size_t)row * D + c) = o;
            o.x = pk2(u[0], u[1]); o.y = pk2(u[2], u[3]); o.z = pk2(u[4], u[5]); o.w = pk2(u[6], u[7]); *(GAS v4u*)(U + (size_t)row * UP + c) = o; }
    }
}

__device__ __forceinline__ void ln_phase(const Args& a, LAS unsigned char* lds, int tid, int lane, int wave, int vcu, int G, int l, int gi, int lni, const float* bias, int ln, int si, bool final) {
    unsigned char* ws = a.ws; const float* mod = (const float*)(ws + WS_MOD); bf16_t* H = (bf16_t*)(ws + WS_H); bf16_t* U = (bf16_t*)(ws + WS_U);
    const bf16_t* P0 = (const bf16_t*)(ws + WS_PART); const bf16_t* P1 = P0 + (size_t)NTOK * D;
    LAS float* V = (LAS float*)lds;
    LAS unsigned char* rb = lds + (wave < 6 ? 49152 + wave * 12288 : LDSCTL_OFF + 2048 + (wave - 6) * 12288);
#define LN_DMA_ROW(r_) do { const size_t ro_ = (size_t)(r_) * D + 8 * lane; _Pragma("unroll") for (int j_ = 0; j_ < 4; ++j_) { \
        __builtin_amdgcn_global_load_lds((const unsigned*)(H + ro_ + 512 * j_), (LAS unsigned*)(rb + j_ * 1024), 16, 0, 0); \
        __builtin_amdgcn_global_load_lds((const unsigned*)(P0 + ro_ + 512 * j_), (LAS unsigned*)(rb + 4096 + j_ * 1024), 16, 0, 0); \
        __builtin_amdgcn_global_load_lds((const unsigned*)(P1 + ro_ + 512 * j_), (LAS unsigned*)(rb + 8192 + j_ * 1024), 16, 0, 0); } } while (0)
    for (int blk = vcu; blk < NTOK / 48; blk += G)
    for (int seg = 0; seg < 2; ++seg) {
        const int r0b = blk * 48, g0 = group_of_row(r0b), g1 = group_of_row(r0b + 47), g = seg == 0 ? g0 : g1;
        const int split = g0 == g1 ? r0b + 48 : (g0 == 0 ? NCTX : NCTX + 4096);
        const int rs = seg == 0 ? r0b : split, re = seg == 0 ? split : r0b + 48;
        if (rs >= re) continue;
        if (rs + wave < re) LN_DMA_ROW(rs + wave);
        __syncthreads();
        { const int c = 4 * tid; const f32x4 z4 = {0.f, 0.f, 0.f, 0.f};
          const f32x4 v0 = *(const f32x4*)(mod + (size_t)(l * 3 + g) * 12288 + gi * 2048 + c), v1 = bias ? *(const f32x4*)(bias + c) : z4;
          const f32x4 v2 = *(const f32x4*)(a.in[I_LNG] + (l * 2 + lni) * 2048 + c), v3 = *(const f32x4*)(a.in[I_LNB] + (l * 2 + lni) * 2048 + c);
          const f32x4 v4 = final ? z4 : *(const f32x4*)(mod + (size_t)(ln * 3 + g) * 12288 + si * 2048 + c), v5 = final ? z4 : *(const f32x4*)(mod + (size_t)(ln * 3 + g) * 12288 + (si + 1) * 2048 + c);
          *(LAS f32x4*)(V + c) = v0; *(LAS f32x4*)(V + 2048 + c) = v1; *(LAS f32x4*)(V + 2 * 2048 + c) = v2; *(LAS f32x4*)(V + 3 * 2048 + c) = v3; *(LAS f32x4*)(V + 4 * 2048 + c) = v4; *(LAS f32x4*)(V + 5 * 2048 + c) = v5; }
        __syncthreads();
#pragma unroll 1
        for (int row = rs + wave; row < re; row += NWAVES) { float x[32]; float s = 0.f;
            v4u hv[4], pa[4], pb[4];
            if (lni == 0) asm volatile("s_waitcnt vmcnt(9)" ::: "memory"); else asm volatile("s_waitcnt vmcnt(8)" ::: "memory");
#pragma unroll
            for (int j = 0; j < 4; ++j) { hv[j] = *(const LAS v4u*)(rb + j * 1024 + lane * 16); pa[j] = *(const LAS v4u*)(rb + 4096 + j * 1024 + lane * 16); pb[j] = *(const LAS v4u*)(rb + 8192 + j * 1024 + lane * 16); }
            LDS_WAIT();
            if (row + NWAVES < re) LN_DMA_ROW(row + NWAVES);
            asm volatile("" ::: "memory");
#pragma unroll
            for (int j = 0; j < 4; ++j) { const int c = 512 * j + 8 * lane; const unsigned hw[4] = {hv[j].x, hv[j].y, hv[j].z, hv[j].w}, aw[4] = {pa[j].x, pa[j].y, pa[j].z, pa[j].w}, bw[4] = {pb[j].x, pb[j].y, pb[j].z, pb[j].w};
#pragma unroll
                for (int h = 0; h < 2; ++h) { const f32x4 gt = *(const LAS f32x4*)(V + c + 4 * h), bs = *(const LAS f32x4*)(V + 2048 + c + 4 * h);
#pragma unroll
                    for (int e = 0; e < 4; ++e) { const int wi = 2 * h + (e >> 1); const float hh = (e & 1) ? bfhi(hw[wi]) : bflo(hw[wi]), p0 = (e & 1) ? bfhi(aw[wi]) : bflo(aw[wi]), p1 = (e & 1) ? bfhi(bw[wi]) : bflo(bw[wi]);
                        const float v = DN_ALPHA * hh + gt[e] * (p0 + p1 + bs[e]); x[8 * j + 4 * h + e] = v; s += v; } }
                asm volatile("" ::: "memory"); }
            const float mean = wave_sum(s) * (1.0f / D); float q = 0.f;
#pragma unroll
            for (int i = 0; i < 32; ++i) { x[i] -= mean; q += x[i] * x[i]; }
            const float rstd = 1.0f / sqrtf(wave_sum(q) * (1.0f / D) + LN_EPS);
            if (lni == 0) {
                float um = 0.f;
#pragma unroll
                for (int j = 0; j < 4; ++j) { const int c = 512 * j + 8 * lane; float hn[8];
#pragma unroll
                    for (int h = 0; h < 2; ++h) { const f32x4 lg = *(const LAS f32x4*)(V + 2 * 2048 + c + 4 * h), lb = *(const LAS f32x4*)(V + 3 * 2048 + c + 4 * h), sh = *(const LAS f32x4*)(V + 4 * 2048 + c + 4 * h), sc = *(const LAS f32x4*)(V + 5 * 2048 + c + 4 * h);
#pragma unroll
                        for (int e = 0; e < 4; ++e) { hn[4 * h + e] = x[8 * j + 4 * h + e] * rstd * lg[e] + lb[e]; const float uu = hn[4 * h + e] * (1.0f + sc[e]) + sh[e]; x[8 * j + 4 * h + e] = uu; um = fmaxf(um, fabsf(uu)); } }
                    v4u o; o.x = pk2(hn[0], hn[1]); o.y = pk2(hn[2], hn[3]); o.z = pk2(hn[4], hn[5]); o.w = pk2(hn[6], hn[7]); *(GAS v4u*)(H + (size_t)row * D + c) = o;
                    asm volatile("" ::: "memory"); }
#pragma unroll
                for (int o = 1; o < 64; o <<= 1) um = fmaxf(um, __shfl_xor(um, o));
                const float qinv = um > 0.f ? 127.0f / um : 0.f; if (lane == 0) ((float*)(ws + WS_USC))[row] = um * (1.0f / 127.0f);
#pragma unroll
                for (int j = 0; j < 4; ++j) { unsigned w0 = 0u, w1 = 0u;
#pragma unroll
                    for (int t = 0; t < 4; ++t) { w0 |= ((unsigned)(int)rintf(x[8 * j + t] * qinv) & 0xffu) << (8 * t); w1 |= ((unsigned)(int)rintf(x[8 * j + 4 + t] * qinv) & 0xffu) << (8 * t); }
                    v2u o; o.x = w0; o.y = w1; *(GAS v2u*)(ws + WS_U8 + (size_t)row * UP8 + 512 * j + 8 * lane) = o; }
            } else
#pragma unroll
            for (int j = 0; j < 4; ++j) { const int c = 512 * j + 8 * lane; float hn[8], u[8];
#pragma unroll
                for (int h = 0; h < 2; ++h) { const f32x4 lg = *(const LAS f32x4*)(V + 2 * 2048 + c + 4 * h), lb = *(const LAS f32x4*)(V + 3 * 2048 + c + 4 * h), sh = *(const LAS f32x4*)(V + 4 * 2048 + c + 4 * h), sc = *(const LAS f32x4*)(V + 5 * 2048 + c + 4 * h);
#pragma unroll
                    for (int e = 0; e < 4; ++e) { hn[4 * h + e] = x[8 * j + 4 * h + e] * rstd * lg[e] + lb[e]; u[4 * h + e] = hn[4 * h + e] * (1.0f + sc[e]) + sh[e]; } }
                if (final) { float* o = a.out + (size_t)row * D + c; *(f32x4*)o = (f32x4){hn[0], hn[1], hn[2], hn[3]}; *(f32x4*)(o + 4) = (f32x4){hn[4], hn[5], hn[6], hn[7]}; }
                else { v4u o; o.x = pk2(hn[0], hn[1]); o.y = pk2(hn[2], hn[3]); o.z = pk2(hn[4], hn[5]); o.w = pk2(hn[6], hn[7]); *(GAS v4u*)(H + (size_t)row * D + c) = o;
                    o.x = pk2(u[0], u[1]); o.y = pk2(u[2], u[3]); o.z = pk2(u[4], u[5]); o.w = pk2(u[6], u[7]); *(GAS v4u*)(U + (size_t)row * UP + c) = o; }
                asm volatile("" ::: "memory"); }
        }
    }
    __syncthreads();
}

struct MlaRowIn { v4u a0, b0; unsigned short krw; f32x2 cs; };
__device__ __forceinline__ void mla_norm_phase(const Args& a, int lane, int wave, int vcu, int G, int j) {
    unsigned char* ws = a.ws; const bf16_t* T1 = (const bf16_t*)(ws + WS_T1); unsigned char* QL = ws + WS_QL;
    unsigned char* CK = ws + WS_CKVN + (size_t)j * NKV * QP8; float* qsc = (float*)(ws + WS_QSC); float* ksc = (float*)(ws + WS_KSC) + (size_t)j * NKV; bf16_t* KR = (bf16_t*)(ws + WS_KR + (size_t)j * al256((size_t)NKV * 64 * 2)); const f32x2* rope = (const f32x2*)(ws + WS_ROPE);
    const float* qn = a.in[I_QN] + j * 512 + 8 * lane; const float* kn = a.in[I_KVN] + j * 512 + 8 * lane;
    float qnv[8], knv[8];
#pragma unroll
    for (int e = 0; e < 8; ++e) { qnv[e] = qn[e]; knv[e] = kn[e]; }
    auto load_row = [&](int row, MlaRowIn& in) { const bf16_t* t = T1 + (size_t)row * 1280; in.a0 = *(const GAS v4u*)(t + 8 * lane); in.b0 = *(const GAS v4u*)(t + 512 + 8 * lane); in.krw = t[1024 + lane];
        in.cs = row >= NCTX ? rope[(size_t)((row - NCTX) & 4095) * 32 + (lane >> 1)] : (f32x2){1.f, 0.f}; };
    auto proc_row = [&](int row, const MlaRowIn& in) {
        const int kvr = kvrow_of_row(row);
        float q[8], k[8]; float sq = 0.f, sk = 0.f;
        { const unsigned aw[4] = {in.a0.x, in.a0.y, in.a0.z, in.a0.w}, bw[4] = {in.b0.x, in.b0.y, in.b0.z, in.b0.w};
#pragma unroll
          for (int e = 0; e < 4; ++e) { q[2 * e] = bflo(aw[e]); q[2 * e + 1] = bfhi(aw[e]); k[2 * e] = bflo(bw[e]); k[2 * e + 1] = bfhi(bw[e]); } }
#pragma unroll
        for (int e = 0; e < 8; ++e) { sq += q[e] * q[e]; sk += k[e] * k[e]; }
        const float rq = 1.0f / sqrtf(wave_sum(sq) * (1.0f / 512.0f) + RMS_EPS), rk = 1.0f / sqrtf(wave_sum(sk) * (1.0f / 512.0f) + RMS_EPS);
#pragma unroll
        for (int e = 0; e < 8; ++e) { q[e] = q[e] * rq * qnv[e]; k[e] = k[e] * rk * knv[e]; }
        { float s0, s1; const v2u oq = quant_row512(q, s0), ok = quant_row512(k, s1);
          *(GAS v2u*)(QL + (size_t)row * QP8 + 8 * lane) = oq; *(GAS v2u*)(CK + (size_t)kvr * QP8 + 8 * lane) = ok; if (lane == 0) { qsc[row] = s0; ksc[kvr] = s1; } }
        float kr = bf2f(in.krw);
        if (row < NCTX) { const int b = row >> 8, tt = row & 255; float* oc = a.out + OUT_CKV + ((size_t)(b * 2 + j) * 256 + tt) * 512 + 8 * lane;
            *(f32x4*)oc = (f32x4){k[0], k[1], k[2], k[3]}; *(f32x4*)(oc + 4) = (f32x4){k[4], k[5], k[6], k[7]};
            a.out[OUT_KR + ((size_t)(b * 2 + j) * 256 + tt) * 64 + lane] = kr; }
        else { const float other = __shfl_xor(kr, 1);
            kr = (lane & 1) ? (other * in.cs[1] + kr * in.cs[0]) : (kr * in.cs[0] - other * in.cs[1]); }
        KR[(size_t)kvr * 64 + lane] = (bf16_t)f2bf(kr); };
    const int gw = vcu * NWAVES + wave, NGW = G * NWAVES;
    for (int row = gw; row < NTOK; row += 3 * NGW) { MlaRowIn r0, r1, r2; const int rb = row + NGW, rc = row + 2 * NGW;
        load_row(row, r0); if (rb < NTOK) load_row(rb, r1); if (rc < NTOK) load_row(rc, r2);
        asm volatile("" ::: "memory");
        proc_row(row, r0); if (rb < NTOK) proc_row(rb, r1); if (rc < NTOK) proc_row(rc, r2); }
}

__device__ __forceinline__ void attn_naive_phase(const Args& a, int lane, int wave, int vcu, int G, int j) {
    unsigned char* ws = a.ws; const bf16_t* Q = (const bf16_t*)(ws + WS_Q); const bf16_t* KV = (const bf16_t*)(ws + WS_KV);
    const bf16_t* KR = (const bf16_t*)(ws + WS_KR + (size_t)j * al256((size_t)NKV * 64 * 2)); bf16_t* O = (bf16_t*)(ws + WS_MIXO);
    for (int pair = vcu * NWAVES + wave; pair < NTOK * 16; pair += G * NWAVES) {
        const int row = pair >> 4, h = pair & 15; int kv0, nk;
        if (row < NCTX) { kv0 = (row >> 8) * 256; nk = 256; } else { const int lb = (row - NCTX) >> 12; kv0 = 4096 + lb * 4608; nk = 4608; }
        const bf16_t* qp = Q + (size_t)row * 3072 + h * 192; const float q0 = bf2f(qp[lane]), q1 = bf2f(qp[64 + lane]), q2 = bf2f(qp[128 + lane]);
        float m = -1e30f, l = 0.f, o0 = 0.f, o1 = 0.f;
        for (int key = 0; key < nk; key += 4) { float s[4], v0[4], v1[4];
#pragma unroll
            for (int u = 0; u < 4; ++u) { const bf16_t* kp = KV + (size_t)(kv0 + key + u) * 4096 + h * 256;
                s[u] = q0 * bf2f(kp[lane]) + q1 * bf2f(kp[64 + lane]) + q2 * bf2f(KR[(size_t)(kv0 + key + u) * 64 + lane]); v0[u] = bf2f(kp[128 + lane]); v1[u] = bf2f(kp[192 + lane]); }
#pragma unroll
            for (int u = 0; u < 4; ++u) s[u] = wave_sum(s[u]);
#pragma unroll
            for (int u = 0; u < 4; ++u) { const float mn = fmaxf(m, s[u]), al = exp2f(m - mn), p = exp2f(s[u] - mn); l = l * al + p; o0 = o0 * al + p * v0[u]; o1 = o1 * al + p * v1[u]; m = mn; }
        }
        const float il = 1.0f / l; O[(size_t)row * MP + h * 128 + lane] = (bf16_t)f2bf(o0 * il); O[(size_t)row * MP + h * 128 + 64 + lane] = (bf16_t)f2bf(o1 * il);
    }
}

__device__ __forceinline__ void fnet_combine_phase(const Args& a, int tid, int lane, int wave, int vcu, int G) {
    unsigned char* ws = a.ws; const bf16_t* PQ = (const bf16_t*)(ws + WS_PQ); bf16_t* F = (bf16_t*)(ws + WS_MIXO); const bf16_t* ATL = (const bf16_t*)(ws + WS_ATL);
    const size_t gt = (size_t)vcu * NTHREADS + tid, NGT = (size_t)G * NTHREADS;
    for (size_t i = gt; i < (size_t)2 * 2048 * 256; i += NGT) { const int c8 = (int)(i & 255) * 8, k = (int)(i >> 8) & 2047, lb = (int)(i >> 19);
        const v4u pv = *(const GAS v4u*)(PQ + ((size_t)(0 * 2 + lb) * 2048 + k) * 2048 + c8), qv = *(const GAS v4u*)(PQ + ((size_t)(1 * 2 + lb) * 2048 + k) * 2048 + c8);
        const unsigned pw[4] = {pv.x, pv.y, pv.z, pv.w}, qw[4] = {qv.x, qv.y, qv.z, qv.w}; v4u lo, hi; unsigned lw[4], hw[4];
#pragma unroll
        for (int e = 0; e < 4; ++e) { const float p0 = bflo(pw[e]), p1 = bfhi(pw[e]), q0 = bflo(qw[e]), q1 = bfhi(qw[e]); lw[e] = pk2(p0 - q0, p1 - q1); hw[e] = pk2(p0 + q0, p1 + q1); }
        lo.x = lw[0]; lo.y = lw[1]; lo.z = lw[2]; lo.w = lw[3]; hi.x = hw[0]; hi.y = hw[1]; hi.z = hw[2]; hi.w = hw[3];
        bf16_t* base = F + (size_t)(NCTX + lb * 4096) * MP + c8;
        *(GAS v4u*)(base + (size_t)k * MP) = lo; if (k > 0) *(GAS v4u*)(base + (size_t)(4096 - k) * MP) = hi; }
    for (int it = vcu * NWAVES + wave; it < 2 * 2048; it += G * NWAVES) { const int lb = it >> 11, ch = it & 2047; const bf16_t* row = ATL + ((size_t)lb * 2048 + ch) * 8192; float s = 0.f;
#pragma unroll
        for (int j = 0; j < 8; ++j) { const v4u x = *(const GAS v4u*)(row + (j * 64 + lane) * 8); s += (bflo(x.x) - bfhi(x.x)) + (bflo(x.y) - bfhi(x.y)) + (bflo(x.z) - bfhi(x.z)) + (bflo(x.w) - bfhi(x.w)); }
        s = wave_sum(s); if (lane == 0) F[(size_t)(NCTX + lb * 4096 + 2048) * MP + ch] = (bf16_t)f2bf(s * (1.0f / 1024.0f)); }
}

__device__ __forceinline__ void transpose_zt_phase(const Args& a, LAS unsigned char* lds, int lane, int wave, int vcu, int G) {
    const bf16_t* ZT = (const bf16_t*)(a.ws + WS_ZT); bf16_t* Z = (bf16_t*)(a.ws + WS_MIXO); LAS bf16_t* scr = (LAS bf16_t*)(lds + wave * 16384);
    const int ch8 = lane & 7, r8 = lane >> 3;
    for (int tile = vcu * NWAVES + wave; tile < 32 * 192; tile += G * NWAVES) { const int c0 = (tile / 192) * 64, t0 = (tile % 192) * 64;
        v4u x[8];
#pragma unroll
        for (int i = 0; i < 8; ++i) x[i] = *(const GAS v4u*)(ZT + (size_t)(c0 + r8 + 8 * i) * NTOK + t0 + 8 * ch8);
#pragma unroll
        for (int i = 0; i < 8; ++i) { LAS unsigned* d = (LAS unsigned*)(scr + (r8 + 8 * i) * 66 + 8 * ch8); d[0] = x[i].x; d[1] = x[i].y; d[2] = x[i].z; d[3] = x[i].w; }
        LDS_WAIT(); asm volatile("" ::: "memory");
#pragma unroll
        for (int j = 0; j < 8; ++j) { const int t = r8 + 8 * j; const LAS bf16_t* s = scr + (8 * ch8) * 66 + t;
            v4u o; o.x = (unsigned)s[0] | ((unsigned)s[66] << 16); o.y = (unsigned)s[2 * 66] | ((unsigned)s[3 * 66] << 16); o.z = (unsigned)s[4 * 66] | ((unsigned)s[5 * 66] << 16); o.w = (unsigned)s[6 * 66] | ((unsigned)s[7 * 66] << 16);
            *(GAS v4u*)(Z + (size_t)(t0 + t) * MP + c0 + 8 * ch8) = o; }
        LDS_WAIT(); asm volatile("" ::: "memory"); }
}

namespace att {
using bf16x8 = __attribute__((ext_vector_type(8))) short;
using s16x4  = __attribute__((ext_vector_type(4))) short;
using f32x16 = __attribute__((ext_vector_type(16))) float;
using u32x4  = __attribute__((ext_vector_type(4))) unsigned;
constexpr int NW = 8, QBLK = 32, KVBLK = 64;
constexpr int LDQ = 3072, LDKV = 4096, LDKR = 64, LDO = MP;
constexpr int SHM_V = KVBLK * 128 * 2, SHM_KN = KVBLK * 128 * 2, SHM_KR = KVBLK * 64 * 2, SHM_QR = NW * 32 * 64 * 2;
constexpr int OFF_KN = 2 * SHM_V, OFF_KR = OFF_KN + 2 * SHM_KN, OFF_QR = OFF_KR + 2 * SHM_KR, OFF_WS = OFF_QR + SHM_QR, SHM_ATTN = OFF_WS + NW * 64 * 4;
constexpr float THR2 = 11.5f;
#define AT_KSWZ(row, colB) ((row) * 256 + ((colB) ^ (((row) & 7) << 4)))
#define AT_RSWZ(row, chunk) ((row) * 128 + ((((chunk) ^ (((row) >> 1) & 7))) << 4))
#define AT_SBAR() __builtin_amdgcn_sched_barrier(0)
__device__ __forceinline__ int crow(int r, int hi) { return (r & 3) + 8 * (r >> 2) + 4 * hi; }
__device__ __forceinline__ unsigned cvtpk(float lo, float hi) { unsigned r; asm volatile("v_cvt_pk_bf16_f32 %0, %1, %2" : "=v"(r) : "v"(lo), "v"(hi)); return r; }

__device__ __forceinline__ void partialSM(f32x16& p0, f32x16& p1, float& m_reg, float& mn, float& alpha) {
  float pmax = p0[0];
#pragma unroll
  for (int r = 1; r < 16; ++r) pmax = fmaxf(pmax, p0[r]);
#pragma unroll
  for (int r = 0; r < 16; ++r) pmax = fmaxf(pmax, p1[r]);
  { auto rr = __builtin_amdgcn_permlane32_swap(__float_as_uint(pmax), __float_as_uint(pmax), false, false);
    pmax = fmaxf(__uint_as_float(rr[0]), __uint_as_float(rr[1])); }
  if (__builtin_expect(__all(pmax - m_reg <= THR2), 1)) { mn = m_reg; alpha = 1.f; }
  else { mn = fmaxf(m_reg, pmax); alpha = __builtin_amdgcn_exp2f(m_reg - mn); m_reg = mn; }
#pragma unroll
  for (int r = 0; r < 16; ++r) p0[r] = p0[r] - mn;
#pragma unroll
  for (int r = 0; r < 16; ++r) p1[r] = p1[r] - mn;
#pragma unroll
  for (int r = 0; r < 16; ++r) p0[r] = __builtin_amdgcn_exp2f(p0[r]);
}
__device__ __forceinline__ void finishSM(f32x16& p0, f32x16& p1, float alpha, float& l_reg, bf16x8& pa0, bf16x8& pa1, bf16x8& pa2, bf16x8& pa3) {
#pragma unroll
  for (int r = 0; r < 16; ++r) p1[r] = __builtin_amdgcn_exp2f(p1[r]);
  float ps = 0;
#pragma unroll
  for (int r = 0; r < 16; ++r) ps += p0[r];
#pragma unroll
  for (int r = 0; r < 16; ++r) ps += p1[r];
  { auto rr = __builtin_amdgcn_permlane32_swap(__float_as_uint(ps), __float_as_uint(ps), false, false);
    ps = __uint_as_float(rr[0]) + __uint_as_float(rr[1]); }
  l_reg = l_reg * alpha + ps;
#define AT_PK4(P, BASE, OUT) do { unsigned a0 = cvtpk(P[BASE + 0], P[BASE + 1]), a1 = cvtpk(P[BASE + 2], P[BASE + 3]);   \
    unsigned b0 = cvtpk(P[BASE + 4], P[BASE + 5]), b1 = cvtpk(P[BASE + 6], P[BASE + 7]);                              \
    auto r0 = __builtin_amdgcn_permlane32_swap(a0, b0, false, false); auto r1 = __builtin_amdgcn_permlane32_swap(a1, b1, false, false); \
    u32x4 w = {r0[0], r1[0], r0[1], r1[1]}; OUT = *reinterpret_cast<bf16x8*>(&w); } while (0)
  AT_PK4(p0, 0, pa0); AT_PK4(p0, 8, pa1); AT_PK4(p1, 0, pa2); AT_PK4(p1, 8, pa3);
#undef AT_PK4
}
__device__ __forceinline__ void qkt(f32x16& p0, f32x16& p1, const LAS char* Kn, const LAS char* Kr, const bf16x8* qr, const LAS char* Qr, int r32, int hi) {
  asm volatile("" : "+v"(r32), "+v"(hi));
  p0 = f32x16{}; p1 = f32x16{};
#pragma unroll
  for (int d0 = 0; d0 < 8; ++d0) { const int cb = (d0 * 16 + hi * 8) * 2;
    const bf16x8 b0 = *reinterpret_cast<const LAS bf16x8*>(Kn + AT_KSWZ(r32, cb));
    const bf16x8 b1 = *reinterpret_cast<const LAS bf16x8*>(Kn + AT_KSWZ(32 + r32, cb));
    p0 = __builtin_amdgcn_mfma_f32_32x32x16_bf16(b0, qr[d0], p0, 0, 0, 0);
    p1 = __builtin_amdgcn_mfma_f32_32x32x16_bf16(b1, qr[d0], p1, 0, 0, 0); }
#pragma unroll
  for (int d0 = 0; d0 < 4; ++d0) { const int ch = 2 * d0 + hi;
    const bf16x8 b0 = *reinterpret_cast<const LAS bf16x8*>(Kr + AT_RSWZ(r32, ch));
    const bf16x8 b1 = *reinterpret_cast<const LAS bf16x8*>(Kr + AT_RSWZ(32 + r32, ch));
    const bf16x8 q = *reinterpret_cast<const LAS bf16x8*>(Qr + AT_RSWZ(r32, ch));
    p0 = __builtin_amdgcn_mfma_f32_32x32x16_bf16(b0, q, p0, 0, 0, 0);
    p1 = __builtin_amdgcn_mfma_f32_32x32x16_bf16(b1, q, p1, 0, 0, 0); }
}
__device__ __forceinline__ int v_st(int k, int c) { const int kk = (k & ~0xC) | ((k & 4) << 1) | ((k & 8) >> 1); return ((kk >> 3) * 4 + (c >> 5)) * 512 + ((kk & 7) * 32 + (c & 31)) * 2; }
__device__ __forceinline__ int v_rd_base(int lane) { return ((lane & 3) << 3) | (((lane >> 2) & 3) << 6) | (((lane >> 4) & 1) << 5) | (((lane >> 5) & 1) << 8); }
constexpr int v_rd_off(int d0, int ks, int half) { return d0 * 512 + ks * 4096 + half * 2048; }
template <int OFF> __device__ __forceinline__ s16x4 tr_read(int vb) {
  s16x4 r; asm volatile("ds_read_b64_tr_b16 %0, %1 offset:%2" : "=&v"(r) : "v"(vb), "i"(OFF) : "memory"); return r;
}
template <int D0> __device__ __forceinline__ void pv_one(f32x16& od, int vb, bf16x8 pa0, bf16x8 pa1, bf16x8 pa2, bf16x8 pa3) {
  const s16x4 l0 = tr_read<v_rd_off(D0, 0, 0)>(vb), h0 = tr_read<v_rd_off(D0, 0, 1)>(vb), l1 = tr_read<v_rd_off(D0, 1, 0)>(vb), h1 = tr_read<v_rd_off(D0, 1, 1)>(vb);
  const s16x4 l2 = tr_read<v_rd_off(D0, 2, 0)>(vb), h2 = tr_read<v_rd_off(D0, 2, 1)>(vb), l3 = tr_read<v_rd_off(D0, 3, 0)>(vb), h3 = tr_read<v_rd_off(D0, 3, 1)>(vb);
  asm volatile("s_waitcnt lgkmcnt(0)" ::: "memory"); AT_SBAR();
#define AT_PK(L, H) (bf16x8){L[0], L[1], L[2], L[3], H[0], H[1], H[2], H[3]}
  od = __builtin_amdgcn_mfma_f32_32x32x16_bf16(pa0, AT_PK(l0, h0), od, 0, 0, 0);
  od = __builtin_amdgcn_mfma_f32_32x32x16_bf16(pa1, AT_PK(l1, h1), od, 0, 0, 0);
  od = __builtin_amdgcn_mfma_f32_32x32x16_bf16(pa2, AT_PK(l2, h2), od, 0, 0, 0);
  od = __builtin_amdgcn_mfma_f32_32x32x16_bf16(pa3, AT_PK(l3, h3), od, 0, 0, 0);
#undef AT_PK
}
__device__ __forceinline__ void pv_d0(f32x16* o, int vb, bf16x8 pa0, bf16x8 pa1, bf16x8 pa2, bf16x8 pa3) {
  pv_one<0>(o[0], vb, pa0, pa1, pa2, pa3); pv_one<1>(o[1], vb, pa0, pa1, pa2, pa3); pv_one<2>(o[2], vb, pa0, pa1, pa2, pa3); pv_one<3>(o[3], vb, pa0, pa1, pa2, pa3);
}

__device__ __forceinline__ void attn_unit(const bf16_t* __restrict__ Qb, const bf16_t* __restrict__ KVh, const bf16_t* __restrict__ KRb, bf16_t* __restrict__ Ob, int seq, LAS char* lds) {
  const int tid = threadIdx.x, wid = __builtin_amdgcn_readfirstlane(tid >> 6), lane = tid & 63, r32 = lane & 31, hi = lane >> 5;
  LAS char* V_lds = lds; LAS char* Kn_lds = lds + OFF_KN; LAS char* Kr_lds = lds + OFF_KR; LAS char* Qr = lds + OFF_QR + wid * 4096;
  LAS float* ws = (LAS float*)(lds + OFF_WS) + wid * 64; LAS float* li_l = ws; LAS float* al_l = ws + 32;
  float m_reg = -1e30f, l_reg = 0; f32x16 o[4] = {}; bf16x8 qr[8];
  const bf16_t* Qw = Qb + (long)(wid * QBLK + r32) * LDQ + hi * 8;
#pragma unroll
  for (int d0 = 0; d0 < 8; ++d0) qr[d0] = *reinterpret_cast<const bf16x8*>(Qw + d0 * 16);
#pragma unroll
  for (int d0 = 0; d0 < 4; ++d0) *reinterpret_cast<LAS bf16x8*>(Qr + AT_RSWZ(r32, 2 * d0 + hi)) = *reinterpret_cast<const bf16x8*>(Qw + 128 + d0 * 16);
  const int sr = tid >> 4, sc = (tid & 15) * 8, vst0 = v_st(sr, sc), vst1 = v_st(32 + sr, sc);
  const int vb0 = (int)(uintptr_t)V_lds + v_rd_base(lane);
  const bf16_t* Vg = KVh + 128 + (long)sr * LDKV + sc;
  const int kn_row = wid * 4 + (lane >> 4), kn_ch = (lane & 15) ^ (kn_row & 7);
  const int kr_row = wid * 8 + (lane >> 3), kr_ch = (lane & 7) ^ ((kr_row >> 1) & 7);
  const bf16_t* Kg = KVh + (long)kn_row * LDKV + kn_ch * 8; const bf16_t* Rg = KRb + (long)kr_row * LDKR + kr_ch * 8;
  bf16x8 vs0, vs1;
#define AT_KDMA(b, k0) do { \
    __builtin_amdgcn_global_load_lds((const unsigned*)(Kg + (long)(k0) * LDKV), (LAS unsigned*)(Kn_lds + (b) * SHM_KN + wid * 1024), 16, 0, 0); \
    __builtin_amdgcn_global_load_lds((const unsigned*)(Kg + (long)((k0) + 32) * LDKV), (LAS unsigned*)(Kn_lds + (b) * SHM_KN + 8192 + wid * 1024), 16, 0, 0); \
    __builtin_amdgcn_global_load_lds((const unsigned*)(Rg + (long)(k0) * LDKR), (LAS unsigned*)(Kr_lds + (b) * SHM_KR + wid * 1024), 16, 0, 0); } while (0)
#define AT_VLOAD(k0) do { vs0 = *reinterpret_cast<const bf16x8*>(Vg + (long)(k0) * LDKV); vs1 = *reinterpret_cast<const bf16x8*>(Vg + (long)((k0) + 32) * LDKV); } while (0)
#define AT_SLOAD(b, k0) do { AT_KDMA(b, k0); AT_VLOAD(k0); } while (0)
#define AT_SWRITE(b) do { *(LAS bf16x8*)(V_lds + (b) * SHM_V + vst0) = vs0; *(LAS bf16x8*)(V_lds + (b) * SHM_V + vst1) = vs1; } while (0)
#define AT_SWAIT() asm volatile("s_waitcnt vmcnt(0)" ::: "memory")
#define AT_RESC(a) do { if (__any((a) < 1.f)) { if (hi == 0) al_l[r32] = (a); asm volatile("s_waitcnt lgkmcnt(0)" ::: "memory"); \
    _Pragma("unroll") for (int d = 0; d < 4; ++d) _Pragma("unroll") for (int r = 0; r < 16; ++r) o[d][r] *= al_l[crow(r, hi)]; } } while (0)
  f32x16 pA0, pA1, pB0, pB1; float mnA, mnB, alA, alB; bf16x8 pa0, pa1, pa2, pa3; const int NT = seq / KVBLK;
  AT_SLOAD(0, 0); AT_SWAIT(); AT_SWRITE(0); __syncthreads();
  qkt(pA0, pA1, Kn_lds, Kr_lds, qr, Qr, r32, hi); partialSM(pA0, pA1, m_reg, mnA, alA);
  AT_SLOAD(1, KVBLK);
  AT_SWAIT(); AT_SWRITE(1); __syncthreads();
  for (int j = 1; j + 1 < NT; j += 2) {
    AT_SBAR(); qkt(pB0, pB1, Kn_lds + SHM_KN, Kr_lds + SHM_KR, qr, Qr, r32, hi);
    finishSM(pA0, pA1, alA, l_reg, pa0, pa1, pa2, pa3); AT_SBAR();
    AT_SLOAD(0, (j + 1) * KVBLK); AT_SBAR();
    pv_d0(o, vb0, pa0, pa1, pa2, pa3); partialSM(pB0, pB1, m_reg, mnB, alB);
    AT_SWAIT(); __syncthreads(); AT_SWRITE(0);
    AT_RESC(alB); __syncthreads();
    AT_SBAR(); qkt(pA0, pA1, Kn_lds, Kr_lds, qr, Qr, r32, hi);
    finishSM(pB0, pB1, alB, l_reg, pa0, pa1, pa2, pa3); AT_SBAR();
    AT_SLOAD(1, (j + 2) * KVBLK); AT_SBAR();
    pv_d0(o, vb0 + SHM_V, pa0, pa1, pa2, pa3); partialSM(pA0, pA1, m_reg, mnA, alA);
    AT_SWAIT(); __syncthreads(); AT_SWRITE(1);
    AT_RESC(alA); __syncthreads();
  }
  AT_SBAR(); qkt(pB0, pB1, Kn_lds + SHM_KN, Kr_lds + SHM_KR, qr, Qr, r32, hi);
  finishSM(pA0, pA1, alA, l_reg, pa0, pa1, pa2, pa3); AT_SBAR();
  pv_d0(o, vb0, pa0, pa1, pa2, pa3); partialSM(pB0, pB1, m_reg, mnB, alB);
  __syncthreads(); AT_RESC(alB);
  finishSM(pB0, pB1, alB, l_reg, pa0, pa1, pa2, pa3); AT_SBAR();
  pv_d0(o, vb0 + SHM_V, pa0, pa1, pa2, pa3);
  if (hi == 0) li_l[r32] = l_reg; asm volatile("s_waitcnt lgkmcnt(0)" ::: "memory");
  float rli[16];
#pragma unroll
  for (int r = 0; r < 16; ++r) rli[r] = __builtin_amdgcn_rcpf(li_l[crow(r, hi)]);
  bf16_t* Ow = Ob + (long)(wid * QBLK) * LDO;
  const int odd = lane & 1;
#pragma unroll
  for (int r = 0; r < 16; r += 2) {
#pragma unroll
    for (int d0 = 0; d0 < 4; ++d0) { const float a = o[d0][r] * rli[r], b = o[d0][r + 1] * rli[r + 1];
      const float recv = __shfl_xor(odd ? a : b, 1);
      const unsigned w = odd ? cvtpk(recv, b) : cvtpk(a, recv); const int orow = crow(odd ? r + 1 : r, hi);
      *(unsigned*)(Ow + (long)orow * LDO + d0 * 32 + (r32 & ~1)) = w; } }
#undef AT_SLOAD
#undef AT_VLOAD
#undef AT_KDMA
#undef AT_SWRITE
#undef AT_SWAIT
#undef AT_RESC
}
}

__device__ __forceinline__ void attn_phase(const Args& a, LAS unsigned char* lds, int vcu, int G, int j) {
    unsigned char* ws = a.ws; const bf16_t* Q = (const bf16_t*)(ws + WS_Q); const bf16_t* KV = (const bf16_t*)(ws + WS_KV);
    const bf16_t* KR = (const bf16_t*)(ws + WS_KR + (size_t)j * al256((size_t)NKV * 64 * 2)); bf16_t* O = (bf16_t*)(ws + WS_MIXO);
    for (int u = vcu; u < 768; u += G) {
        int qrow0, kv0, seq, h;
        if (u < 512) { const int lb = u >> 8, qb = u & 15; h = (u >> 4) & 15; qrow0 = NCTX + lb * 4096 + qb * 256; kv0 = 4096 + lb * 4608; seq = 4608; }
        else { const int c = u - 512, b = c >> 4; h = c & 15; qrow0 = b * 256; kv0 = b * 256; seq = 256; }
        __syncthreads();
        att::attn_unit(Q + (size_t)qrow0 * 3072 + h * 192, KV + (size_t)kv0 * 4096 + h * 256, KR + (size_t)kv0 * 64, O + (size_t)qrow0 * MP + h * 128, seq, (LAS char*)lds);
    }
    __syncthreads();
}

struct SchedGrid {
    const char* A; const char* B; char* O;
    size_t a_pm, b_pn, a_s, b_s, o_pm, o_pn, o_s;
    int ldc, nM, nN, nS, G, c;
    __device__ __forceinline__ bool next(int i, pg8::Unit& u) const {
        const int L = i * G + c, per = nM * nN; if (L >= per * nS) return false;
        const int s = L / per; int pm, pn; pg8::tile_of(L - s * per, nM, nN, pm, pn);
        u.A = A + pm * a_pm + s * a_s; u.B = B + pn * b_pn + s * b_s; u.O = O + pm * o_pm + pn * o_pn + s * o_s; u.ldc = ldc; u.pm = pm; u.pn = pn; u.aux = s; return true;
    }
};
struct SchedPair {
    SchedGrid g0, g1; int G, c;
    __device__ __forceinline__ bool next(int i, pg8::Unit& u) const {
        const int L = i * G + c, n0 = g0.nM * g0.nN;
        if (L < n0) { int pm, pn; pg8::tile_of(L, g0.nM, g0.nN, pm, pn); u.A = g0.A + pm * g0.a_pm; u.B = g0.B + pn * g0.b_pn; u.O = g0.O + pm * g0.o_pm + pn * g0.o_pn; u.ldc = g0.ldc; u.pm = pm; u.pn = pn; u.aux = 0; return true; }
        const int L1 = L - n0; if (L1 >= g1.nM * g1.nN) return false;
        int pm, pn; pg8::tile_of(L1, g1.nM, g1.nN, pm, pn); u.A = g1.A + pm * g1.a_pm; u.B = g1.B + pn * g1.b_pn; u.O = g1.O + pm * g1.o_pm + pn * g1.o_pn; u.ldc = g1.ldc; u.pm = pm; u.pn = pn; u.aux = 1; return true;
    }
};
struct SchedF1 {
    const char* dftc; const char* U; char* atc; char* atl; int G, c;
    __device__ __forceinline__ bool next(int i, pg8::Unit& u) const {
        const int L = i * G + c; if (L >= 768) return false;
        const int part = L & 1, g = (L >> 1) & 7, tt = L >> 4;
        u.A = dftc + (size_t)part * 256 * 256 * 2; u.B = U + ((size_t)tt * 256 * UP + g * 256) * 2;
        if (tt < 16) { u.O = atc + ((size_t)tt * 2048 * 512 + (size_t)(g * 256) * 512 + part * 256) * 2; u.ldc = 512; }
        else { const int lb = (tt - 16) >> 4, l0 = ((tt - 16) & 15) * 256; u.O = atl + ((size_t)lb * 2048 * 8192 + (size_t)(g * 256) * 8192 + part * 4096 + l0) * 2; u.ldc = 8192; }
        u.pm = part; u.pn = tt; u.aux = g; return true;
    }
};

struct SchedF2 {
    const char* tab; const char* atl; char* pq; int G, c;
    __device__ __forceinline__ bool next(int i, pg8::Unit& u) const {
        const int L = i * G + c; if (L >= 256) return false;
        const int s = L >> 6, w = s >> 1, lb = s & 1; int pm, pn; pg8::tile_of(L & 63, 8, 8, pm, pn);
        u.A = tab + ((size_t)w * 2048 + pm * 256) * 4096 * 2; u.B = atl + (((size_t)lb * 2048 + pn * 256) * 8192 + (size_t)w * 4096) * 2;
        u.O = pq + ((((size_t)w * 2 + lb) * 2048 + pm * 256) * 2048 + pn * 256) * 2; u.ldc = 2048; u.pm = pm; u.pn = pn; u.aux = s; return true;
    }
};

#define DEVFN __device__ __forceinline__
#define C2_TYPEDEF typedef float c2 __attribute__((ext_vector_type(2)));
#define LDSP LAS
#define OPAQUE(x) asm volatile("" : "+v"(x))
#define U32X4 v4u
#define U32X2 v2u
#define LOAD16(p) (*(const v4u*)(p))
#define LOAD8(p) (*(const v2u*)(p))
#define STORE16(p, v) (*(v4u*)(p) = (v))
#define STORE8(p, v) (*(v2u*)(p) = (v))
#define BFLO(w) bflo(w)
#define BFHI(w) bfhi(w)
#define PK2(a, b) pk2(a, b)
#define BF16X8 pg8::bf16x8
#define F32X4 f32x4
#define F32X4_ZERO ((f32x4){0.f, 0.f, 0.f, 0.f})
#define F32X4_GET(a, r) ((a)[r])
#define LSTORE16(p, v) (*(LAS v4u*)(p) = (v))
#define LSTORE8(p, v) (*(LAS v2u*)(p) = (v))
#define LLOAD8(p) (*(const LAS v2u*)(p))
#define LLOAD_BF8(p) (*(const LAS pg8::bf16x8*)(p))
#define MFMA16(a, b, c) __builtin_amdgcn_mfma_f32_16x16x32_bf16(a, b, c, 0, 0, 0)
typedef float f32x16_t __attribute__((ext_vector_type(16)));
#define F32X16 f32x16_t
#define F32X16_ZERO ((f32x16_t){0.f, 0.f, 0.f, 0.f, 0.f, 0.f, 0.f, 0.f, 0.f, 0.f, 0.f, 0.f, 0.f, 0.f, 0.f, 0.f})
#define F32X16_GET(a, r) ((a)[r])
#define F32X16_SET(a, r, x) ((a)[r] = (x))
#define U32X4_ZERO ((v4u){0u, 0u, 0u, 0u})
#define LLOAD16(p) (*(const LAS v4u*)(p))
__device__ __forceinline__ pg8::bf16x8 make_bf8(const float* v) { v4u w; w.x = pk2(v[0], v[1]); w.y = pk2(v[2], v[3]); w.z = pk2(v[4], v[5]); w.w = pk2(v[6], v[7]); return __builtin_bit_cast(pg8::bf16x8, w); }
#define MAKE_BF8(v) make_bf8(v)
#define BF8_FROM_U32X4(w) __builtin_bit_cast(BF16X8, (w))
#define OPAQUE_BF8(x) asm volatile("" : "+v"(x))
#define SCHED_FENCE() __builtin_amdgcn_sched_barrier(0)
#define MFMA32(a, b, c) __builtin_amdgcn_mfma_f32_32x32x16_bf16(a, b, c, 0, 0, 0)
#define LANE_XOR1(x) __builtin_bit_cast(float, __builtin_amdgcn_mov_dpp(__builtin_bit_cast(int, (x)), 0xB1, 0xF, 0xF, true))
#define BF2F(x) bf2f(x)
#define F2BF(x) ((bf16_t)pk2((x), 0.f))
#define COS_TURNS(x) __builtin_amdgcn_cosf(x)
#define SIN_TURNS(x) __builtin_amdgcn_sinf(x)
#define EXPF(x) __expf(x)
#define RSQRTF(x) (1.0f / sqrtf(x))
#define WAVE_SUM(v) wave_sum(v)
#define BLOCK_SYNC() __syncthreads()
#define WAVE_SYNC() asm volatile("s_waitcnt lgkmcnt(0)" ::: "memory")
C2_TYPEDEF
DEVFN c2 cmul(c2 a, c2 b) { c2 r; r.x = a.x * b.x - a.y * b.y; r.y = a.x * b.y + a.y * b.x; return r; }
DEVFN c2 cmulc(c2 a, c2 b) { c2 r; r.x = a.x * b.x + a.y * b.y; r.y = a.y * b.x - a.x * b.y; return r; }
#define SWZ(i) ((i) ^ ((((i) >> 5) & 1) * 5) ^ ((((i) >> 6) & 1) * 10) ^ ((((i) >> 7) & 1) << 4))
DEVFN constexpr float cos16(int i) { return i == 0 ? 1.f : i == 1 ? 0.9238795325f : i == 2 ? 0.7071067812f : i == 3 ? 0.3826834324f : i == 4 ? 0.f : i == 5 ? -0.3826834324f : i == 6 ? -0.7071067812f : -0.9238795325f; }
DEVFN constexpr float sin16(int i) { return i == 0 ? 0.f : i == 1 ? 0.3826834324f : i == 2 ? 0.7071067812f : i == 3 ? 0.9238795325f : i == 4 ? 1.f : i == 5 ? 0.9238795325f : i == 6 ? 0.7071067812f : 0.3826834324f; }
template <int LOGN, int S, int G, bool INV, int NT>
DEVFN void fft_pass(LDSP c2* x, int total, int tid) {
    OPAQUE(tid);
    constexpr int N = 1 << LOGN, R = 1 << G, H3 = N >> (S + G);
    const int ngroups = total / R;
#pragma unroll 1
    for (int j = tid; j < ngroups; j += NT) {
        const int tr = j / (N / R), jj = j % (N / R), blk = jj / H3, pos = jj % H3;
        const int i0 = tr * N + blk * (R * H3) + pos;
        c2 v[R];
        const int b0 = SWZ(i0);
#pragma unroll
        for (int q = 0; q < R; ++q) v[q] = x[b0 ^ SWZ(q * H3)];
        c2 wg[G];
        { const float fr = (float)pos * (1.0f / (float)(R * H3)); wg[0].x = COS_TURNS(fr); wg[0].y = -SIN_TURNS(fr);
#pragma unroll
          for (int g = 1; g < G; ++g) { wg[g].x = wg[g - 1].x * wg[g - 1].x - wg[g - 1].y * wg[g - 1].y; wg[g].y = 2.0f * wg[g - 1].x * wg[g - 1].y; } }
#pragma unroll
        for (int gg = 0; gg < G; ++gg) {
            const int g = INV ? (G - 1 - gg) : gg;
            const int hq = R >> (g + 1);
#pragma unroll
            for (int q = 0; q < R; ++q) {
                if ((q & hq) == 0) {
                    const int m = q & (hq - 1), ci = m * (8 / hq);
                    c2 w = wg[g];
                    if (m != 0) { c2 cc; cc.x = cos16(ci); cc.y = -sin16(ci); w = cmul(w, cc); }
                    const c2 a = v[q], b = v[q + hq];
                    if (!INV) { c2 d; d.x = a.x - b.x; d.y = a.y - b.y; v[q].x = a.x + b.x; v[q].y = a.y + b.y; v[q + hq] = cmul(d, w); }
                    else { const c2 bw = cmulc(b, w); v[q].x = a.x + bw.x; v[q].y = a.y + bw.y; v[q + hq].x = a.x - bw.x; v[q + hq].y = a.y - bw.y; }
                }
            }
        }
#pragma unroll
        for (int q = 0; q < R; ++q) x[b0 ^ SWZ(q * H3)] = v[q];
    }
}
template <int LOGW, bool INV> DEVFN void fft_wave(LDSP c2* x, int lane) {
    constexpr int NW = 1 << LOGW;
    if constexpr (LOGW == 9) {
        if (!INV) { fft_pass<9, 0, 3, false, 64>(x, NW, lane); WAVE_SYNC(); fft_pass<9, 3, 3, false, 64>(x, NW, lane); WAVE_SYNC(); fft_pass<9, 6, 3, false, 64>(x, NW, lane); WAVE_SYNC(); }
        else { fft_pass<9, 6, 3, true, 64>(x, NW, lane); WAVE_SYNC(); fft_pass<9, 3, 3, true, 64>(x, NW, lane); WAVE_SYNC(); fft_pass<9, 0, 3, true, 64>(x, NW, lane); WAVE_SYNC(); }
    } else {
        static_assert(LOGW == 9 || LOGW == 10, "wave-local sizes");
        if (!INV) { fft_pass<10, 0, 3, false, 64>(x, NW, lane); WAVE_SYNC(); fft_pass<10, 3, 3, false, 64>(x, NW, lane); WAVE_SYNC(); fft_pass<10, 6, 2, false, 64>(x, NW, lane); WAVE_SYNC(); fft_pass<10, 8, 2, false, 64>(x, NW, lane); WAVE_SYNC(); }
        else { fft_pass<10, 8, 2, true, 64>(x, NW, lane); WAVE_SYNC(); fft_pass<10, 6, 2, true, 64>(x, NW, lane); WAVE_SYNC(); fft_pass<10, 3, 3, true, 64>(x, NW, lane); WAVE_SYNC(); fft_pass<10, 0, 3, true, 64>(x, NW, lane); WAVE_SYNC(); }
    }
}
struct HyParams {
    float dec[2][2];
    float skip[2];
    float cw[3][3];
    float cb[3];
};
template <int NV> struct ShortRaw { U32X4 v; unsigned short xl, xr; };
template <int NV>
DEVFN void hy_short_load(ShortRaw<NV>& r, const bf16_t* Pcol, unsigned o, int t0, int L) {
    if constexpr (NV == 8) r.v = LOAD16(Pcol + o); else { const U32X2 t = LOAD8(Pcol + o); r.v.x = t.x; r.v.y = t.y; r.v.z = 0u; r.v.w = 0u; }
    r.xl = Pcol[t0 > 0 ? o - 1u : o]; r.xr = Pcol[t0 + NV < L ? o + (unsigned)NV : o];
}
template <int NV>
DEVFN void hy_short_calc(const ShortRaw<NV>& r, int t0, int L, float w0, float w1, float w2, float cb, float (&out)[NV]) {
    float x[NV + 2]; const unsigned w[4] = {r.v.x, r.v.y, r.v.z, r.v.w};
#pragma unroll
    for (int e = 0; e < NV / 2; ++e) { x[1 + 2 * e] = BFLO(w[e]); x[2 + 2 * e] = BFHI(w[e]); }
    x[0] = t0 > 0 ? BF2F(r.xl) : 0.f; x[NV + 1] = t0 + NV < L ? BF2F(r.xr) : 0.f;
#pragma unroll
    for (int e = 0; e < NV; ++e) out[e] = w0 * x[e] + w1 * x[e + 1] + w2 * x[e + 2] + cb;
}
template <int LOGN, int NB, int O>
DEVFN void hy_conv_order(LDSP c2* XB, LDSP c2* KB, LDSP float* red, int c, int region_base, int fpos, const bf16_t* PT, const bf16_t* FILT, const HyParams& hp, bf16_t* ZT, int tid,
                         float (&za)[(NB << (LOGN - 1)) / NTHREADS], float (&zb)[(NB << (LOGN - 1)) / NTHREADS]) {
    constexpr int N = 1 << LOGN, L = N / 2, NV = NB * L / NTHREADS;
    static_assert((NB == 1 && LOGN == 13 && NV == 8) || (NB == 8 && LOGN == 9 && NV == 4), "supported shapes");
    const int lane = tid & 63, wv = tid >> 6;
    const bf16_t* Pv = PT + (size_t)c * NTOK; const bf16_t* Pg = PT + (size_t)((1 + O) * 2048 + c) * NTOK;
    const int v0 = NV * tid, pair = v0 / L, t0 = v0 % L, sb = region_base + (2 * pair) * L;
    const bf16_t* Ff = FILT + (size_t)(0 * 4096 + O * 2048 + c) * FILT_LD + fpos; const bf16_t* Fb = FILT + (size_t)(1 * 4096 + O * 2048 + c) * FILT_LD + fpos;
    LDSP c2* KBw = NB == 1 ? KB : KB + wv * N;
    const int ft0 = NB == 1 ? 8 * tid : 4 * lane; U32X4 rf, rb;
    if constexpr (NB == 1) { rf = LOAD16(Ff + ft0); rb = LOAD16(Fb + ft0); } else { const U32X2 a2 = LOAD8(Ff + ft0), b2 = LOAD8(Fb + ft0); rf.x = a2.x; rf.y = a2.y; rf.z = 0u; rf.w = 0u; rb.x = b2.x; rb.y = b2.y; rb.z = 0u; rb.w = 0u; }
    ShortRaw<NV> rva, rvb;
    if (O == 0) { hy_short_load<NV>(rva, Pv, (unsigned)(sb + t0), t0, L); hy_short_load<NV>(rvb, Pv, (unsigned)(sb + L + t0), t0, L); }
    float ss = 0.f; const float tsc = 1.0f / (float)(L - 1); const float d0 = hp.dec[0][O], d1 = hp.dec[1][O];
    { const unsigned wf[4] = {rf.x, rf.y, rf.z, rf.w}, wb[4] = {rb.x, rb.y, rb.z, rb.w};
#pragma unroll
      for (int e = 0; e < NV; ++e) { const int t = ft0 + e; const float tn = (float)t * tsc;
          const float f = ((e & 1) ? BFHI(wf[e >> 1]) : BFLO(wf[e >> 1])) * (EXPF(-tn * d0) + 0.05f), b = ((e & 1) ? BFHI(wb[e >> 1]) : BFLO(wb[e >> 1])) * (EXPF(-tn * d1) + 0.05f);
          ss += f * f + b * b; c2 k; k.x = f; k.y = 0.f; KBw[SWZ(t)] = k; c2 kb; kb.x = t > 0 ? b : 0.f; kb.y = 0.f; KBw[SWZ(t > 0 ? N - t : L)] = kb; } }
    ss = WAVE_SUM(ss);
    float tot;
    if constexpr (NB == 1) { BLOCK_SYNC(); if (lane == 0) red[wv] = ss; }
    if (O == 0) { hy_short_calc<NV>(rva, t0, L, hp.cw[0][0], hp.cw[0][1], hp.cw[0][2], hp.cb[0], za); hy_short_calc<NV>(rvb, t0, L, hp.cw[0][0], hp.cw[0][1], hp.cw[0][2], hp.cb[0], zb); }
#pragma unroll
    for (int e = 0; e < NV; ++e) { c2 z; z.x = za[e]; z.y = zb[e]; XB[SWZ(pair * N + t0 + e)] = z; c2 zz; zz.x = 0.f; zz.y = 0.f; XB[SWZ(pair * N + L + t0 + e)] = zz; }
    ShortRaw<NV> rga, rgb;
    hy_short_load<NV>(rga, Pg, (unsigned)(sb + t0), t0, L); hy_short_load<NV>(rgb, Pg, (unsigned)(sb + L + t0), t0, L);
    if constexpr (NB == 1) {
        BLOCK_SYNC();
        tot = 0.f;
#pragma unroll
        for (int w = 0; w < NTHREADS / 64; ++w) tot += red[w];
        const float sc = RSQRTF(tot + 1e-12f) * (1.0f / (float)N);
        fft_pass<13, 0, 3, false, NTHREADS>(KB, N, tid); fft_pass<13, 0, 3, false, NTHREADS>(XB, N, tid);
        BLOCK_SYNC();
        { LDSP c2* kw = KB + wv * 1024; LDSP c2* xw = XB + wv * 1024;
          fft_wave<10, false>(kw, lane); fft_wave<10, false>(xw, lane);
#pragma unroll 4
          for (int i = 0; i < 16; ++i) { const int p = wv * 1024 + lane + 64 * i; c2 k = KB[SWZ(p)]; k.x *= sc; k.y *= sc; const c2 xv = XB[SWZ(p)]; XB[SWZ(p)] = cmul(xv, k); }
          WAVE_SYNC();
          fft_wave<10, true>(xw, lane); }
        BLOCK_SYNC();
        fft_pass<13, 0, 3, true, NTHREADS>(XB, N, tid);
        BLOCK_SYNC();
    } else {
        WAVE_SYNC();
        const float sc = RSQRTF(ss + 1e-12f) * (1.0f / (float)N);
        LDSP c2* xw = XB + wv * N;
        fft_wave<9, false>(KBw, lane); fft_wave<9, false>(xw, lane);
#pragma unroll 4
        for (int i = 0; i < 8; ++i) { const int p = lane + 64 * i; c2 k = KBw[SWZ(p)]; k.x *= sc; k.y *= sc; const c2 xv = xw[SWZ(p)]; xw[SWZ(p)] = cmul(xv, k); }
        WAVE_SYNC();
        fft_wave<9, true>(xw, lane);
    }
    { const float sk = hp.skip[O]; float ga[NV], gb[NV];
      hy_short_calc<NV>(rga, t0, L, hp.cw[1 + O][0], hp.cw[1 + O][1], hp.cw[1 + O][2], hp.cb[1 + O], ga); hy_short_calc<NV>(rgb, t0, L, hp.cw[1 + O][0], hp.cw[1 + O][1], hp.cw[1 + O][2], hp.cb[1 + O], gb);
#pragma unroll
      for (int e = 0; e < NV; ++e) { const c2 y = XB[SWZ(pair * N + t0 + e)]; za[e] = ga[e] * (y.x + sk * za[e]); zb[e] = gb[e] * (y.y + sk * zb[e]); }
      if (O == 1) { bf16_t* Zc = ZT + (size_t)c * NTOK;
          if constexpr (NV == 8) { U32X4 wa, wb; wa.x = PK2(za[0], za[1]); wa.y = PK2(za[2], za[3]); wa.z = PK2(za[4], za[5]); wa.w = PK2(za[6], za[7]); wb.x = PK2(zb[0], zb[1]); wb.y = PK2(zb[2], zb[3]); wb.z = PK2(zb[4], zb[5]); wb.w = PK2(zb[6], zb[7]);
              STORE16(Zc + (unsigned)(sb + t0), wa); STORE16(Zc + (unsigned)(sb + L + t0), wb); }
          else { U32X2 wa, wb; wa.x = PK2(za[0], za[1]); wa.y = PK2(za[2], za[3]); wb.x = PK2(zb[0], zb[1]); wb.y = PK2(zb[2], zb[3]); STORE8(Zc + (unsigned)(sb + t0), wa); STORE8(Zc + (unsigned)(sb + L + t0), wb); } } }
    if constexpr (NB == 8) WAVE_SYNC();
}
template <int LOGN, int NB>
DEVFN void hy_conv_unit(LDSP c2* XB, LDSP c2* KB, LDSP float* red, int c, int region_base, int fpos, const bf16_t* PT, const bf16_t* FILT, const HyParams& hp, bf16_t* ZT, int tid) {
    constexpr int NV = (NB << (LOGN - 1)) / NTHREADS;
    float za[NV], zb[NV];
#pragma unroll
    for (int i = 0; i < NV; ++i) { za[i] = 0.f; zb[i] = 0.f; }
    BLOCK_SYNC();
    hy_conv_order<LOGN, NB, 0>(XB, KB, red, c, region_base, fpos, PT, FILT, hp, ZT, tid, za, zb);
    hy_conv_order<LOGN, NB, 1>(XB, KB, red, c, region_base, fpos, PT, FILT, hp, ZT, tid, za, zb);
}
constexpr int CT_PITCH = 264, CT_ZS = 16 * CT_PITCH * 2, CT_KCOPY = 528 * 2, CT_KC = 8 * CT_KCOPY;
constexpr int CT_OFF_ZS0 = 0, CT_OFF_ZS1 = CT_ZS, CT_OFF_G1 = 2 * CT_ZS, CT_OFF_G2 = 3 * CT_ZS, CT_OFF_KC = 4 * CT_ZS, CT_BYTES = 4 * CT_ZS + 2 * CT_KC;
DEVFN void hy_ctx_mfma_unit(LDSP unsigned char* lb, int c, const bf16_t* PT, const bf16_t* FILT, const HyParams& hp, bf16_t* ZT, int tid) {
    constexpr int L = 256;
    const int lane = tid & 63, wv = tid >> 6;
    BLOCK_SYNC();
    { const int b = tid >> 5, t8 = (tid & 31) * 8; const unsigned o = (unsigned)(b * L + t8);
      ShortRaw<8> r0, r1, r2; hy_short_load<8>(r0, PT + (size_t)c * NTOK, o, t8, L); hy_short_load<8>(r1, PT + (size_t)(2048 + c) * NTOK, o, t8, L); hy_short_load<8>(r2, PT + (size_t)(4096 + c) * NTOK, o, t8, L);
      float v[8]; U32X4 w;
      hy_short_calc<8>(r0, t8, L, hp.cw[0][0], hp.cw[0][1], hp.cw[0][2], hp.cb[0], v); w.x = PK2(v[0], v[1]); w.y = PK2(v[2], v[3]); w.z = PK2(v[4], v[5]); w.w = PK2(v[6], v[7]); LSTORE16(lb + CT_OFF_ZS0 + (b * CT_PITCH + t8) * 2, w);
      hy_short_calc<8>(r1, t8, L, hp.cw[1][0], hp.cw[1][1], hp.cw[1][2], hp.cb[1], v); w.x = PK2(v[0], v[1]); w.y = PK2(v[2], v[3]); w.z = PK2(v[4], v[5]); w.w = PK2(v[6], v[7]); LSTORE16(lb + CT_OFF_G1 + (b * CT_PITCH + t8) * 2, w);
      hy_short_calc<8>(r2, t8, L, hp.cw[2][0], hp.cw[2][1], hp.cw[2][2], hp.cb[2], v); w.x = PK2(v[0], v[1]); w.y = PK2(v[2], v[3]); w.z = PK2(v[4], v[5]); w.w = PK2(v[6], v[7]); LSTORE16(lb + CT_OFF_G2 + (b * CT_PITCH + t8) * 2, w); }
#pragma unroll
    for (int O = 0; O < 2; ++O) {
        const bf16_t* Ff = FILT + (size_t)(0 * 4096 + O * 2048 + c) * FILT_LD + 4096; const bf16_t* Fb = FILT + (size_t)(1 * 4096 + O * 2048 + c) * FILT_LD + 4096;
        const U32X2 rf = LOAD8(Ff + 4 * lane), rb = LOAD8(Fb + 4 * lane); const unsigned wf[2] = {rf.x, rf.y}, wb[2] = {rb.x, rb.y};
        float f[4], bk[4], ss = 0.f; const float tsc = 1.0f / (float)(L - 1);
#pragma unroll
        for (int e = 0; e < 4; ++e) { const float tn = (float)(4 * lane + e) * tsc;
            f[e] = ((e & 1) ? BFHI(wf[e >> 1]) : BFLO(wf[e >> 1])) * (EXPF(-tn * hp.dec[0][O]) + 0.05f); bk[e] = ((e & 1) ? BFHI(wb[e >> 1]) : BFLO(wb[e >> 1])) * (EXPF(-tn * hp.dec[1][O]) + 0.05f); ss += f[e] * f[e] + bk[e] * bk[e]; }
        ss = WAVE_SUM(ss); const float nr = RSQRTF(ss + 1e-12f);
        LDSP bf16_t* kc = (LDSP bf16_t*)(lb + CT_OFF_KC + O * CT_KC + wv * CT_KCOPY);
#pragma unroll
        for (int e = 0; e < 4; ++e) { const int t = 4 * lane + e; const int mf = 255 - t - wv, mb = 255 + t - wv;
            if (mf >= 0) kc[mf] = F2BF(f[e] * nr); if (t > 0) kc[mb] = F2BF(bk[e] * nr); }
    }
    BLOCK_SYNC();
    const int bcol = lane & 15, g = lane >> 4; float z1[2][4];
#pragma unroll
    for (int O = 0; O < 2; ++O) {
        LDSP unsigned char* zin = lb + (O == 0 ? CT_OFF_ZS0 : CT_OFF_ZS1); LDSP unsigned char* gat = lb + (O == 0 ? CT_OFF_G1 : CT_OFF_G2); LDSP unsigned char* kc = lb + CT_OFF_KC + O * CT_KC;
        const float sk = hp.skip[O];
#pragma unroll
        for (int tt = 0; tt < 2; ++tt) { const int t0 = 32 * wv + 16 * tt; F32X4 acc = F32X4_ZERO;
#pragma unroll
            for (int ks = 0; ks < 8; ++ks) { const int s0 = 32 * ks; const int i0 = 255 - (t0 + bcol - s0 - 8 * g);
                const BF16X8 a = LLOAD_BF8(kc + (i0 & 7) * CT_KCOPY + (i0 & ~7) * 2), bq = LLOAD_BF8(zin + (bcol * CT_PITCH + s0 + 8 * g) * 2);
                acc = MFMA16(a, bq, acc); }
            const int tb = t0 + 4 * g; const U32X2 zr = LLOAD8(zin + (bcol * CT_PITCH + tb) * 2), gr = LLOAD8(gat + (bcol * CT_PITCH + tb) * 2);
            const float zv[4] = {BFLO(zr.x), BFHI(zr.x), BFLO(zr.y), BFHI(zr.y)}, gv[4] = {BFLO(gr.x), BFHI(gr.x), BFLO(gr.y), BFHI(gr.y)}; float o[4];
#pragma unroll
            for (int r = 0; r < 4; ++r) { const float zprev = O == 0 ? zv[r] : z1[tt][r]; o[r] = gv[r] * (F32X4_GET(acc, r) + sk * zprev); z1[tt][r] = o[r]; }
            U32X2 w; w.x = PK2(o[0], o[1]); w.y = PK2(o[2], o[3]);
            if (O == 0) LSTORE8(lb + CT_OFF_ZS1 + (bcol * CT_PITCH + tb) * 2, w); else STORE8(ZT + (size_t)c * NTOK + (unsigned)(bcol * L + tb), w); }
        if (O == 0) BLOCK_SYNC();
    }
}
constexpr int LT_INP = 72, LT_MIDP = 136;
constexpr int LT_IN = 0, LT_IN_BYTES = 2 * 128 * LT_INP * 2, LT_MID = LT_IN + LT_IN_BYTES, LT_MID_BYTES = 2 * 64 * LT_MIDP * 2, LT_ZS = LT_MID + LT_MID_BYTES, LT_GS = LT_ZS + 2 * 4096 * 2, LT_BYTES = LT_GS + 2 * 2 * 4096 * 2;
struct LatFrags { BF16X8 af[8]; BF16X8 gb[16]; };
DEVFN float lat_af_val(int k1, int pp, int kk) { const int p = kk >> 6, n1 = kk & 63; const float tr = (float)((k1 * n1) & 63) * (1.0f / 64.0f); return p == pp ? COS_TURNS(tr) : (pp == 0 ? SIN_TURNS(tr) : -SIN_TURNS(tr)); }
DEVFN float lat_gb_val(int k2, int pp, int kk) { const int p = kk >> 7, n2 = kk & 127; const float tr = (float)((n2 * k2) & 127) * (1.0f / 128.0f); return p == pp ? COS_TURNS(tr) : (p == 0 ? -SIN_TURNS(tr) : SIN_TURNS(tr)); }
DEVFN void lat_make_frags(LatFrags& fr, int tid) {
    const int lane = tid & 63, wv = tid >> 6, hh = lane >> 5, m = lane & 31, rb = wv >> 1;
    { const int a = m >> 3, h = (m >> 2) & 1, b = m & 3, k1 = 16 * rb + 4 * a + 2 * h + (b >> 1), pp = b & 1;
#pragma unroll
      for (int ks = 0; ks < 8; ++ks) { int k1o = k1; OPAQUE(k1o); const int k0 = 16 * ks + 8 * hh; U32X4 w;
          w.x = PK2(lat_af_val(k1o, pp, k0 + 0), lat_af_val(k1o, pp, k0 + 1)); w.y = PK2(lat_af_val(k1o, pp, k0 + 2), lat_af_val(k1o, pp, k0 + 3));
          w.z = PK2(lat_af_val(k1o, pp, k0 + 4), lat_af_val(k1o, pp, k0 + 5)); w.w = PK2(lat_af_val(k1o, pp, k0 + 6), lat_af_val(k1o, pp, k0 + 7));
          fr.af[ks] = BF8_FROM_U32X4(w); OPAQUE_BF8(fr.af[ks]); SCHED_FENCE(); } }
    { const int c = lane & 31, k2 = 16 * wv + (c >> 1), pp = c & 1;
#pragma unroll
      for (int ks = 0; ks < 16; ++ks) { int k2o = k2; OPAQUE(k2o); const int k0 = 16 * ks + 8 * hh; U32X4 w;
          w.x = PK2(lat_gb_val(k2o, pp, k0 + 0), lat_gb_val(k2o, pp, k0 + 1)); w.y = PK2(lat_gb_val(k2o, pp, k0 + 2), lat_gb_val(k2o, pp, k0 + 3));
          w.z = PK2(lat_gb_val(k2o, pp, k0 + 4), lat_gb_val(k2o, pp, k0 + 5)); w.w = PK2(lat_gb_val(k2o, pp, k0 + 6), lat_gb_val(k2o, pp, k0 + 7));
          fr.gb[ks] = BF8_FROM_U32X4(w); OPAQUE_BF8(fr.gb[ks]); SCHED_FENCE(); } }
}
DEVFN int lat_crow(int r, int hh) { return (r & 3) + 8 * (r >> 2) + 4 * hh; }
DEVFN void lat_fft(LDSP unsigned char* lb, const LatFrags& fr, F32X16 (&out)[2], int tid) {
    OPAQUE(tid);
    const int lane = tid & 63, wv = tid >> 6, hh = lane >> 5, col = lane & 31, rb = wv >> 1, ch = wv & 1;
#pragma unroll
    for (int cb = 0; cb < 2; ++cb) { const int n2 = 64 * ch + 32 * cb + col; F32X16 acc = F32X16_ZERO;
#pragma unroll
        for (int ks = 0; ks < 8; ++ks) { const int kk = 16 * ks + 8 * hh, p = kk >> 6, n1 = kk & 63;
            const BF16X8 b = LLOAD_BF8(lb + LT_IN + ((p * 128 + n2) * LT_INP + n1) * 2); acc = MFMA32(fr.af[ks], b, acc); }
#pragma unroll
        for (int a = 0; a < 4; ++a)
#pragma unroll
            for (int j = 0; j < 2; ++j) { const int k1 = 16 * rb + 4 * a + 2 * hh + j; const float re = F32X16_GET(acc, 4 * a + 2 * j), im = F32X16_GET(acc, 4 * a + 2 * j + 1);
                const float tr = (float)(k1 * n2) * (1.0f / 8192.0f), cs = COS_TURNS(tr), sn = SIN_TURNS(tr);
                *(LDSP bf16_t*)(lb + LT_MID + ((0 * 64 + k1) * LT_MIDP + n2) * 2) = F2BF(re * cs + im * sn); *(LDSP bf16_t*)(lb + LT_MID + ((1 * 64 + k1) * LT_MIDP + n2) * 2) = F2BF(im * cs - re * sn); } }
    BLOCK_SYNC();
    int col3 = col, hh3 = hh; OPAQUE(col3); OPAQUE(hh3);
#pragma unroll
    for (int mb = 0; mb < 2; ++mb) { F32X16 acc = F32X16_ZERO; const int k1 = 32 * mb + col3;
#pragma unroll
        for (int ks = 0; ks < 16; ++ks) { const int kk = 16 * ks + 8 * hh3, p = kk >> 7, n2 = kk & 127;
            const BF16X8 a = LLOAD_BF8(lb + LT_MID + ((p * 64 + k1) * LT_MIDP + n2) * 2); acc = MFMA32(a, fr.gb[ks], acc); }
        out[mb] = acc; }
}
DEVFN void lat_scatter_conj(LDSP unsigned char* lb, const F32X16 (&y)[2], int tid) {
    OPAQUE(tid);
    const int lane = tid & 63, wv = tid >> 6, hh = lane >> 5, c = lane & 31, k2 = 16 * wv + (c >> 1), pp = c & 1; const float sg = pp ? -1.0f : 1.0f;
#pragma unroll
    for (int mb = 0; mb < 2; ++mb)
#pragma unroll
        for (int r = 0; r < 16; ++r) { const int k1 = 32 * mb + lat_crow(r, hh);
            *(LDSP bf16_t*)(lb + LT_IN + ((pp * 128 + k1 + 64 * (k2 & 1)) * LT_INP + (k2 >> 1)) * 2) = F2BF(sg * F32X16_GET(y[mb], r)); }
}
DEVFN void hy_lat_mfma_unit(LDSP unsigned char* lb, LDSP float* red, const LatFrags& fr, int c, const bf16_t* PT, const bf16_t* FILT, const HyParams& hp, bf16_t* ZT, int tid) {
    constexpr int L = 4096, N = 8192, RB = 4096;
    const int lane = tid & 63, wv = tid >> 6, pp = lane & 1;
    BLOCK_SYNC();
    { int tq = tid; OPAQUE(tq); const int t8 = 8 * tq;
#pragma unroll
    for (int b = 0; b < 2; ++b) { const unsigned o = (unsigned)(RB + b * L + t8); ShortRaw<8> r0, r1, r2;
        hy_short_load<8>(r0, PT + (size_t)c * NTOK, o, t8, L); hy_short_load<8>(r1, PT + (size_t)(2048 + c) * NTOK, o, t8, L); hy_short_load<8>(r2, PT + (size_t)(4096 + c) * NTOK, o, t8, L);
        float v[8]; U32X4 w;
        hy_short_calc<8>(r0, t8, L, hp.cw[0][0], hp.cw[0][1], hp.cw[0][2], hp.cb[0], v); w.x = PK2(v[0], v[1]); w.y = PK2(v[2], v[3]); w.z = PK2(v[4], v[5]); w.w = PK2(v[6], v[7]); LSTORE16(lb + LT_ZS + (b * L + t8) * 2, w);
        hy_short_calc<8>(r1, t8, L, hp.cw[1][0], hp.cw[1][1], hp.cw[1][2], hp.cb[1], v); w.x = PK2(v[0], v[1]); w.y = PK2(v[2], v[3]); w.z = PK2(v[4], v[5]); w.w = PK2(v[6], v[7]); LSTORE16(lb + LT_GS + ((0 * 2 + b) * L + t8) * 2, w);
        hy_short_calc<8>(r2, t8, L, hp.cw[2][0], hp.cw[2][1], hp.cw[2][2], hp.cb[2], v); w.x = PK2(v[0], v[1]); w.y = PK2(v[2], v[3]); w.z = PK2(v[4], v[5]); w.w = PK2(v[6], v[7]); LSTORE16(lb + LT_GS + ((1 * 2 + b) * L + t8) * 2, w); } }
#pragma unroll 1
    for (int O = 0; O < 2; ++O) {
        int tq = tid; OPAQUE(tq); const int t8 = 8 * tq;
        const bf16_t* Ff = FILT + (size_t)(0 * 4096 + O * 2048 + c) * FILT_LD; const bf16_t* Fb = FILT + (size_t)(1 * 4096 + O * 2048 + c) * FILT_LD;
        const float d0 = O == 0 ? hp.dec[0][0] : hp.dec[0][1], d1 = O == 0 ? hp.dec[1][0] : hp.dec[1][1], sk = O == 0 ? hp.skip[0] : hp.skip[1];
        float ss = 0.f;
        { const U32X4 rf = LOAD16(Ff + t8), rbk = LOAD16(Fb + t8); const unsigned wf[4] = {rf.x, rf.y, rf.z, rf.w}, wb[4] = {rbk.x, rbk.y, rbk.z, rbk.w}; const float tsc = 1.0f / (float)(L - 1);
          { const U32X4 z4 = U32X4_ZERO; const int row = tq >> 2, q = tq & 3; LSTORE16(lb + LT_IN + ((128 + row) * LT_INP + 16 * q) * 2, z4); LSTORE16(lb + LT_IN + ((128 + row) * LT_INP + 16 * q + 8) * 2, z4); }
#pragma unroll
          for (int e = 0; e < 8; ++e) { const int t = t8 + e; const float tn = (float)t * tsc;
              const float f = ((e & 1) ? BFHI(wf[e >> 1]) : BFLO(wf[e >> 1])) * (EXPF(-tn * d0) + 0.05f), b = ((e & 1) ? BFHI(wb[e >> 1]) : BFLO(wb[e >> 1])) * (EXPF(-tn * d1) + 0.05f);
              ss += f * f + b * b;
              *(LDSP bf16_t*)(lb + LT_IN + ((t & 127) * LT_INP + (t >> 7)) * 2) = F2BF(f);
              const int nb = t > 0 ? N - t : L; *(LDSP bf16_t*)(lb + LT_IN + ((nb & 127) * LT_INP + (nb >> 7)) * 2) = F2BF(t > 0 ? b : 0.f); } }
        ss = WAVE_SUM(ss);
        if (lane == 0) red[wv] = ss;
        BLOCK_SYNC();
        float tot = 0.f;
#pragma unroll
        for (int w = 0; w < NTHREADS / 64; ++w) tot += red[w];
        const float sc = RSQRTF(tot + 1e-12f) * (1.0f / (float)N);
        F32X16 ksp[2]; lat_fft(lb, fr, ksp, tid);
        int tr_ = tid; OPAQUE(tr_); const int t8b = 8 * tr_;
        { const U32X4 z4 = U32X4_ZERO; const int row = tr_ >> 1, q = tr_ & 1; LSTORE16(lb + LT_IN + (row * LT_INP + 32 + 16 * q) * 2, z4); LSTORE16(lb + LT_IN + (row * LT_INP + 32 + 16 * q + 8) * 2, z4); }
#pragma unroll
        for (int b = 0; b < 2; ++b) { const U32X4 zr = LLOAD16(lb + LT_ZS + (b * L + t8b) * 2); const unsigned zw[4] = {zr.x, zr.y, zr.z, zr.w};
#pragma unroll
            for (int e = 0; e < 8; ++e) { const int t = t8b + e; *(LDSP bf16_t*)(lb + LT_IN + ((b * 128 + (t & 127)) * LT_INP + (t >> 7)) * 2) = (bf16_t)((e & 1) ? (zw[e >> 1] >> 16) : (zw[e >> 1] & 0xffffu)); } }
        BLOCK_SYNC();
        F32X16 xs[2]; lat_fft(lb, fr, xs, tid);
#pragma unroll
        for (int mb = 0; mb < 2; ++mb)
#pragma unroll
            for (int r = 0; r < 16; ++r) { const float x = F32X16_GET(xs[mb], r), k = F32X16_GET(ksp[mb], r) * sc, xo = LANE_XOR1(x), ko = LANE_XOR1(k);
                F32X16_SET(xs[mb], r, pp ? (xo * k + x * ko) : (x * k - xo * ko)); }
        lat_scatter_conj(lb, xs, tid);
        BLOCK_SYNC();
        F32X16 ys[2]; lat_fft(lb, fr, ys, tid);
        if (wv < 4) { int lg = lane; OPAQUE(lg); const int hh_ = lg >> 5, pp_ = lg & 1, k2g = 16 * wv + ((lg & 31) >> 1); const float sg = pp_ ? -1.0f : 1.0f;
#pragma unroll
            for (int mb = 0; mb < 2; ++mb)
#pragma unroll
                for (int a = 0; a < 4; ++a) { const int t = 64 * k2g + 32 * mb + 8 * a + 4 * hh_;
                    const U32X2 zr = LLOAD8(lb + LT_ZS + (pp_ * L + t) * 2), gr = LLOAD8(lb + LT_GS + ((O * 2 + pp_) * L + t) * 2);
                    const float zv[4] = {BFLO(zr.x), BFHI(zr.x), BFLO(zr.y), BFHI(zr.y)}, gv[4] = {BFLO(gr.x), BFHI(gr.x), BFLO(gr.y), BFHI(gr.y)}; float o[4];
#pragma unroll
                    for (int e = 0; e < 4; ++e) o[e] = gv[e] * (sg * F32X16_GET(ys[mb], 4 * a + e) + sk * zv[e]);
                    U32X2 w; w.x = PK2(o[0], o[1]); w.y = PK2(o[2], o[3]);
                    if (O == 0) LSTORE8(lb + LT_ZS + (pp_ * L + t) * 2, w); else STORE8(ZT + (size_t)c * NTOK + (unsigned)(RB + pp_ * L + t), w); } }
        BLOCK_SYNC();
    }
}
__device__ __forceinline__ void hy_load_params(const Args& a, int c, HyParams& hp) {
#pragma unroll
    for (int d = 0; d < 2; ++d)
#pragma unroll
        for (int o = 0; o < 2; ++o) hp.dec[d][o] = __expf(a.in[I_HDEC][(d * 2 + o) * 2048 + c]);
    hp.skip[0] = a.in[I_HSKIP][c]; hp.skip[1] = a.in[I_HSKIP][2048 + c];
#pragma unroll
    for (int w = 0; w < 3; ++w) { hp.cb[w] = a.in[I_HCB][w * 2048 + c];
#pragma unroll
        for (int k = 0; k < 3; ++k) hp.cw[w][k] = a.in[I_HCW][k * 6144 + w * 2048 + c]; }
}
__device__ __forceinline__ void hy_conv_phase(const Args& a, LAS unsigned char* lds, int tid, int vcu, int G) {
    unsigned char* ws = a.ws; const bf16_t* PT = (const bf16_t*)(ws + WS_PT); const bf16_t* FILT = (const bf16_t*)(ws + WS_FILT); bf16_t* ZT = (bf16_t*)(ws + WS_ZT);
    LAS float* red = (LAS float*)(lds + LDSCTL_OFF);
    { LatFrags fr; lat_make_frags(fr, tid);
      for (int c = vcu; c < 2048; c += G) { HyParams hp; hy_load_params(a, c, hp); hy_lat_mfma_unit(lds, red, fr, c, PT, FILT, hp, ZT, tid); } }
    for (int c = vcu; c < 2048; c += G) { HyParams hp; hy_load_params(a, c, hp); hy_ctx_mfma_unit(lds, c, PT, FILT, hp, ZT, tid); }
    __syncthreads();
}

constexpr int N_PHASES = 36;
#ifndef MK_PER_PHASE
#define MK_PER_PHASE 0
#endif
#ifndef ATTN_NAIVE
#define ATTN_NAIVE 0
#endif

__global__ void __launch_bounds__(NTHREADS, 2) trunk_fwd(Args args) {
    extern __shared__ __attribute__((aligned(16))) unsigned char lds_raw[];
    LAS unsigned char* lds = (LAS unsigned char*)lds_raw;
    volatile LAS unsigned* MISC = (volatile LAS unsigned*)(lds + MISC_OFF);
    const int tid = threadIdx.x, lane = tid & 63, wave = __builtin_amdgcn_readfirstlane(tid >> 6);
    const int G = gridDim.x, bx = blockIdx.x, vcu = (G % 8 == 0) ? (bx % 8) * (G / 8) + bx / 8 : bx;
    unsigned char* ws = args.ws;
    for (int u = tid; u < (LDS_BYTES - LDSCTL_OFF) / 4; u += NTHREADS) ((LAS unsigned*)(lds + LDSCTL_OFF))[u] = 0u;
    __syncthreads();
    XcdBarrier bar; bar.bar = (unsigned*)(ws + WS_CTL) + 4096; bar.x = 0; bar.st = nullptr;
    if (!MK_PER_PHASE) bar = xcd_barrier_post((unsigned*)(ws + WS_CTL) + 4096, MISC + 8);
    const int lo = args.ph_lo, hi = args.ph_hi;
#ifndef PH_ONLY_LO
#define PH_ONLY_LO 0
#define PH_ONLY_HI 1000
#endif
#define IN(k) ((k) >= PH_ONLY_LO && (k) < PH_ONLY_HI && lo <= (k) && (k) < hi)
#ifdef PROBE_MULT
    unsigned long long pr_prev = __builtin_amdgcn_s_memrealtime(), pr_acc = 0ull;
#define PROBE_STAMP(k) do { const unsigned long long now_ = __builtin_amdgcn_s_memrealtime(); if ((PROBE_MASK >> (k)) & 1ull) pr_acc += now_ - pr_prev; pr_prev = now_; } while (0)
#else
#define PROBE_STAMP(k) do { } while (0)
#endif
#define SEAM(k) do { if (IN(k) && IN((k) + 1)) xcd_barrier(bar); PROBE_STAMP(k); } while (0)
#ifndef DUP_N
#define DUP_N 1
#define DUP_A -1
#define DUP_B -1
#define DUP_C -1
#define DUP_D -1
#endif
#define NREP(k) (((k) == DUP_A || (k) == DUP_B || (k) == DUP_C || (k) == DUP_D) ? DUP_N : 1)
#define REPEAT(k) for (int rep_ = 0; rep_ < NREP(k); ++rep_)
    const char* U = (const char*)(ws + WS_U); const char* MIXO = (const char*)(ws + WS_MIXO); char* PART = (char*)(ws + WS_PART);

#define OUTPROJ(Aptr, Wptr, KTOT) OUTPROJ_P(Aptr, Wptr, KTOT, KTOT)
#define OUTPROJ_P(Aptr, Wptr, KTOT, PITCH) do { SchedGrid S{(const char*)(Aptr), (const char*)(Wptr), PART, (size_t)256 * (PITCH) * 2, (size_t)256 * (PITCH) * 2, (size_t)((KTOT) / 2) * 2, (size_t)((KTOT) / 2) * 2, \
        (size_t)256 * D * 2, (size_t)256 * 2, (size_t)NTOK * D * 2, D, 48, 8, 2, G, bx}; pg8::EpiBf16<0> E{nullptr}; pg8::gemm_phase<pg8::EpiBf16<0>, SchedGrid, true, true>(lds, (KTOT) / 2, (PITCH), (PITCH), S, E); } while (0)
#define FFN_BLOCK(l, p, lnext, final) do { \
    if (IN(p)) REPEAT(p) { SchedGrid S{(const char*)(ws + WS_U8), (const char*)(ws + WS_WGU + (size_t)(l) * SZ_WGU), (char*)(ws + WS_ACT), (size_t)256 * UP8, (size_t)256 * WGP8, 0, 0, (size_t)256 * AP * 2, (size_t)128 * 2, 0, AP, 48, 44, 1, G, bx}; \
        pg8::EpiSwigluI8 E{(const float*)(ws + WS_USC), (const float*)(ws + WS_WSC) + (size_t)(l) * 11264}; pg8::gemm_phase<pg8::EpiSwigluI8, SchedGrid, true, true, true>(lds, D / 2, UP8 / 2, WGP8 / 2, S, E);     \
        if ((l) < 3 && G == 256 && bx >= 64) { convert_weights(args, 3 * ((l) + 1) + 2, 3 * ((l) + 1) + 3, (bx - 64) * NWAVES + wave, 192 * NWAVES, (LAS float*)(lds + wave * 16384), lane); __syncthreads(); ffn_w8(args, (l) + 1, bx - 64, 192, lds, tid); }     \
        else if ((l) < 3 && G != 256) { convert_weights(args, 3 * ((l) + 1) + 2, 3 * ((l) + 1) + 3, vcu * NWAVES + wave, G * NWAVES, (LAS float*)(lds + wave * 16384), lane); __syncthreads(); ffn_w8(args, (l) + 1, vcu, G, lds, tid); } } SEAM(p); \
    if (IN((p) + 1)) REPEAT((p) + 1) { OUTPROJ_P(ws + WS_ACT, ws + WS_WD + (size_t)(l) * SZ_WD, DFF, AP); } SEAM((p) + 1); \
    if (IN((p) + 2)) { \
        ln_phase(args, lds, tid, lane, wave, vcu, G, (l), 5, 1, nullptr, (lnext), 0, (final)); } if (!(final)) SEAM((p) + 2); } while (0)
#define MLA_BLOCK(j, l, p) do { \
    if (IN(p)) REPEAT(p) { SchedGrid S{U, (const char*)(ws + WS_W1 + (size_t)(j) * SZ_W1), (char*)(ws + WS_T1), (size_t)256 * UP * 2, (size_t)256 * D * 2, 0, 0, (size_t)256 * 1280 * 2, (size_t)256 * 2, 0, 1280, 48, 5, 1, G, bx}; \
        pg8::EpiBf16<0> E{nullptr}; pg8::gemm_phase<pg8::EpiBf16<0>, SchedGrid, true, true>(lds, D, UP, D, S, E); } SEAM(p); \
    if (IN((p) + 1)) { mla_norm_phase(args, lane, wave, vcu, G, (j)); } SEAM((p) + 1); \
    if (IN((p) + 2)) REPEAT((p) + 2) { SchedPair S; \
        S.g0 = SchedGrid{(const char*)(ws + WS_QL), (const char*)(ws + WS_WUQ + (size_t)(j) * SZ_WUQ), (char*)(ws + WS_Q), (size_t)256 * QP8, (size_t)256 * QP8, 0, 0, (size_t)256 * 3072 * 2, (size_t)256 * 2, 0, 3072, 48, 12, 1, G, bx}; \
        S.g1 = SchedGrid{(const char*)(ws + WS_CKVN + (size_t)(j) * NKV * QP8), (const char*)(ws + WS_WUKV + (size_t)(j) * SZ_WUKV), (char*)(ws + WS_KV), (size_t)256 * QP8, (size_t)256 * QP8, 0, 0, (size_t)256 * 4096 * 2, (size_t)256 * 2, 0, 4096, 52, 16, 1, G, bx}; \
        S.G = G; S.c = bx; pg8::EpiQKV E{(const pg8::f32x2*)(ws + WS_ROPE), QSCALE, (const float*)(ws + WS_QSC), (const float*)(ws + WS_WUQSC) + (j) * 3072, (const float*)(ws + WS_KSC) + (size_t)(j) * NKV, (const float*)(ws + WS_WUKVSC) + (j) * 4096}; \
        int k512 = 256; asm volatile("" : "+s"(k512)); pg8::gemm_phase<pg8::EpiQKV, SchedPair, false, true, true>(lds, k512, QP8 / 2, QP8 / 2, S, E); } SEAM((p) + 2);     \
    if (IN((p) + 3)) REPEAT((p) + 3) { if (ATTN_NAIVE) attn_naive_phase(args, lane, wave, vcu, G, (j)); else attn_phase(args, lds, vcu, G, (j)); } SEAM((p) + 3); \
    if (IN((p) + 4)) REPEAT((p) + 4) { OUTPROJ_P(MIXO, ws + WS_WO + (size_t)(l) * SZ_WO, D, MP); } SEAM((p) + 4); \
    if (IN((p) + 5)) { ln_phase(args, lds, tid, lane, wave, vcu, G, (l), 2, 0, nullptr, (l), 3, false); } SEAM((p) + 5); } while (0)

    if (IN(0)) REPEAT(0) { p0_prologue(args, lds, tid, lane, wave, vcu, G); } SEAM(0);
    if (IN(1)) { p1_embed(args, lane, wave, vcu, G);
        { SchedGrid S{(const char*)(ws + WS_W3), (const char*)(ws + WS_HF2), (char*)(ws + WS_FILT), (size_t)256 * 256 * 2, (size_t)256 * 256 * 2, 0, 0, (size_t)256 * FILT_LD * 2, (size_t)256 * 2, 0, FILT_LD, 32, 17, 1, G, bx};
          pg8::EpiBf16<0> E{nullptr}; int k256 = 256; asm volatile("" : "+s"(k256));
          pg8::gemm_phase<pg8::EpiBf16<0>, SchedGrid, true, true>(lds, k256, 256, 256, S, E); }
    } SEAM(1);
    MLA_BLOCK(0, 0, 2);
    FFN_BLOCK(0, 8, 1, false);
    if (IN(11)) REPEAT(11) {
        { SchedGrid S{(const char*)(ws + WS_WIN), U, (char*)(ws + WS_PT), (size_t)256 * D * 2, (size_t)256 * UP * 2, 0, 0, (size_t)256 * NTOK * 2, (size_t)256 * 2, 0, NTOK, 24, 48, 1, G, bx};
          pg8::EpiBf16<1> E{args.in[I_HBIN]}; pg8::gemm_phase<pg8::EpiBf16<1>, SchedGrid, true, true>(lds, D, D, UP, S, E); }
        { const bool part = (G == 256); if (!part || bx >= 128) { const int w0 = part ? bx - 128 : vcu, nwg = part ? 128 : G;
            convert_weights(args, 18, 21, w0 * NWAVES + wave, nwg * NWAVES, (LAS float*)(lds + wave * 16384), lane); convert_weights(args, 23, 24, w0 * NWAVES + wave, nwg * NWAVES, (LAS float*)(lds + wave * 16384), lane); convert_weights(args, 27, 28, w0 * NWAVES + wave, nwg * NWAVES, (LAS float*)(lds + wave * 16384), lane);
            make_dml(ws, (size_t)w0 * NTHREADS + tid, (size_t)nwg * NTHREADS); __syncthreads();
            wq_desc(args, 21, (signed char*)(ws + WS_WUQ + SZ_WUQ), QP8, (float*)(ws + WS_WUQSC) + 3072, w0, nwg, lds, tid); wq_desc(args, 22, (signed char*)(ws + WS_WUKV + SZ_WUKV), QP8, (float*)(ws + WS_WUKVSC) + 4096, w0, nwg, lds, tid); } }
    } SEAM(11);
    if (IN(12)) REPEAT(12) { hy_conv_phase(args, lds, tid, vcu, G); } SEAM(12);
    if (IN(13)) { transpose_zt_phase(args, lds, lane, wave, vcu, G); } SEAM(13);
    if (IN(14)) { OUTPROJ_P(MIXO, ws + WS_WO + (size_t)1 * SZ_WO, D, MP); } SEAM(14);
    if (IN(15)) { ln_phase(args, lds, tid, lane, wave, vcu, G, 1, 2, 0, args.in[I_HBOUT], 1, 3, false); } SEAM(15);
    FFN_BLOCK(1, 16, 2, false);
    if (IN(19)) REPEAT(19) { SchedF1 S{(const char*)(ws + WS_DFTC), U, (char*)(ws + WS_ATC), (char*)(ws + WS_ATL), G, bx}; pg8::EpiBf16<0> E{nullptr}; int k256 = 256; asm volatile("" : "+s"(k256)); pg8::gemm_phase<pg8::EpiBf16<0>, SchedF1, true, true>(lds, k256, 256, UP, S, E); } SEAM(19);
    if (IN(20)) REPEAT(20) {
        { SchedF2 S{(const char*)(ws + WS_DML), (const char*)(ws + WS_ATL), (char*)(ws + WS_PQ), G, bx};
          pg8::EpiBf16<0> E{nullptr}; pg8::gemm_phase<pg8::EpiBf16<0>, SchedF2, true, true>(lds, 4096, 4096, 8192, S, E); }
        { SchedGrid S{(const char*)(ws + WS_DMC), (const char*)(ws + WS_ATC), (char*)(ws + WS_MIXO), 0, (size_t)256 * 512 * 2, 0, (size_t)2048 * 512 * 2, 0, (size_t)256 * 2, (size_t)256 * MP * 2, MP, 1, 8, 16, G, bx};
          pg8::EpiBf16<0> E{nullptr}; pg8::gemm_phase<pg8::EpiBf16<0>, SchedGrid, true, true>(lds, 512, 512, 512, S, E); }
    } SEAM(20);
    if (IN(35)) { fnet_combine_phase(args, tid, lane, wave, vcu, G); } if (IN(35) && IN(21)) xcd_barrier(bar); PROBE_STAMP(35);
    if (IN(21)) { OUTPROJ_P(MIXO, ws + WS_WO + (size_t)2 * SZ_WO, D, MP); } SEAM(21);
    if (IN(22)) { ln_phase(args, lds, tid, lane, wave, vcu, G, 2, 2, 0, args.in[I_FNB], 2, 3, false); } SEAM(22);
    FFN_BLOCK(2, 23, 3, false);
    MLA_BLOCK(1, 3, 26);
    FFN_BLOCK(3, 32, 3, true);
#ifdef PROBE_MULT
    { __syncthreads(); PROBE_STAMP(34); if (bx == 0 && tid == 0) { pr_acc += *(LAS unsigned long long*)(lds + LDSCTL_OFF + 1024); const unsigned long long t0_ = __builtin_amdgcn_s_memrealtime(), want_ = pr_acc * PROBE_MULT; while (__builtin_amdgcn_s_memrealtime() - t0_ < want_) __builtin_amdgcn_s_sleep(8); } }
#endif
#undef IN
#undef SEAM
}

extern "C" void kernel_launch(void* const* d_in, const int* in_sizes, int n_in, void* d_out, int out_size, void* d_ws, size_t ws_size, hipStream_t stream) {
    static int grid = 0;
    if (grid == 0) {
        if (n_in != 38 || ws_size < WS_END) { fprintf(stderr, "kernel_launch: expected 38 inputs and >= %zu bytes of workspace; got %d, %zu\n", (size_t)WS_END, n_in, ws_size); grid = -1; return; }
        int dev = 0, cus = 0, per_cu = 0;
        if (hipGetDevice(&dev) != hipSuccess || hipDeviceGetAttribute(&cus, hipDeviceAttributeMultiprocessorCount, dev) != hipSuccess) { grid = -1; return; }
        if (hipFuncSetAttribute((const void*)trunk_fwd, hipFuncAttributeMaxDynamicSharedMemorySize, LDS_BYTES) != hipSuccess) { fprintf(stderr, "kernel_launch: hipFuncSetAttribute failed\n"); grid = -1; return; }
        if (hipOccupancyMaxActiveBlocksPerMultiprocessor(&per_cu, (const void*)trunk_fwd, NTHREADS, LDS_BYTES) != hipSuccess || per_cu < 1) { fprintf(stderr, "kernel_launch: occupancy query reports %d workgroups per CU\n", per_cu); }
        (void)hipGetLastError();
        grid = cus;
    }
    if (grid < 0) return;
    if (hipMemsetAsync((char*)d_ws + WS_CTL, 0, CTL_ZERO_BYTES, stream) != hipSuccess) return;
    Args a{};
    for (int i = 0; i < 38; ++i) a.in[i] = (const float*)d_in[i];
    a.out = (float*)d_out; a.ws = (unsigned char*)d_ws; a.li = 0; a.pad = 0;
#if MK_PER_PHASE
    for (int p = 0; p < N_PHASES; ++p) { a.ph_lo = p; a.ph_hi = p + 1; hipLaunchKernelGGL(trunk_fwd, dim3(grid), dim3(NTHREADS), LDS_BYTES, stream, a); }
#else
    a.ph_lo = 0; a.ph_hi = N_PHASES; hipLaunchKernelGGL(trunk_fwd, dim3(grid), dim3(NTHREADS), LDS_BYTES, stream, a);
#endif
    const hipError_t le = hipPeekAtLastError();
    if (le != hipSuccess) fprintf(stderr, "kernel_launch: launch failed: %s\n", hipGetErrorName(le));
}
```
